# Optimizing an MI355X kernel written in HIP

```python
import math
import jax, jax.numpy as jnp
from jax import lax
import numpy as np

D_MODEL = 2048
BATCH = 8
SEQ = 4096
DEPTH = 2

HEAD_DIM = 128
UNIT = D_MODEL // (4 * HEAD_DIM)
GMLP_GROUPS = UNIT
GMLP_CHUNK = 128
GMLP_WIDTH = GMLP_GROUPS * HEAD_DIM
DIFF_HEADS = UNIT
DIFF_QK_WIDTH = DIFF_HEADS * 2 * HEAD_DIM
DIFF_V_DIM = 2 * HEAD_DIM
DIFF_WIDTH = DIFF_HEADS * DIFF_V_DIM
DIFF_Q_BLOCK = 128
CONV_GROUPS = UNIT
CONV_WIDTH = CONV_GROUPS * HEAD_DIM
CONV_K = 3
MIX_WIDTH = GMLP_WIDTH + DIFF_WIDTH + CONV_WIDTH
IN_PROJ_WIDTH = 2 * GMLP_WIDTH + 2 * DIFF_QK_WIDTH + DIFF_WIDTH + 3 * CONV_WIDTH
SPLIT_IDX = [2 * GMLP_WIDTH,
             2 * GMLP_WIDTH + DIFF_QK_WIDTH,
             2 * GMLP_WIDTH + 2 * DIFF_QK_WIDTH,
             2 * GMLP_WIDTH + 2 * DIFF_QK_WIDTH + DIFF_WIDTH]
D_FF = ((8 * D_MODEL + 3 * 256 - 1) // (3 * 256)) * 256
ROPE_THETA = 10000.0
RMS_EPS = 1e-6
LN_EPS = 1e-5

kernel_name = "hymba_gmlp_diffattn_shortconv_block"


def rms_norm(x, g):
    xf = x.astype(jnp.float32)
    y = xf * lax.rsqrt(jnp.mean(xf * xf, axis=-1, keepdims=True) + RMS_EPS)
    return (y * g.astype(jnp.float32)).astype(x.dtype)


def group_rms(x):
    xf = x.astype(jnp.float32)
    return (xf * lax.rsqrt(jnp.mean(xf * xf, axis=-1, keepdims=True) + RMS_EPS)).astype(x.dtype)


def rope(x, cos, sin):
    xf = x.astype(jnp.float32)
    x1, x2 = jnp.split(xf, 2, axis=-1)
    out = jnp.concatenate([x1 * cos - x2 * sin, x2 * cos + x1 * sin], axis=-1)
    return out.astype(x.dtype)


def gmlp_mixer(z, ln_g, ln_b, ws, bs):
    b_, s_, _ = z.shape
    z = jax.nn.gelu(z, approximate=False).reshape(b_, s_, 2, GMLP_GROUPS, HEAD_DIM)
    u, v = z[:, :, 0], z[:, :, 1]
    vf = v.astype(jnp.float32)
    mu = jnp.mean(vf, axis=-1, keepdims=True)
    var = jnp.mean(jnp.square(vf - mu), axis=-1, keepdims=True)
    vn = ((vf - mu) * lax.rsqrt(var + LN_EPS) * ln_g.astype(jnp.float32)
          + ln_b.astype(jnp.float32)).astype(v.dtype)
    vn = vn.reshape(b_, s_ // GMLP_CHUNK, GMLP_CHUNK, GMLP_GROUPS, HEAD_DIM)
    causal = jnp.tril(jnp.ones((GMLP_CHUNK, GMLP_CHUNK), dtype=bool))
    w = jnp.where(causal[None], ws, jnp.zeros_like(ws))
    mixed = jnp.einsum('gts,bnsgc->bntgc', w, vn) + jnp.transpose(bs)[:, :, None]
    return u * mixed.reshape(b_, s_, GMLP_GROUPS, HEAD_DIM)


def diff_attention(q, k, v, lam, cos, sin):
    b_, s_, h_, _, d_ = q.shape
    nb = s_ // DIFF_Q_BLOCK
    q = rope(q, cos, sin) * (1.0 / math.sqrt(d_))
    k = rope(k, cos, sin)
    qb = q.reshape(b_, nb, DIFF_Q_BLOCK, h_, 2, d_).transpose(1, 0, 3, 4, 2, 5)
    kt = k.transpose(0, 2, 3, 1, 4)
    vt = v.transpose(0, 2, 1, 3)
    key_pos = jnp.arange(s_)

    def block(args):
        q_blk, i = args
        s = jnp.einsum('bhmqd,bhmkd->bhmqk', q_blk, kt).astype(jnp.float32)
        q_pos = i * DIFF_Q_BLOCK + jnp.arange(DIFF_Q_BLOCK)
        causal = key_pos[None, :] <= q_pos[:, None]
        s = jnp.where(causal, s, -jnp.inf)
        p = jax.nn.softmax(s, axis=-1)
        a = p[:, :, 0] - lam * p[:, :, 1]
        return jnp.einsum('bhqk,bhkd->bhqd', a.astype(vt.dtype), vt)

    o = lax.map(block, (qb, jnp.arange(nb)))
    return o.transpose(1, 0, 3, 2, 4).reshape(b_, s_, h_, 2 * d_)


def short_conv_mixer(bg, cg, hc, conv_w):
    xh = cg * hc
    y = lax.conv_general_dilated(
        xh, conv_w[:, None, :].astype(xh.dtype), window_strides=(1,),
        padding=[(CONV_K - 1, 0)], dimension_numbers=('NWC', 'WIO', 'NWC'),
        feature_group_count=CONV_WIDTH)
    return bg * y


def setup_inputs(seed: int = 0) -> dict:
    key = jax.random.key(seed)
    ks = jax.random.split(key, 20)
    f32 = jnp.float32
    nrm = lambda k, shape, scale: jax.random.normal(k, shape, f32) * scale
    return {
        "x": nrm(ks[0], (BATCH, SEQ, D_MODEL), 1.0),
        "positions": jnp.broadcast_to(jnp.arange(SEQ, dtype=jnp.int32), (BATCH, SEQ)),
        "attn_norm": 1.0 + nrm(ks[1], (DEPTH, D_MODEL), 0.02),
        "w_in": nrm(ks[2], (DEPTH, D_MODEL, IN_PROJ_WIDTH), D_MODEL ** -0.5),
        "gmlp_ln_g": 1.0 + nrm(ks[3], (DEPTH, GMLP_GROUPS, HEAD_DIM), 0.02),
        "gmlp_ln_b": nrm(ks[4], (DEPTH, GMLP_GROUPS, HEAD_DIM), 0.02),
        "gmlp_ws": nrm(ks[5], (DEPTH, GMLP_GROUPS, GMLP_CHUNK, GMLP_CHUNK), GMLP_CHUNK ** -0.5),
        "gmlp_bs": 1.0 + nrm(ks[6], (DEPTH, GMLP_GROUPS, GMLP_CHUNK), 0.02),
        "lambda_q1": nrm(ks[7], (DEPTH, HEAD_DIM), 0.1),
        "lambda_k1": nrm(ks[8], (DEPTH, HEAD_DIM), 0.1),
        "lambda_q2": nrm(ks[9], (DEPTH, HEAD_DIM), 0.1),
        "lambda_k2": nrm(ks[10], (DEPTH, HEAD_DIM), 0.1),
        "conv_w": nrm(ks[11], (DEPTH, CONV_K, CONV_WIDTH), CONV_K ** -0.5),
        "mix_norm": 1.0 + nrm(ks[12], (DEPTH, MIX_WIDTH), 0.02),
        "w_out": nrm(ks[13], (DEPTH, MIX_WIDTH, D_MODEL), MIX_WIDTH ** -0.5),
        "ffn_norm": 1.0 + nrm(ks[14], (DEPTH, D_MODEL), 0.02),
        "w_gate": nrm(ks[15], (DEPTH, D_MODEL, D_FF), D_MODEL ** -0.5),
        "w_up": nrm(ks[16], (DEPTH, D_MODEL, D_FF), D_MODEL ** -0.5),
        "w_down": nrm(ks[17], (DEPTH, D_FF, D_MODEL), D_FF ** -0.5),
        "final_norm": 1.0 + nrm(ks[18], (D_MODEL,), 0.02),
    }


def reference(x, positions, attn_norm, w_in, gmlp_ln_g, gmlp_ln_b, gmlp_ws, gmlp_bs,
              lambda_q1, lambda_k1, lambda_q2, lambda_k2, conv_w, mix_norm, w_out,
              ffn_norm, w_gate, w_up, w_down, final_norm):
    b_, s_, _ = x.shape
    inv_freq = 1.0 / (ROPE_THETA ** (jnp.arange(0, HEAD_DIM, 2, dtype=jnp.float32) / HEAD_DIM))
    ang = positions.astype(jnp.float32)[..., None] * inv_freq
    cos = jnp.cos(ang)[:, :, None, None, :]
    sin = jnp.sin(ang)[:, :, None, None, :]

    for l in range(DEPTH):
        h = rms_norm(x, attn_norm[l])
        z = h @ w_in[l]
        za, zq, zk, zv, zc = jnp.split(z, SPLIT_IDX, axis=-1)

        ya = gmlp_mixer(za, gmlp_ln_g[l], gmlp_ln_b[l], gmlp_ws[l], gmlp_bs[l])

        lam_init = 0.8 - 0.6 * math.exp(-0.3 * l)
        lam = (jnp.exp(jnp.sum(lambda_q1[l].astype(jnp.float32) * lambda_k1[l].astype(jnp.float32)))
               - jnp.exp(jnp.sum(lambda_q2[l].astype(jnp.float32) * lambda_k2[l].astype(jnp.float32)))
               + lam_init)
        yb = diff_attention(zq.reshape(b_, s_, DIFF_HEADS, 2, HEAD_DIM),
                            zk.reshape(b_, s_, DIFF_HEADS, 2, HEAD_DIM),
                            zv.reshape(b_, s_, DIFF_HEADS, DIFF_V_DIM), lam, cos, sin)
        yb = group_rms(yb) * (1.0 - lam_init)

        bg, cg, hc = jnp.split(zc, 3, axis=-1)
        yc = short_conv_mixer(bg, cg, hc, conv_w[l]).reshape(b_, s_, CONV_GROUPS, HEAD_DIM)

        mix = jnp.concatenate([group_rms(ya).reshape(b_, s_, GMLP_WIDTH),
                               yb.reshape(b_, s_, DIFF_WIDTH),
                               group_rms(yc).reshape(b_, s_, CONV_WIDTH)], axis=-1)
        mix = mix * mix_norm[l].astype(mix.dtype)
        x = x + mix @ w_out[l]

        h = rms_norm(x, ffn_norm[l])
        x = x + (jax.nn.silu(h @ w_gate[l]) * (h @ w_up[l])) @ w_down[l]

    return rms_norm(x, final_norm)
```

```cpp
#include <hip/hip_runtime.h>
#include <hip/hip_cooperative_groups.h>
#include <hip/hip_bf16.h>
#include <cstdio>
#include <cstdint>
#include <cmath>
namespace cg = cooperative_groups;
template <int X> __device__ __forceinline__ float swz(float v) { return __int_as_float(__builtin_amdgcn_ds_swizzle(__float_as_int(v), 0x1f | (X << 10))); }
__device__ __forceinline__ float sum32(float v) { auto rr = __builtin_amdgcn_permlane32_swap(__float_as_uint(v), __float_as_uint(v), false, false); return __uint_as_float(rr[0]) + __uint_as_float(rr[1]); }
namespace pg8 {
#define PG8_LAS __attribute__((address_space(3)))
typedef unsigned short bf16_t;
typedef short bf16x8 __attribute__((ext_vector_type(8)));
typedef float f32x4 __attribute__((ext_vector_type(4)));
typedef unsigned u32x4 __attribute__((ext_vector_type(4)));
constexpr int BM = 256, BK = 64, HALF = 128, HTB = HALF * BK * 2  , STAGE_BYTES = 8 * HTB, NXCD = 8, WGM = 8;

__host__ __device__ __forceinline__ int lds_byte(int r, int c) { const int st = (r >> 4) * 2 + (c >> 5), rr = r & 15, cc = c & 31, ob = rr * 64 + cc * 2; return st * 1024 + (ob ^ (((ob >> 9) & 1) << 5)); }
__host__ __device__ __forceinline__ void stage_rc(int b, int& R, int& C) { const int st = b / 1024, sb = b % 1024, swz = sb ^ (((sb >> 9) & 1) << 5); R = (st >> 1) * 16 + swz / 64; C = (st & 1) * 32 + (swz % 64) / 2; }
__host__ __device__ __forceinline__ int perm32(int rho) { const int n = rho >> 4, i = rho & 15; return 8 * (i >> 2) + 4 * n + (i & 3); }

struct Unit { int pm, pn; };
struct Gemm { const bf16_t* A; const bf16_t* Bt; int M, N, K; };

struct StaticOrder {
    int nM, nN, nwg, G, c;
    __host__ __device__ void init(int M, int N, int G_, int c_) { nM = M / BM; nN = N / BM; nwg = nM * nN; G = G_; c = c_; }
    __host__ __device__ bool next(int i, Unit& u) const {
        const long L = (long)i * G + c; if (L >= nwg) return false;
        int wgid = (int)L; { const int q = nwg / NXCD, r = nwg % NXCD, xcd = wgid % NXCD, off = wgid / NXCD; wgid = (xcd < r ? xcd * (q + 1) : r * (q + 1) + (xcd - r) * q) + off; }
        const int nig = WGM * nN, gid = wgid / nig, fm = gid * WGM, gsz = (nM - fm) < WGM ? (nM - fm) : WGM;
        u.pm = fm + ((wgid % nig) % gsz); u.pn = (wgid % nig) / gsz; return true;
    }
    __device__ __forceinline__ void a_ready(const Unit&) const {}
    __device__ __forceinline__ void done(const Unit&) const {}
};

__device__ __forceinline__ unsigned cvt_pk_bf16(float lo, float hi) { unsigned r; asm volatile("v_cvt_pk_bf16_f32 %0, %1, %2" : "=v"(r) : "v"(lo), "v"(hi)); return r; }
typedef float f32x2 __attribute__((ext_vector_type(2)));
__device__ __forceinline__ float row_ssq(const float* ssqp, int row) { const f32x4 a = *(const f32x4*)(ssqp + (size_t)row * 8), b = *(const f32x4*)(ssqp + (size_t)row * 8 + 4); return ((a[0] + a[1]) + (a[2] + a[3])) + ((b[0] + b[1]) + (b[2] + b[3])); }
__device__ __forceinline__ float row_rstd(const float* ssqp, int row) { return 1.0f / sqrtf(row_ssq(ssqp, row) * (1.0f / 2048.0f) + 1e-6f); }
struct RsTab { const PG8_LAS float* rs; int pmA, pmB; const float* ssq;
    __device__ __forceinline__ float get(int pm, int r) const { return rs[(pm == pmA ? 0 : 256) + r]; } };
struct EpiZ {
    static constexpr bool PERM = true, AFTER_DRAIN = false, HAS_INIT = false;
    bf16_t* O; int ldc; const float* ssq;
    __device__ __forceinline__ void operator()(const f32x4 (&acc)[2][2][4][2], const Unit& u, int wr, int wc, int fr, int fq) const {
        const int row0 = u.pm * BM + wr * 64 + fr, col0 = u.pn * BM + wc * 32 + 8 * fq;
#pragma unroll
        for (int ai = 0; ai < 2; ++ai)
#pragma unroll
            for (int m = 0; m < 4; ++m) { const int row = row0 + ai * HALF + m * 16; const float rs = row_rstd(ssq, row); bf16_t* rowp = O + (size_t)row * ldc + col0;
#pragma unroll
                for (int bj = 0; bj < 2; ++bj) { const f32x4 v0 = acc[ai][bj][m][0] * rs, v1 = acc[ai][bj][m][1] * rs;
                    u32x4 w; w.x = cvt_pk_bf16(v0[0], v0[1]); w.y = cvt_pk_bf16(v0[2], v0[3]); w.z = cvt_pk_bf16(v1[0], v1[1]); w.w = cvt_pk_bf16(v1[2], v1[3]);
                    *(u32x4*)(rowp + bj * HALF) = w; } }
    }
};
struct EpiIn {
    static constexpr bool PERM = true, AFTER_DRAIN = false, HAS_INIT = false;
    bf16_t* Z; int ldc; RsTab T; bf16_t* QK; bf16_t* V; const float* ctab; const float* stab;
    __device__ __forceinline__ void operator()(const f32x4 (&acc)[2][2][4][2], const Unit& u, int wr, int wc, int fr, int fq) const {
        const int row0 = u.pm * BM + wr * 64 + fr, pn = u.pn;
        if (pn < 4 || pn >= 16) {
            const int col0 = pn * BM + wc * 32 + 8 * fq;
#pragma unroll
            for (int ai = 0; ai < 2; ++ai)
#pragma unroll
                for (int m = 0; m < 4; ++m) { const int row = row0 + ai * HALF + m * 16; const float rs = T.get(u.pm, wr * 64 + fr + ai * HALF + m * 16); bf16_t* rowp = Z + (size_t)row * ldc + col0;
#pragma unroll
                    for (int bj = 0; bj < 2; ++bj) { const f32x4 v0 = acc[ai][bj][m][0] * rs, v1 = acc[ai][bj][m][1] * rs;
                        u32x4 w; w.x = cvt_pk_bf16(v0[0], v0[1]); w.y = cvt_pk_bf16(v0[2], v0[3]); w.z = cvt_pk_bf16(v1[0], v1[1]); w.w = cvt_pk_bf16(v1[2], v1[3]);
                        *(u32x4*)(rowp + bj * HALF) = w; } }
        } else if (pn < 12) {
            const int hd = (pn - 4) * 2 + (wc >> 1), j0 = 32 * (wc & 1) + 8 * fq;
#pragma unroll
            for (int g2 = 0; g2 < 4; ++g2) { const int ai = g2 >> 1, m0 = (g2 & 1) * 2;
                f32x4 tc[2][4];
#pragma unroll
                for (int mm = 0; mm < 2; ++mm) { const size_t tb = (size_t)(row0 + ai * HALF + (m0 + mm) * 16) * 64 + j0;
                    tc[mm][0] = *(const f32x4*)(ctab + tb); tc[mm][1] = *(const f32x4*)(ctab + tb + 4); tc[mm][2] = *(const f32x4*)(stab + tb); tc[mm][3] = *(const f32x4*)(stab + tb + 4); }
#pragma unroll
                for (int mm = 0; mm < 2; ++mm) { const int m = m0 + mm; const int row = row0 + ai * HALF + m * 16; const float rs = T.get(u.pm, wr * 64 + fr + ai * HALF + m * 16);
                    const f32x4 c0 = tc[mm][0], c1 = tc[mm][1], s0 = tc[mm][2], s1 = tc[mm][3];
                    const f32x4 a0 = acc[ai][0][m][0] * rs, a1 = acc[ai][0][m][1] * rs, b0 = acc[ai][1][m][0] * rs, b1 = acc[ai][1][m][1] * rs;
                    const f32x4 p0 = a0 * c0 - b0 * s0, p1 = a1 * c1 - b1 * s1, q0 = b0 * c0 + a0 * s0, q1 = b1 * c1 + a1 * s1;
                    bf16_t* dp = QK + (((size_t)(row >> 12) * 16 + hd) * 4096 + (row & 4095)) * 128 + j0;
                    u32x4 w; w.x = cvt_pk_bf16(p0[0], p0[1]); w.y = cvt_pk_bf16(p0[2], p0[3]); w.z = cvt_pk_bf16(p1[0], p1[1]); w.w = cvt_pk_bf16(p1[2], p1[3]); *(u32x4*)dp = w;
                    w.x = cvt_pk_bf16(q0[0], q0[1]); w.y = cvt_pk_bf16(q0[2], q0[3]); w.z = cvt_pk_bf16(q1[0], q1[1]); w.w = cvt_pk_bf16(q1[2], q1[3]); *(u32x4*)(dp + 64) = w; }
            }
        } else {
#pragma unroll
            for (int ai = 0; ai < 2; ++ai)
#pragma unroll
                for (int m = 0; m < 4; ++m) { const int row = row0 + ai * HALF + m * 16; const float rs = T.get(u.pm, wr * 64 + fr + ai * HALF + m * 16);
#pragma unroll
                    for (int bj = 0; bj < 2; ++bj) { const f32x4 v0 = acc[ai][bj][m][0] * rs, v1 = acc[ai][bj][m][1] * rs;
                        bf16_t* dp = V + (((size_t)(row >> 12) * 8 + (pn - 12) * 2 + bj) * 4096 + (row & 4095)) * 128 + wc * 32 + 8 * fq;
                        u32x4 w; w.x = cvt_pk_bf16(v0[0], v0[1]); w.y = cvt_pk_bf16(v0[2], v0[3]); w.z = cvt_pk_bf16(v1[0], v1[1]); w.w = cvt_pk_bf16(v1[2], v1[3]);
                        *(u32x4*)dp = w; } }
        }
    }
};
__device__ __forceinline__ float swiglu1(float g, float u) { return g * u * __builtin_amdgcn_rcpf(1.0f + __builtin_amdgcn_exp2f(-1.4426950408889634f * g)); }
struct EpiSwiGLU {
    static constexpr bool PERM = true, AFTER_DRAIN = false, HAS_INIT = false;
    bf16_t* O; int ldc; RsTab T;
    __device__ __forceinline__ void operator()(const f32x4 (&acc)[2][2][4][2], const Unit& u, int wr, int wc, int fr, int fq) const {
        const int row0 = u.pm * BM + wr * 64 + fr, col0 = u.pn * HALF + wc * 32 + 8 * fq;
#pragma unroll
        for (int ai = 0; ai < 2; ++ai)
#pragma unroll
            for (int m = 0; m < 4; ++m) { const int row = row0 + ai * HALF + m * 16; const float rs = T.get(u.pm, wr * 64 + fr + ai * HALF + m * 16); bf16_t* rowp = O + (size_t)row * ldc + col0;
                const f32x4 g0 = acc[ai][0][m][0] * rs, g1 = acc[ai][0][m][1] * rs, u0 = acc[ai][1][m][0] * rs, u1 = acc[ai][1][m][1] * rs;
                u32x4 w; w.x = cvt_pk_bf16(swiglu1(g0[0], u0[0]), swiglu1(g0[1], u0[1])); w.y = cvt_pk_bf16(swiglu1(g0[2], u0[2]), swiglu1(g0[3], u0[3]));
                w.z = cvt_pk_bf16(swiglu1(g1[0], u1[0]), swiglu1(g1[1], u1[1])); w.w = cvt_pk_bf16(swiglu1(g1[2], u1[2]), swiglu1(g1[3], u1[3]));
                *(u32x4*)rowp = w; }
    }
};
struct EpiRes {
    static constexpr bool PERM = true, AFTER_DRAIN = false, HAS_INIT = true;
    bf16_t* X; int ldc; float* ssqp; PG8_LAS float* P;
    __device__ __forceinline__ void init(f32x4 (&acc)[2][2][4][2], const Unit& u, int wr, int wc, int fr, int fq) const {
        const int row0 = u.pm * BM + wr * 64 + fr, col0 = u.pn * BM + wc * 32 + 8 * fq;
#pragma unroll
        for (int ai = 0; ai < 2; ++ai)
#pragma unroll
            for (int m = 0; m < 4; ++m) { const bf16_t* rp = X + (size_t)(row0 + ai * HALF + m * 16) * ldc + col0;
#pragma unroll
                for (int bj = 0; bj < 2; ++bj) { const u32x4 b = *(const u32x4*)(rp + bj * HALF);
                    acc[ai][bj][m][0] = (f32x4){__uint_as_float(b.x << 16), __uint_as_float(b.x & 0xffff0000u), __uint_as_float(b.y << 16), __uint_as_float(b.y & 0xffff0000u)};
                    acc[ai][bj][m][1] = (f32x4){__uint_as_float(b.z << 16), __uint_as_float(b.z & 0xffff0000u), __uint_as_float(b.w << 16), __uint_as_float(b.w & 0xffff0000u)}; } }
    }
    template <int AI0, int AI1> __device__ __forceinline__ void load_tile(u32x4 (&nx)[2][4][2], const Unit& u, int wr, int wc, int fr, int fq) const {
        const int row0 = u.pm * BM + wr * 64 + fr, col0 = u.pn * BM + wc * 32 + 8 * fq;
#pragma unroll
        for (int ai = AI0; ai < AI1; ++ai)
#pragma unroll
            for (int m = 0; m < 4; ++m) { const bf16_t* rp = X + (size_t)(row0 + ai * HALF + m * 16) * ldc + col0;
#pragma unroll
                for (int bj = 0; bj < 2; ++bj) nx[ai][m][bj] = *(const u32x4*)(rp + bj * HALF); }
    }
    __device__ __forceinline__ void unpack(f32x4 (&acc)[2][2][4][2], const u32x4 (&nx)[2][4][2]) const {
#pragma unroll
        for (int ai = 0; ai < 2; ++ai)
#pragma unroll
            for (int m = 0; m < 4; ++m)
#pragma unroll
                for (int bj = 0; bj < 2; ++bj) { const u32x4 b = nx[ai][m][bj];
                    acc[ai][bj][m][0] = (f32x4){__uint_as_float(b.x << 16), __uint_as_float(b.x & 0xffff0000u), __uint_as_float(b.y << 16), __uint_as_float(b.y & 0xffff0000u)};
                    acc[ai][bj][m][1] = (f32x4){__uint_as_float(b.z << 16), __uint_as_float(b.z & 0xffff0000u), __uint_as_float(b.w << 16), __uint_as_float(b.w & 0xffff0000u)}; }
    }
    __device__ __forceinline__ void fused(f32x4 (&acc)[2][2][4][2], const Unit& u, const Unit& un, bool has_next, int wr, int wc, int fr, int fq) const {
        const int row0 = u.pm * BM + wr * 64 + fr, col0 = u.pn * BM + wc * 32 + 8 * fq;
        u32x4 w[2][4][2];
#pragma unroll
        for (int ai = 0; ai < 2; ++ai)
#pragma unroll
            for (int m = 0; m < 4; ++m) { float part = 0.f;
#pragma unroll
                for (int bj = 0; bj < 2; ++bj) { const f32x4 a0 = acc[ai][bj][m][0], a1 = acc[ai][bj][m][1];
                    part += (a0[0] * a0[0] + a0[1] * a0[1]) + (a0[2] * a0[2] + a0[3] * a0[3]) + (a1[0] * a1[0] + a1[1] * a1[1]) + (a1[2] * a1[2] + a1[3] * a1[3]);
                    w[ai][m][bj].x = cvt_pk_bf16(a0[0], a0[1]); w[ai][m][bj].y = cvt_pk_bf16(a0[2], a0[3]); w[ai][m][bj].z = cvt_pk_bf16(a1[0], a1[1]); w[ai][m][bj].w = cvt_pk_bf16(a1[2], a1[3]); }
                part += swz<16>(part); part = sum32(part);
                if (fq == 0) P[(wr * 64 + ai * HALF + m * 16 + fr) * 4 + wc] = part; }
        asm volatile("" ::: "memory");
        u32x4 nx[2][4][2];
        if (has_next) load_tile<0, 2>(nx, un, wr, wc, fr, fq);
        asm volatile("" ::: "memory");
#pragma unroll
        for (int ai = 0; ai < 2; ++ai)
#pragma unroll
            for (int m = 0; m < 4; ++m) { bf16_t* rowp = X + (size_t)(row0 + ai * HALF + m * 16) * ldc + col0;
#pragma unroll
                for (int bj = 0; bj < 2; ++bj) *(u32x4*)(rowp + bj * HALF) = w[ai][m][bj]; }
        asm volatile("s_waitcnt lgkmcnt(0)" ::: "memory"); __builtin_amdgcn_s_barrier(); asm volatile("" ::: "memory");
        const int t = (wr * 4 + wc) * 64 + fq * 16 + fr;
        if (t < BM) { const f32x4 p = *(const PG8_LAS f32x4*)(P + t * 4); ssqp[((size_t)u.pm * BM + t) * 8 + u.pn] = (p[0] + p[1]) + (p[2] + p[3]); }
        if (has_next) unpack(acc, nx);
    }
    __device__ __forceinline__ void operator()(const f32x4 (&acc)[2][2][4][2], const Unit& u, int wr, int wc, int fr, int fq) const {
        const int row0 = u.pm * BM + wr * 64 + fr, col0 = u.pn * BM + wc * 32 + 8 * fq;
#pragma unroll
        for (int ai = 0; ai < 2; ++ai)
#pragma unroll
            for (int m = 0; m < 4; ++m) { const int row = row0 + ai * HALF + m * 16; bf16_t* rowp = X + (size_t)row * ldc + col0; float part = 0.f;
#pragma unroll
                for (int bj = 0; bj < 2; ++bj) { const f32x4 a0 = acc[ai][bj][m][0], a1 = acc[ai][bj][m][1];
                    part += (a0[0] * a0[0] + a0[1] * a0[1]) + (a0[2] * a0[2] + a0[3] * a0[3]) + (a1[0] * a1[0] + a1[1] * a1[1]) + (a1[2] * a1[2] + a1[3] * a1[3]);
                    u32x4 w; w.x = cvt_pk_bf16(a0[0], a0[1]); w.y = cvt_pk_bf16(a0[2], a0[3]); w.z = cvt_pk_bf16(a1[0], a1[1]); w.w = cvt_pk_bf16(a1[2], a1[3]);
                    *(u32x4*)(rowp + bj * HALF) = w; }
                part += swz<16>(part); part = sum32(part);
                if (fq == 0) P[(wr * 64 + ai * HALF + m * 16 + fr) * 4 + wc] = part; }
        asm volatile("s_waitcnt lgkmcnt(0)" ::: "memory"); __builtin_amdgcn_s_barrier(); asm volatile("" ::: "memory");
        const int t = (wr * 4 + wc) * 64 + fq * 16 + fr;
        if (t < BM) { const f32x4 p = *(const PG8_LAS f32x4*)(P + t * 4); ssqp[((size_t)u.pm * BM + t) * 8 + u.pn] = (p[0] + p[1]) + (p[2] + p[3]); }
    }
};
template <class Epi, class Sched, bool ALIGN_EPI = false, bool SP2 = false>
__device__ __forceinline__ void gemm_phase(PG8_LAS unsigned char* lds, const Gemm g, const Sched& S, const Epi& E) {
    int tid_o = threadIdx.x; asm volatile("" : "+v"(tid_o));
    const int tid = tid_o, wid = __builtin_amdgcn_readfirstlane(tid >> 6), lane = tid & 63, wr = wid >> 2, wc = wid & 3, fr = lane & 15, fq = lane >> 4;
    const int K = g.K, nt = K / BK;
    unsigned voffA[2], voffB[2];
#pragma unroll
    for (int i = 0; i < 2; ++i) { int R, C; stage_rc(tid * 16 + i * 8192, R, C); const int Rb = Epi::PERM ? ((R & ~31) + perm32(R & 31)) : R;
        voffA[i] = (unsigned)(R * K + C) * 2u; voffB[i] = (unsigned)(Rb * K + C) * 2u; }
    const size_t kstep = (size_t)(BK * 2);
    const size_t hstep = (size_t)HALF * K * 2;
    const size_t tstep = 2 * hstep;
    const unsigned ldsw = (unsigned)wid * 1024u;
    const int aoff = lds_byte(wr * 64 + fr, fq * 8), boff = lds_byte(wc * 32 + fr, fq * 8);
#define PG8_SA(b, h) (((b) * 2 + (h)) * HTB)
#define PG8_SB(b, h) ((4 + (b) * 2 + (h)) * HTB)
#define PG8_STAGE(bufoff, gbase, voff) do { _Pragma("unroll") for (int _i = 0; _i < 2; ++_i) \
        __builtin_amdgcn_global_load_lds((const unsigned*)((const char*)(gbase) + (voff)[_i]), (PG8_LAS unsigned*)(lds + (bufoff) + ldsw + _i * 8192), 16, 0, 0); } while (0)
#define PG8_LDA(dst, b, h) do { _Pragma("unroll") for (int m = 0; m < 4; ++m) _Pragma("unroll") for (int k = 0; k < 2; ++k) dst[m][k] = *(const PG8_LAS bf16x8*)(lds + PG8_SA(b, h) + aoff + m * 2048 + k * 1024); } while (0)
#define PG8_LDB(dst, b, h) do { _Pragma("unroll") for (int n = 0; n < 2; ++n) _Pragma("unroll") for (int k = 0; k < 2; ++k) dst[n][k] = *(const PG8_LAS bf16x8*)(lds + PG8_SB(b, h) + boff + n * 2048 + k * 1024); } while (0)
#define PG8_MMA(ai, bj, At, Bt) do { __builtin_amdgcn_s_setprio(1); _Pragma("unroll") for (int m = 0; m < 4; ++m) _Pragma("unroll") for (int n = 0; n < 2; ++n) _Pragma("unroll") for (int k = 0; k < 2; ++k) \
        acc[ai][bj][m][n] = __builtin_amdgcn_mfma_f32_16x16x32_bf16(Bt[n][k], At[m][k], acc[ai][bj][m][n], 0, 0, 0); __builtin_amdgcn_s_setprio(0); } while (0)
#define PG8_WAIT_V(n) asm volatile("s_waitcnt vmcnt(" #n ")" ::: "memory")
#define PG8_WAIT_L(n) asm volatile("s_waitcnt lgkmcnt(" #n ")" ::: "memory")
#define PG8_BAR __builtin_amdgcn_s_barrier()
#define PG8_SCHED __builtin_amdgcn_sched_barrier(0)
    Unit cur, nxt; int ui = 0;
    if (!S.next(0, cur)) return;
    f32x4 acc[2][2][4][2];
    if constexpr (Epi::HAS_INIT) E.init(acc, cur, wr, wc, fr, fq);
    else {
#pragma unroll
    for (int a = 0; a < 2; ++a)
#pragma unroll
        for (int b = 0; b < 2; ++b)
#pragma unroll
            for (int m = 0; m < 4; ++m)
#pragma unroll
                for (int n = 0; n < 2; ++n) acc[a][b][m][n] = (f32x4){0.f, 0.f, 0.f, 0.f};
    }
    bf16x8 At[4][2], B0[2][2], B1[2][2];
    const char* cA = (const char*)g.A + (size_t)cur.pm * tstep; const char* cB = (const char*)g.Bt + (size_t)cur.pn * tstep;
    S.a_ready(cur);
    if constexpr (SP2) {
        PG8_STAGE(PG8_SB(0, 0), cB, voffB); PG8_STAGE(PG8_SB(0, 1), cB + hstep, voffB); PG8_STAGE(PG8_SA(0, 0), cA, voffA); PG8_STAGE(PG8_SA(0, 1), cA + hstep, voffA);
        if (wr == 1) PG8_BAR;
        PG8_WAIT_V(2); PG8_BAR;
        PG8_STAGE(PG8_SB(1, 0), cB + kstep, voffB); PG8_STAGE(PG8_SA(1, 0), cA + kstep, voffA); PG8_STAGE(PG8_SB(1, 1), cB + hstep + kstep, voffB);
        PG8_WAIT_V(6); PG8_BAR;
    } else {
        PG8_STAGE(PG8_SB(0, 0), cB, voffB); PG8_STAGE(PG8_SA(0, 0), cA, voffA); PG8_STAGE(PG8_SB(0, 1), cB + hstep, voffB); PG8_STAGE(PG8_SA(0, 1), cA + hstep, voffA);
        if (wr == 1) PG8_BAR;
        PG8_WAIT_V(4); PG8_BAR;
        PG8_STAGE(PG8_SB(1, 0), cB + kstep, voffB); PG8_STAGE(PG8_SA(1, 0), cA + kstep, voffA); PG8_STAGE(PG8_SB(1, 1), cB + hstep + kstep, voffB);
        PG8_WAIT_V(6); PG8_BAR;
    }
    for (;;) {
        const bool has_next = S.next(ui + 1, nxt);
        const char* nA = has_next ? (const char*)g.A + (size_t)nxt.pm * tstep : cA; const char* nB = has_next ? (const char*)g.Bt + (size_t)nxt.pn * tstep : cB;
        for (int t = 0; t < nt; t += 2) {
            const bool last = (t == nt - 2);
            const char* a1 = cA + (size_t)(t + 1) * kstep;
            const char* a2 = last ? nA : cA + (size_t)(t + 2) * kstep; const char* b2 = last ? nB : cB + (size_t)(t + 2) * kstep;
            const char* a3 = a2 + kstep; const char* b3 = b2 + kstep;
            if (last && has_next) S.a_ready(nxt);
            if constexpr (SP2) {
            PG8_LDB(B0, 0, 0); PG8_LDB(B1, 0, 1); PG8_SCHED; PG8_LDA(At, 0, 0); PG8_STAGE(PG8_SA(1, 1), a1 + hstep, voffA);
            PG8_WAIT_V(8); PG8_WAIT_L(0); PG8_BAR; PG8_MMA(0, 0, At, B0); PG8_MMA(0, 1, At, B1); PG8_BAR; PG8_SCHED;
            PG8_LDA(At, 0, 1); PG8_STAGE(PG8_SB(0, 0), b2, voffB); PG8_STAGE(PG8_SB(0, 1), b2 + hstep, voffB); PG8_STAGE(PG8_SA(0, 0), a2, voffA);
            PG8_WAIT_V(8); PG8_WAIT_L(0); PG8_BAR; PG8_MMA(1, 0, At, B0); PG8_MMA(1, 1, At, B1); PG8_BAR; PG8_SCHED;
            PG8_LDB(B0, 1, 0); PG8_LDB(B1, 1, 1); PG8_SCHED; PG8_LDA(At, 1, 0); PG8_STAGE(PG8_SA(0, 1), a2 + hstep, voffA);
            PG8_WAIT_V(8); PG8_WAIT_L(0); PG8_BAR; PG8_MMA(0, 0, At, B0); PG8_MMA(0, 1, At, B1); PG8_BAR; PG8_SCHED;
            PG8_LDA(At, 1, 1); PG8_STAGE(PG8_SB(1, 0), b3, voffB); PG8_STAGE(PG8_SB(1, 1), b3 + hstep, voffB); PG8_STAGE(PG8_SA(1, 0), a3, voffA);
            PG8_WAIT_V(8); PG8_WAIT_L(0); PG8_BAR; PG8_MMA(1, 0, At, B0); PG8_MMA(1, 1, At, B1); PG8_BAR; PG8_SCHED;
            } else {
            PG8_LDB(B0, 0, 0); PG8_SCHED; PG8_LDA(At, 0, 0); PG8_STAGE(PG8_SA(1, 1), a1 + hstep, voffA);
            PG8_WAIT_L(8); PG8_BAR; PG8_WAIT_L(0); PG8_MMA(0, 0, At, B0); PG8_BAR; PG8_SCHED;
            PG8_LDB(B1, 0, 1); PG8_STAGE(PG8_SB(0, 0), b2, voffB);
            PG8_BAR; PG8_WAIT_L(0); PG8_MMA(0, 1, At, B1); PG8_BAR;
            PG8_LDA(At, 0, 1); PG8_STAGE(PG8_SA(0, 0), a2, voffA);
            PG8_BAR; PG8_WAIT_L(0); PG8_MMA(1, 0, At, B0); PG8_BAR; PG8_SCHED;
            PG8_STAGE(PG8_SB(0, 1), b2 + hstep, voffB);
            PG8_WAIT_V(6); PG8_BAR; PG8_MMA(1, 1, At, B1); PG8_BAR;
            PG8_LDB(B0, 1, 0); PG8_SCHED; PG8_LDA(At, 1, 0); PG8_STAGE(PG8_SA(0, 1), a2 + hstep, voffA);
            PG8_WAIT_L(8); PG8_BAR; PG8_WAIT_L(0); PG8_MMA(0, 0, At, B0); PG8_BAR; PG8_SCHED;
            PG8_LDB(B1, 1, 1); PG8_STAGE(PG8_SB(1, 0), b3, voffB);
            PG8_BAR; PG8_WAIT_L(0); PG8_MMA(0, 1, At, B1); PG8_BAR;
            PG8_LDA(At, 1, 1); PG8_STAGE(PG8_SA(1, 0), a3, voffA);
            PG8_BAR; PG8_WAIT_L(0); PG8_MMA(1, 0, At, B0); PG8_BAR; PG8_SCHED;
            PG8_STAGE(PG8_SB(1, 1), b3 + hstep, voffB);
            PG8_WAIT_V(6); PG8_BAR; PG8_MMA(1, 1, At, B1); PG8_BAR;
            }
        }
        if constexpr (ALIGN_EPI) { if (wr == 0) PG8_BAR; }
        int fr_e = fr, fq_e = fq; asm volatile("" : "+v"(fr_e), "+v"(fq_e));
        if constexpr (Epi::HAS_INIT) { E.fused(acc, cur, nxt, has_next, wr, wc, fr_e, fq_e); S.done(cur); }
        else if constexpr (!Epi::AFTER_DRAIN) { E(acc, cur, wr, wc, fr_e, fq_e); S.done(cur); }
        if (!has_next) break;
        if constexpr (Epi::HAS_INIT) { }
        else {
#pragma unroll
        for (int a = 0; a < 2; ++a)
#pragma unroll
            for (int b = 0; b < 2; ++b)
#pragma unroll
                for (int m = 0; m < 4; ++m)
#pragma unroll
                    for (int n = 0; n < 2; ++n) acc[a][b][m][n] = (f32x4){0.f, 0.f, 0.f, 0.f};
        }
        cur = nxt; cA = nA; cB = nB; ++ui;
        if constexpr (ALIGN_EPI) { if (wr == 1) PG8_BAR; }
    }
    PG8_WAIT_V(0);
    if constexpr (!ALIGN_EPI) { if (wr == 0) PG8_BAR; }
    PG8_BAR;
    if constexpr (Epi::AFTER_DRAIN) { E.fused(acc, cur, wr, wc, fr, fq, lds, wid, lane); S.done(cur); }
#undef PG8_SA
#undef PG8_SB
#undef PG8_STAGE
#undef PG8_LDA
#undef PG8_LDB
#undef PG8_MMA
#undef PG8_WAIT_V
#undef PG8_WAIT_L
#undef PG8_BAR
#undef PG8_SCHED
}
}
#ifndef PG8_SP2
#define PG8_SP2 true
#endif
#ifndef PG8_ALIGN
#define PG8_ALIGN true
#endif
namespace att {
constexpr int D = 128;
constexpr int LDQ = 128, LDKV = 128, LDO = 128;
constexpr float THR = 8.f;
constexpr bool WSKIP = false;
constexpr float SCALE = 0.08838834764831845f;
constexpr int NW = 8, QBLK = 32, KVBLK = 64, QB = NW * QBLK;
constexpr int SHM_V = KVBLK * D * 2, SHM_K = KVBLK * D * 2;
constexpr int LDS_BYTES = 2 * SHM_V + 2 * SHM_K + NW * 64 * 4;
using bf16 = __hip_bfloat16;
typedef short bf16x8 __attribute__((ext_vector_type(8)));
typedef short s16x4 __attribute__((ext_vector_type(4)));
typedef float f32x16 __attribute__((ext_vector_type(16)));
typedef float f32x4 __attribute__((ext_vector_type(4)));
typedef unsigned u32x4 __attribute__((ext_vector_type(4)));
template <class A, class Bt> struct same_t { static constexpr bool v = false; };
template <class A> struct same_t<A, A> { static constexpr bool v = true; };

#define KSWZ(row, colB) ((row) * 256 + ((colB) ^ (((row) & 7) << 4)))
#define SBAR() __builtin_amdgcn_sched_barrier(0)
__device__ __forceinline__ int v_st(int k, int c) { const int kk = (k & ~0xC) | ((k & 4) << 1) | ((k & 8) >> 1); return ((kk >> 3) * 4 + (c >> 5)) * 512 + ((kk & 7) * 32 + (c & 31)) * 2; }
__device__ __forceinline__ int v_rd_base(int lane) { return ((lane & 3) << 3) | (((lane >> 2) & 3) << 6) | (((lane >> 4) & 1) << 5) | (((lane >> 5) & 1) << 8); }
constexpr int v_rd_off(int d0, int ks, int half) { return d0 * 512 + ks * 4096 + half * 2048; }
__device__ __forceinline__ int crow(int r, int hi) { return (r & 3) + 8 * (r >> 2) + 4 * hi; }
__device__ __forceinline__ unsigned cvtpk(float lo, float hi) {
    unsigned r; asm volatile("v_cvt_pk_bf16_f32 %0, %1, %2" : "=v"(r) : "v"(lo), "v"(hi)); return r;
}
__device__ __forceinline__ bf16x8 pack8(f32x4 a, f32x4 b) {
    u32x4 w = {cvtpk(a[0], a[1]), cvtpk(a[2], a[3]), cvtpk(b[0], b[1]), cvtpk(b[2], b[3])};
    return *reinterpret_cast<bf16x8*>(&w);
}
template <class T> __device__ __forceinline__ bf16x8 load8(const T* p) {
    if constexpr (same_t<T, float>::v) { return pack8(*(const f32x4*)p, *(const f32x4*)(p + 4)); }
    else { return *reinterpret_cast<const bf16x8*>(p); }
}
__device__ __forceinline__ void mask_tile(f32x16& p0, f32x16& p1, int dq, unsigned W) {
    const float NEG = -__builtin_inff();
#pragma unroll
    for (int r = 0; r < 16; ++r) {
        const int c = (r & 3) + 8 * (r >> 2);
        if ((unsigned)(dq - c) >= W) p0[r] = NEG;
        if ((unsigned)(dq - c - 32) >= W) p1[r] = NEG;
    }
}
__device__ __forceinline__ void partialSM(f32x16& p0, f32x16& p1, float& m_reg, float& mn, float& alpha) {
    float pmax = p0[0]; for (int r = 1; r < 16; ++r) pmax = fmaxf(pmax, p0[r]); for (int r = 0; r < 16; ++r) pmax = fmaxf(pmax, p1[r]);
    { auto rr = __builtin_amdgcn_permlane32_swap(__float_as_uint(pmax), __float_as_uint(pmax), false, false);
      pmax = fmaxf(__uint_as_float(rr[0]), __uint_as_float(rr[1])); }
    constexpr float C2 = 1.4426950408889634f * SCALE;
    if (__builtin_expect(__all((pmax - m_reg) * SCALE <= THR), 1)) { mn = m_reg; alpha = 1.f; }
    else { mn = fmaxf(m_reg, pmax); alpha = __builtin_amdgcn_exp2f((m_reg - mn) * C2); m_reg = mn; }
    const float mnL = -mn * C2;
    for (int r = 0; r < 16; ++r) p0[r] = fmaf(p0[r], C2, mnL); for (int r = 0; r < 16; ++r) p1[r] = fmaf(p1[r], C2, mnL);
    for (int r = 0; r < 16; ++r) p0[r] = __builtin_amdgcn_exp2f(p0[r]);
}
__device__ __forceinline__ void finishSM(f32x16& p0, f32x16& p1, float alpha, float& l_reg, bf16x8& pa0, bf16x8& pa1, bf16x8& pa2, bf16x8& pa3) {
    for (int r = 0; r < 16; ++r) p1[r] = __builtin_amdgcn_exp2f(p1[r]);
    float ps = 0; for (int r = 0; r < 16; ++r) ps += p0[r]; for (int r = 0; r < 16; ++r) ps += p1[r];
    { auto rr = __builtin_amdgcn_permlane32_swap(__float_as_uint(ps), __float_as_uint(ps), false, false);
      ps = __uint_as_float(rr[0]) + __uint_as_float(rr[1]); }
    l_reg = l_reg * alpha + ps;
#define PK4(P, B_, OUT) do { unsigned a0 = cvtpk(P[B_+0], P[B_+1]), a1 = cvtpk(P[B_+2], P[B_+3]);                          \
        unsigned b0 = cvtpk(P[B_+4], P[B_+5]), b1 = cvtpk(P[B_+6], P[B_+7]);                                             \
        auto r0 = __builtin_amdgcn_permlane32_swap(a0, b0, false, false); auto r1 = __builtin_amdgcn_permlane32_swap(a1, b1, false, false); \
        u32x4 w = {r0[0], r1[0], r0[1], r1[1]}; OUT = *reinterpret_cast<bf16x8*>(&w); } while (0)
    PK4(p0, 0, pa0); PK4(p0, 8, pa1); PK4(p1, 0, pa2); PK4(p1, 8, pa3);
#undef PK4
}
template <int KB, bool SK>
__device__ __forceinline__ void qkt(f32x16& p0, f32x16& p1, const char* K_lds, int r32, int hi, const bf16x8* qr, bool act) {
    if (SK && !act) { const float NEG = -__builtin_inff();
#pragma unroll
        for (int r = 0; r < 16; ++r) { p0[r] = NEG; p1[r] = NEG; } return; }
    p0 = f32x16{}; p1 = f32x16{};
    const char* kb[4];
#pragma unroll
    for (int dd = 0; dd < 4; ++dd) kb[dd] = K_lds + KB * SHM_K + KSWZ(r32, (dd * 16 + hi * 8) * 2);
#pragma unroll
    for (int d0 = 0; d0 < 8; ++d0) { const char* a = kb[d0 & 3] + (d0 >> 2) * 128;
        bf16x8 b0 = *reinterpret_cast<const bf16x8*>(a);
        bf16x8 b1 = *reinterpret_cast<const bf16x8*>(a + 32 * 256);
        p0 = __builtin_amdgcn_mfma_f32_32x32x16_bf16(b0, qr[d0], p0, 0, 0, 0);
        p1 = __builtin_amdgcn_mfma_f32_32x32x16_bf16(b1, qr[d0], p1, 0, 0, 0); }
}
template <int VB, bool SK>
__device__ __forceinline__ void pv_tile(f32x16* o, int vb0, bf16x8 pa0, bf16x8 pa1, bf16x8 pa2, bf16x8 pa3, bool act) {
    if (SK && !act) return;
#define TRRD(dst, off) asm volatile("ds_read_b64_tr_b16 %0, %1 offset:%2" : "=&v"(dst) : "v"(vb0), "i"(off) : "memory")
#define PV_D0(d0) do { s16x4 l0, l1, l2, l3, h0, h1, h2, h3; constexpr int b_ = VB * SHM_V + v_rd_off(d0, 0, 0);     \
        TRRD(l0, b_); TRRD(h0, b_ + 2048); TRRD(l1, b_ + 4096); TRRD(h1, b_ + 6144); TRRD(l2, b_ + 8192); TRRD(h2, b_ + 10240); TRRD(l3, b_ + 12288); TRRD(h3, b_ + 14336); \
        asm volatile("s_waitcnt lgkmcnt(0)" ::: "memory"); SBAR();                 \
        o[d0] = __builtin_amdgcn_mfma_f32_32x32x16_bf16(pa0, (bf16x8){l0[0], l0[1], l0[2], l0[3], h0[0], h0[1], h0[2], h0[3]}, o[d0], 0, 0, 0);   \
        o[d0] = __builtin_amdgcn_mfma_f32_32x32x16_bf16(pa1, (bf16x8){l1[0], l1[1], l1[2], l1[3], h1[0], h1[1], h1[2], h1[3]}, o[d0], 0, 0, 0);   \
        o[d0] = __builtin_amdgcn_mfma_f32_32x32x16_bf16(pa2, (bf16x8){l2[0], l2[1], l2[2], l2[3], h2[0], h2[1], h2[2], h2[3]}, o[d0], 0, 0, 0);   \
        o[d0] = __builtin_amdgcn_mfma_f32_32x32x16_bf16(pa3, (bf16x8){l3[0], l3[1], l3[2], l3[3], h3[0], h3[1], h3[2], h3[3]}, o[d0], 0, 0, 0); } while (0)
    PV_D0(0); PV_D0(1); PV_D0(2); PV_D0(3);
#undef PV_D0
#undef TRRD
}

template <class TIn, class TOut> struct BlockRef { const TIn* Q; const TIn* K; const TIn* V; TOut* O; int P0; };
template <class TIn> struct Seam {
    bf16x8 qr[8];
    bf16x8 st_v0, st_v1, st_k0, st_k1; f32x4 sf0, sf1, sf2, sf3;
    f32x4 tq[16];
};
__device__ __forceinline__ int swa_jlo(int P0, int W) { const int lowk = P0 - W + 1; return lowk > 0 ? lowk / KVBLK : 0; }
#define ROW(p, k0, rr) ((p) + (size_t)((k0) + (rr)) * LDKV + sc)
#define VMW() asm volatile("s_waitcnt vmcnt(0)" ::: "memory")
#define VMWN(n) asm volatile("s_waitcnt vmcnt(%0)" :: "i"(n) : "memory")
#define SLOAD_H(Kp, Vp, k0) do { S.st_v0 = load8<TIn>(ROW(Vp, k0, sr)); S.st_v1 = load8<TIn>(ROW(Vp, k0, 32 + sr));              \
                         S.st_k0 = load8<TIn>(ROW(Kp, k0, sr)); S.st_k1 = load8<TIn>(ROW(Kp, k0, 32 + sr)); } while (0)
#define SWRITE_HK(bf) do { *(bf16x8*)(K_lds + (bf) * SHM_K + kws) = S.st_k0; *(bf16x8*)(K_lds + (bf) * SHM_K + kws + 32 * 256) = S.st_k1; } while (0)
#define SWRITE_HV(bf) do { *(bf16x8*)(V_lds + (bf) * SHM_V + vst0) = S.st_v0; *(bf16x8*)(V_lds + (bf) * SHM_V + vst1) = S.st_v1; } while (0)
#define SWRITE_H(bf) do { SWRITE_HV(bf); SWRITE_HK(bf); } while (0)
#define SLOAD_F(p, k0) do { S.sf0 = *(const f32x4*)ROW(p, k0, sr); S.sf1 = *(const f32x4*)(ROW(p, k0, sr) + 4);                \
                            S.sf2 = *(const f32x4*)ROW(p, k0, 32 + sr); S.sf3 = *(const f32x4*)(ROW(p, k0, 32 + sr) + 4); } while (0)
#define SWRITE_KF(bf) do { *(bf16x8*)(K_lds + (bf) * SHM_K + kws) = pack8(S.sf0, S.sf1); *(bf16x8*)(K_lds + (bf) * SHM_K + kws + 32 * 256) = pack8(S.sf2, S.sf3); } while (0)
#define SWRITE_VF(bf) do { *(bf16x8*)(V_lds + (bf) * SHM_V + vst0) = pack8(S.sf0, S.sf1); *(bf16x8*)(V_lds + (bf) * SHM_V + vst1) = pack8(S.sf2, S.sf3); } while (0)
template <class TIn, class TOut>
__device__ __forceinline__ void causal_swa_prime(const BlockRef<TIn, TOut>& cur, int W, char* lds, Seam<TIn>& S) {
    constexpr bool F32 = same_t<TIn, float>::v;
    int tid_o = threadIdx.x; asm volatile("" : "+v"(tid_o));
    const int tid = tid_o, wid = __builtin_amdgcn_readfirstlane(tid >> 6), lane = tid & 63, r32 = lane & 31, hi = lane >> 5;
    const int sr = tid >> 4, sc = (tid & 15) * 8, kws = KSWZ(sr, sc * 2); char* K_lds = lds + 2 * SHM_V;
    const int kb0 = swa_jlo(cur.P0, W) * KVBLK;
    for (int d0 = 0; d0 < 8; ++d0) S.qr[d0] = load8<TIn>(cur.Q + (size_t)(wid * QBLK + r32) * LDQ + d0 * 16 + hi * 8);
    if constexpr (F32) { SLOAD_F((const float*)cur.K, kb0); VMW(); SWRITE_KF(0); SBAR(); SLOAD_F((const float*)cur.V, kb0); }
    else { SLOAD_H(cur.K, cur.V, kb0); VMW(); SWRITE_HK(0); }
    __syncthreads();
}
template <class TIn, class TOut>
__device__ __forceinline__ void causal_swa_block(const BlockRef<TIn, TOut>& cur, const BlockRef<TIn, TOut>& nxt, int skv, int W, char* lds, Seam<TIn>& S) {
    constexpr bool F32 = same_t<TIn, float>::v;
    int tid_o = threadIdx.x; asm volatile("" : "+v"(tid_o));
    const int tid = tid_o, wid = __builtin_amdgcn_readfirstlane(tid >> 6), lane = tid & 63, r32 = lane & 31, hi = lane >> 5;
    const int j_lo = swa_jlo(cur.P0, W);
    int j_hi = (cur.P0 + QB - 1) / KVBLK + 1; if (j_hi > skv / KVBLK) j_hi = skv / KVBLK;
    const int NT = j_hi - j_lo;
    const int kbn = swa_jlo(nxt.P0, W) * KVBLK;
    const int qlo = cur.P0 + wid * QBLK, qm = qlo + r32 - 4 * hi;
    char* V_lds = lds; char* K_lds = lds + 2 * SHM_V;
    float* ws = (float*)(lds + 2 * SHM_V + 2 * SHM_K) + wid * 64; float* li_l = ws, * al_l = ws + 32;
    float m_reg = -1e30f, l_reg = 0; f32x16 o[4] = {};
    const int sr = tid >> 4, sc = (tid & 15) * 8, vst0 = v_st(sr, sc), vst1 = v_st(32 + sr, sc), kws = KSWZ(sr, sc * 2);
    const int vb0 = (int)(uintptr_t)V_lds + v_rd_base(lane);
    const TIn* Kh = cur.K; const TIn* Vh = cur.V;
#define RESC(a) do { if (__any((a) < 1.f)) { if (hi == 0) al_l[r32] = (a); asm volatile("s_waitcnt lgkmcnt(0)" ::: "memory");              \
                     for (int d_ = 0; d_ < 4; ++d_) for (int r = 0; r < 16; ++r) o[d_][r] *= al_l[crow(r, hi)]; } } while (0)
#define KBASE(t) ((j_lo + (t)) * KVBLK)
#define ACT(t) (KBASE(t) <= qlo + QBLK - 1 && KBASE(t) + KVBLK - 1 >= qlo - W + 1)
#define MASKT(P0_, P1_, t) do { const int kb_ = KBASE(t); if ((!SK || ACT(t)) && (kb_ + KVBLK - 1 > qlo || kb_ <= qlo + QBLK - 1 - W)) mask_tile(P0_, P1_, qm - kb_, (unsigned)W); } while (0)
    constexpr int NQL = F32 ? 16 : 8;
    constexpr bool SK = WSKIP && !F32;
#define SEAM_K0() do { VMWN(NQL); if constexpr (F32) { SWRITE_KF(0); SBAR(); SLOAD_F((const float*)nxt.V, kbn); } else { SWRITE_HK(0); } SBAR(); } while (0)
    f32x16 pA0, pA1, pB0, pB1; float mnA, mnB, alA, alB; bf16x8 pa0, pa1, pa2, pa3;
    if constexpr (F32) { VMW(); SWRITE_VF(0); SBAR(); } else { SWRITE_HV(0); SBAR(); }
    if (NT > 1) { if constexpr (F32) SLOAD_F((const float*)Kh, KBASE(1)); else SLOAD_H(Kh, Vh, KBASE(1)); }
    SBAR(); qkt<0, SK>(pA0, pA1, K_lds, r32, hi, S.qr, ACT(0));
    if constexpr (F32) { if (NT > 1) { VMW(); SWRITE_KF(1); SBAR(); SLOAD_F((const float*)Vh, KBASE(1)); } }
    MASKT(pA0, pA1, 0); partialSM(pA0, pA1, m_reg, mnA, alA);
    if (NT > 1) { VMW(); if constexpr (F32) { SWRITE_VF(1); SBAR(); if (NT > 2) SLOAD_F((const float*)Kh, KBASE(2)); } else SWRITE_H(1); }
    __syncthreads();
#define HALF_STEP(PX0, PX1, mnX, alX, PY0, PY1, alY, t, KB, VB, SB) do {                                                      \
        SBAR(); qkt<KB, SK>(PX0, PX1, K_lds, r32, hi, S.qr, ACT(t));                                             \
        finishSM(PY0, PY1, alY, l_reg, pa0, pa1, pa2, pa3); SBAR();                                                           \
        if ((t) + 1 < NT) { if constexpr (F32) { VMW(); SWRITE_KF(SB); SBAR(); SLOAD_F((const float*)Vh, KBASE((t) + 1)); }  \
                            else { SLOAD_H(Kh, Vh, KBASE((t) + 1)); } SBAR(); }                                               \
        pv_tile<VB, SK>(o, vb0, pa0, pa1, pa2, pa3, ACT((t) - 1)); MASKT(PX0, PX1, (t)); partialSM(PX0, PX1, m_reg, mnX, alX);                                        \
        __syncthreads();                                                                                                      \
        if ((t) + 1 < NT) { VMW(); if constexpr (F32) { SWRITE_VF(SB); SBAR(); if ((t) + 2 < NT) SLOAD_F((const float*)Kh, KBASE((t) + 2)); } \
                            else { SWRITE_H(SB); } }                                                                          \
        RESC(alX); __syncthreads(); } while (0)
    for (int t = 1; t + 1 < NT; t += 2) {
        HALF_STEP(pB0, pB1, mnB, alB, pA0, pA1, alA, t, 1, 0, 0);
        HALF_STEP(pA0, pA1, mnA, alA, pB0, pB1, alB, t + 1, 0, 1, 1);
    }
    const bool even = (NT & 1) == 0;
    if (even) { SBAR(); qkt<1, SK>(pB0, pB1, K_lds, r32, hi, S.qr, ACT(NT - 1)); SBAR(); }
#define QROW(e) (nxt.Q + (size_t)(wid * QBLK + r32) * D + ((e) >> 1) * 16 + hi * 8 + ((e) & 1) * 4)
    if constexpr (F32) { SLOAD_F((const float*)nxt.K, kbn); SBAR();
#pragma unroll
        for (int e = 0; e < 8; ++e) S.tq[e] = *(const f32x4*)QROW(e); }
    else { SLOAD_H(nxt.K, nxt.V, kbn); SBAR();
#pragma unroll
        for (int d0 = 0; d0 < 8; ++d0) S.qr[d0] = load8<TIn>(nxt.Q + (size_t)(wid * QBLK + r32) * LDQ + d0 * 16 + hi * 8); }
    SBAR();
    finishSM(pA0, pA1, alA, l_reg, pa0, pa1, pa2, pa3); SBAR();
    if constexpr (F32) {
#pragma unroll
        for (int e = 8; e < 16; ++e) S.tq[e] = *(const f32x4*)QROW(e); SBAR(); }
#undef QROW
    pv_tile<0, SK>(o, vb0, pa0, pa1, pa2, pa3, ACT(even ? NT - 2 : NT - 1));
    if (even) { MASKT(pB0, pB1, NT - 1); partialSM(pB0, pB1, m_reg, mnB, alB); __syncthreads(); RESC(alB);
        finishSM(pB0, pB1, alB, l_reg, pa0, pa1, pa2, pa3); SBAR(); pv_tile<1, SK>(o, vb0, pa0, pa1, pa2, pa3, ACT(NT - 1)); }
    SBAR(); SEAM_K0();
    if (hi == 0) li_l[r32] = l_reg; asm volatile("s_waitcnt lgkmcnt(0)" ::: "memory");
    float rli[16];
#pragma unroll
    for (int r = 0; r < 16; ++r) rli[r] = __builtin_amdgcn_rcpf(li_l[crow(r, hi)]);
    TOut* Ow = cur.O + (size_t)(wid * QBLK) * LDO;
#pragma unroll
    for (int r = 0; r < 16; ++r) { const int orow = crow(r, hi);
#pragma unroll
        for (int d0 = 0; d0 < 4; ++d0) { const float v = o[d0][r] * rli[r];
            if constexpr (same_t<TOut, float>::v) { Ow[(size_t)orow * LDO + d0 * 32 + r32] = v; }
            else { const float vn = swz<1>(v);
                   if ((r32 & 1) == 0) *(unsigned*)(Ow + (size_t)orow * LDO + d0 * 32 + r32) = cvtpk(v, vn); } } }
    if constexpr (F32) {
#pragma unroll
        for (int d0 = 0; d0 < 8; ++d0) S.qr[d0] = pack8(S.tq[2 * d0], S.tq[2 * d0 + 1]); }
    __syncthreads();
#undef RESC
#undef KBASE
#undef ACT
#undef MASKT
#undef SEAM_K0
#undef HALF_STEP
}
#undef ROW
#undef VMW
#undef VMWN
#undef SLOAD_H
#undef SWRITE_HK
#undef SWRITE_HV
#undef SWRITE_H
#undef SLOAD_F
#undef SWRITE_KF
#undef SWRITE_VF

constexpr int P_QB = 128, SHM_VT = 2 * SHM_V;
constexpr int L_K = 0, L_V = 2 * SHM_K, L_P = L_V + 2 * SHM_VT, L_M = L_P + 2 * NW * 2048, L_WS = L_M + 2 * NW * 256, PAIR_LDS_BYTES = L_WS + NW * 256;
__device__ __forceinline__ void pair_core(const bf16* Qp, const bf16* Kp, const bf16* V0p, const bf16* V1p, int P0, char* lds, f32x16 (&o)[4]) {
    int tid_o = threadIdx.x; asm volatile("" : "+v"(tid_o));
    const int tid = tid_o, wid = __builtin_amdgcn_readfirstlane(tid >> 6), lane = tid & 63, r32 = lane & 31, hi = lane >> 5;
    const int wq = wid & 3, half = wid >> 2;
    const int NT = (P0 + P_QB) / KVBLK;
    const int qlo = P0 + wq * QBLK, qm = qlo + r32 - 4 * hi;
    char* K_lds = lds + L_K; char* V_lds = lds + L_V;
    float* ws = (float*)(lds + L_WS) + wid * 64; float* li_l = ws; float* al_l = ws + 32;
    float* Mmine = (float*)(lds + L_M) + wid * 64 + lane; const float* Mpart = (const float*)(lds + L_M) + (wid ^ 4) * 64 + lane;
    u32x4* Pmine = (u32x4*)(lds + L_P + wid * 2048) + lane; const u32x4* Ppart = (const u32x4*)(lds + L_P + (wid ^ 4) * 2048) + lane;
    const int sr = tid >> 4, sc = (tid & 15) * 8, vst0 = v_st(sr, sc), vst1 = v_st(32 + sr, sc), kws = KSWZ(sr, sc * 2);
    const int vb0 = (int)(uintptr_t)V_lds + half * SHM_V + v_rd_base(lane);
    const unsigned sof0 = (unsigned)(sr * D + sc) * 2u;
    bf16x8 qr[8];
#pragma unroll
    for (int d0 = 0; d0 < 8; ++d0) qr[d0] = load8<bf16>(Qp + (size_t)(wq * QBLK + r32) * D + d0 * 16 + hi * 8);
    const char* kb[4];
#pragma unroll
    for (int dd = 0; dd < 4; ++dd) kb[dd] = K_lds + half * (32 * 256) + KSWZ(r32, (dd * 16 + hi * 8) * 2);
    float m_reg = -1e30f, l_reg = 0.f;
#pragma unroll
    for (int d_ = 0; d_ < 4; ++d_) o[d_] = f32x16{};
    bf16x8 st_k0, st_k1, st_v00, st_v01, st_v10, st_v11;
#define PLOAD(k0) do { st_k0 = load8<bf16>(Kp + (size_t)((k0) + sr) * D + sc); st_k1 = load8<bf16>(Kp + (size_t)((k0) + 32 + sr) * D + sc);            \
                       st_v00 = load8<bf16>(V0p + (size_t)((k0) + sr) * D + sc); st_v01 = load8<bf16>(V0p + (size_t)((k0) + 32 + sr) * D + sc);        \
                       st_v10 = load8<bf16>(V1p + (size_t)((k0) + sr) * D + sc); st_v11 = load8<bf16>(V1p + (size_t)((k0) + 32 + sr) * D + sc); } while (0)
#define PWRITE(bf) do { *(bf16x8*)(K_lds + (bf) * SHM_K + kws) = st_k0; *(bf16x8*)(K_lds + (bf) * SHM_K + kws + 32 * 256) = st_k1;                       \
                        *(bf16x8*)(V_lds + (bf) * SHM_VT + vst0) = st_v00; *(bf16x8*)(V_lds + (bf) * SHM_VT + vst1) = st_v01;                             \
                        *(bf16x8*)(V_lds + (bf) * SHM_VT + SHM_V + vst0) = st_v10; *(bf16x8*)(V_lds + (bf) * SHM_VT + SHM_V + vst1) = st_v11; } while (0)
#define PTRRD(dst, base, off) asm volatile("ds_read_b64_tr_b16 %0, %1 offset:%2" : "=&v"(dst) : "v"(base), "i"(off) : "memory")
#define PPV_D0(d0) do { s16x4 l0, l1, l2, l3, h0, h1, h2, h3; constexpr int b_ = v_rd_off(d0, 0, 0);                                                        \
        PTRRD(l0, vbo, b_); PTRRD(h0, vbo, b_ + 2048); PTRRD(l1, vbo, b_ + 4096); PTRRD(h1, vbo, b_ + 6144); PTRRD(l2, vbp, b_); PTRRD(h2, vbp, b_ + 2048); PTRRD(l3, vbp, b_ + 4096); PTRRD(h3, vbp, b_ + 6144); \
        asm volatile("s_waitcnt lgkmcnt(0)" ::: "memory"); SBAR(); __builtin_amdgcn_s_setprio(1);                                                             \
        o[d0] = __builtin_amdgcn_mfma_f32_32x32x16_bf16(own0_, (bf16x8){l0[0], l0[1], l0[2], l0[3], h0[0], h0[1], h0[2], h0[3]}, o[d0], 0, 0, 0);             \
        o[d0] = __builtin_amdgcn_mfma_f32_32x32x16_bf16(own1_, (bf16x8){l1[0], l1[1], l1[2], l1[3], h1[0], h1[1], h1[2], h1[3]}, o[d0], 0, 0, 0);             \
        o[d0] = __builtin_amdgcn_mfma_f32_32x32x16_bf16(pt0, (bf16x8){l2[0], l2[1], l2[2], l2[3], h2[0], h2[1], h2[2], h2[3]}, o[d0], 0, 0, 0);               \
        o[d0] = __builtin_amdgcn_mfma_f32_32x32x16_bf16(pt1, (bf16x8){l3[0], l3[1], l3[2], l3[3], h3[0], h3[1], h3[2], h3[3]}, o[d0], 0, 0, 0); __builtin_amdgcn_s_setprio(0); } while (0)
#define PPV(vbuf, own0, own1) do { const u32x4 q0_ = Ppart[(vbuf) * 1024], q1_ = Ppart[(vbuf) * 1024 + 64];     const bf16x8 pt0 = __builtin_bit_cast(bf16x8, q0_), pt1 = __builtin_bit_cast(bf16x8, q1_), own0_ = own0, own1_ = own1;   \
        const int vbo = vb0 + (vbuf) * SHM_VT + half * 8192, vbp = vb0 + (vbuf) * SHM_VT + (half ^ 1) * 8192; PPV_D0(0); PPV_D0(1); PPV_D0(2); PPV_D0(3); } while (0)
    constexpr float C2 = 1.4426950408889634f * SCALE;
#define PBAR() asm volatile("s_waitcnt lgkmcnt(0)\n\ts_barrier" ::: "memory")
#define PLOADK(k0) do { const char* kt_ = (const char*)Kp + (size_t)(k0) * (D * 2); st_k0 = *(const bf16x8*)(kt_ + sof0); st_k1 = *(const bf16x8*)(kt_ + 32 * D * 2 + sof0); } while (0)
#define PLOADV(k0) do { const char* v0_ = (const char*)V0p + (size_t)(k0) * (D * 2); const char* v1_ = (const char*)V1p + (size_t)(k0) * (D * 2);                          \
                        st_v00 = *(const bf16x8*)(v0_ + sof0); st_v01 = *(const bf16x8*)(v0_ + 32 * D * 2 + sof0); st_v10 = *(const bf16x8*)(v1_ + sof0); st_v11 = *(const bf16x8*)(v1_ + 32 * D * 2 + sof0); } while (0)
#define PWRITEK(bf) do { *(bf16x8*)(K_lds + (bf) * SHM_K + kws) = st_k0; *(bf16x8*)(K_lds + (bf) * SHM_K + kws + 32 * 256) = st_k1; } while (0)
#define PWRITEV(bf) do { *(bf16x8*)(V_lds + (bf) * SHM_VT + vst0) = st_v00; *(bf16x8*)(V_lds + (bf) * SHM_VT + vst1) = st_v01;                            \
                         *(bf16x8*)(V_lds + (bf) * SHM_VT + SHM_V + vst0) = st_v10; *(bf16x8*)(V_lds + (bf) * SHM_VT + SHM_V + vst1) = st_v11; } while (0)
#define PQKT(P, bf) do { P = f32x16{}; bf16x8 kf_[8];                                                                                                     \
        _Pragma("unroll") for (int d0 = 0; d0 < 8; ++d0) kf_[d0] = *reinterpret_cast<const bf16x8*>(kb[d0 & 3] + (d0 >> 2) * 128 + (bf) * SHM_K);            \
        __builtin_amdgcn_s_setprio(1);                                                                                                                  \
        _Pragma("unroll") for (int d0 = 0; d0 < 8; ++d0) P = __builtin_amdgcn_mfma_f32_32x32x16_bf16(kf_[d0], qr[d0], P, 0, 0, 0);                          \
        __builtin_amdgcn_s_setprio(0); } while (0)
#define PMAX(P, t, LM) do { const int kb_ = (t) * KVBLK + half * 32;                                                                                      \
        if (kb_ + 31 > qlo) { const float NEG = -__builtin_inff(); const int dq = qm - kb_;                                                              \
            _Pragma("unroll") for (int r = 0; r < 16; ++r) { const int c = (r & 3) + 8 * (r >> 2); if (dq - c < 0) P[r] = NEG; } }                       \
        LM = fmaxf(fmaxf(P[0], P[1]), P[2]); _Pragma("unroll") for (int r = 3; r < 15; r += 2) LM = fmaxf(fmaxf(LM, P[r]), P[r + 1]); LM = fmaxf(LM, P[15]);                                                                       \
        { auto rr = __builtin_amdgcn_permlane32_swap(__float_as_uint(LM), __float_as_uint(LM), false, false); LM = fmaxf(__uint_as_float(rr[0]), __uint_as_float(rr[1])); } \
        Mmine[((t) & 1) * (NW * 64)] = LM; } while (0)
#define PPK4(P, B_, OUT) do { unsigned a0 = cvtpk(P[B_ + 0], P[B_ + 1]), a1 = cvtpk(P[B_ + 2], P[B_ + 3]), b0 = cvtpk(P[B_ + 4], P[B_ + 5]), b1 = cvtpk(P[B_ + 6], P[B_ + 7]);  \
        auto r0 = __builtin_amdgcn_permlane32_swap(a0, b0, false, false); auto r1 = __builtin_amdgcn_permlane32_swap(a1, b1, false, false);                  \
        u32x4 w = {r0[0], r1[0], r0[1], r1[1]}; OUT = *reinterpret_cast<bf16x8*>(&w); } while (0)
#define PSOFT(P, tt, LM, AL) do { const float pmax = fmaxf(LM, Mpart[((tt) & 1) * (NW * 64)]);                                                           \
        const bool defer = __all((pmax - m_reg) * SCALE <= THR); const float mn = defer ? m_reg : fmaxf(m_reg, pmax);                                    \
        AL = __builtin_amdgcn_exp2f((m_reg - mn) * C2); m_reg = mn; const float mnL = -mn * C2;                                                          \
        _Pragma("unroll") for (int r = 0; r < 16; ++r) P[r] = __builtin_amdgcn_exp2f(fmaf(P[r], C2, mnL));                                               \
        float ps = 0.f; _Pragma("unroll") for (int r = 0; r < 16; ++r) ps += P[r];                                                                        \
        { auto rr = __builtin_amdgcn_permlane32_swap(__float_as_uint(ps), __float_as_uint(ps), false, false); ps = __uint_as_float(rr[0]) + __uint_as_float(rr[1]); } \
        l_reg = l_reg * AL + ps; PPK4(P, 0, pa_o0); PPK4(P, 8, pa_o1);                                                                                    \
        Pmine[((tt) & 1) * 1024] = __builtin_bit_cast(u32x4, pa_o0); Pmine[((tt) & 1) * 1024 + 64] = __builtin_bit_cast(u32x4, pa_o1); } while (0)
#define PRESC(AL) do { if (__any((AL) < 1.f)) { if (hi == 0) al_l[r32] = (AL); asm volatile("s_waitcnt lgkmcnt(0)" ::: "memory");                       \
        _Pragma("unroll") for (int d_ = 0; d_ < 4; ++d_) _Pragma("unroll") for (int r = 0; r < 16; ++r) o[d_][r] *= al_l[crow(r, hi)]; } } while (0)
    bf16x8 pa_o0 = {}, pa_o1 = {};
    f32x16 p_old, p_new; float lm_old, lm_new, alpha;
    PLOADK(0); PWRITEK(0);
    PLOADK(KVBLK);
    {
        const u32x4 z4 = {0u, 0u, 0u, 0u};
#pragma unroll
        for (int i = 0; i < 4; ++i) *(u32x4*)(V_lds + SHM_VT + tid * 16 + i * 8192) = z4;
        Pmine[1024] = z4; Pmine[1024 + 64] = z4;
    }
    PBAR();
    PWRITEK(1); PLOADK((NT > 2 ? 2 : NT - 1) * KVBLK); PLOADV(0);
    PQKT(p_old, 0); PMAX(p_old, 0, lm_old);
    PBAR();
#define PEXP(P, r0) do { _Pragma("unroll") for (int r = (r0); r < (r0) + 8; ++r) P[r] = __builtin_amdgcn_exp2f(fmaf(P[r], C2, mnL_)); } while (0)
#define PSTEP(PO, LMO, PN, LMN, t_, LAST) do { const int bf = (t_) & 1; const int tn = ((t_) + 2 < NT) ? (t_) + 2 : NT - 1;                                     \
        const u32x4 q0_ = Ppart[bf * 1024], q1_ = Ppart[bf * 1024 + 64]; const bf16x8 pt0 = __builtin_bit_cast(bf16x8, q0_), pt1 = __builtin_bit_cast(bf16x8, q1_), own0_ = pa_o0, own1_ = pa_o1;   \
        const int vbo = vb0 + bf * SHM_VT + half * 8192, vbp = vb0 + bf * SHM_VT + (half ^ 1) * 8192;                              \
        PWRITEV(bf ^ 1);                                                                                                                                     \
        if (!(LAST)) { PWRITEK(bf ^ 1); PLOADK(tn * KVBLK); PLOADV((t_) * KVBLK); }                                                                           \
        PPV_D0(0);                                                                                                                                           \
        const float pmax_ = fmaxf(LMO, Mpart[(((t_) - 1) & 1) * (NW * 64)]);                                                                                  \
        const bool defer_ = __all((pmax_ - m_reg) * SCALE <= THR); const float mn_ = defer_ ? m_reg : fmaxf(m_reg, pmax_);                                    \
        alpha = __builtin_amdgcn_exp2f((m_reg - mn_) * C2); m_reg = mn_; const float mnL_ = -mn_ * C2;                                                        \
        PEXP(PO, 0);                                                                                                                                         \
        PPV_D0(1);                                                                                                                                           \
        PEXP(PO, 8);                                                                                                                                         \
        PPV_D0(2);                                                                                                                                           \
        { float ps = 0.f; _Pragma("unroll") for (int r = 0; r < 16; ++r) ps += PO[r];                                                                         \
          auto rr = __builtin_amdgcn_permlane32_swap(__float_as_uint(ps), __float_as_uint(ps), false, false); ps = __uint_as_float(rr[0]) + __uint_as_float(rr[1]); l_reg = l_reg * alpha + ps; } \
        PPV_D0(3);                                                                                                                                           \
        if (!(LAST)) { PQKT(PN, bf); }                                                                                                                        \
        PPK4(PO, 0, pa_o0); PPK4(PO, 8, pa_o1);                                                                                                               \
        Pmine[(bf ^ 1) * 1024] = __builtin_bit_cast(u32x4, pa_o0); Pmine[(bf ^ 1) * 1024 + 64] = __builtin_bit_cast(u32x4, pa_o1);            \
        if (!(LAST)) { PMAX(PN, (t_), LMN); }                                                                                                                 \
        PRESC(alpha);                                                                                                                                        \
        PBAR(); } while (0)
    for (int t = 1; t < NT; t += 2) { PSTEP(p_old, lm_old, p_new, lm_new, t, false); PSTEP(p_new, lm_new, p_old, lm_old, t + 1, (t + 1 == NT)); }
    { PPV((NT - 1) & 1, pa_o0, pa_o1); }
    *Mmine = l_reg;
    PBAR();
    const float l_tot = l_reg + *Mpart;
    if (hi == 0) li_l[r32] = l_tot; asm volatile("s_waitcnt lgkmcnt(0)" ::: "memory");
    float rli[16];
#pragma unroll
    for (int r = 0; r < 16; ++r) rli[r] = __builtin_amdgcn_rcpf(li_l[crow(r, hi)]);
#pragma unroll
    for (int r = 0; r < 16; ++r)
#pragma unroll
        for (int d0 = 0; d0 < 4; ++d0) o[d0][r] *= rli[r];
    PBAR();
#undef PLOAD
#undef PWRITE
#undef PTRRD
#undef PPV_D0
#undef PPV
#undef PPK4
#undef PBAR
#undef PSTEP
#undef PEXP
#undef PLOADK
#undef PLOADV
#undef PWRITEK
#undef PWRITEV
#undef PQKT
#undef PMAX
#undef PSOFT
#undef PRESC
}

__device__ __forceinline__ void diff_block(const bf16* Qp, const bf16* Kp, const bf16* V0p, const bf16* V1p, int P0, char* lds, float lam, float oscale, const float* gain, unsigned short* mixrow0, int plane, u32x4* park) {
    f32x16 o[4];
    for (int mp = 0; mp < 2; ++mp) {
        pair_core(Qp + (size_t)mp * plane, Kp + (size_t)mp * plane, V0p, V1p, P0, lds, o);
        if (mp == 0) { int t2 = threadIdx.x; asm volatile("" : "+v"(t2)); u32x4* pk = park + (t2 >> 6) * 512 + (t2 & 63);
#pragma unroll
            for (int d0 = 0; d0 < 4; ++d0)
#pragma unroll
                for (int j4 = 0; j4 < 2; ++j4) { u32x4 w; w.x = cvtpk(o[d0][8 * j4], o[d0][8 * j4 + 1]); w.y = cvtpk(o[d0][8 * j4 + 2], o[d0][8 * j4 + 3]); w.z = cvtpk(o[d0][8 * j4 + 4], o[d0][8 * j4 + 5]); w.w = cvtpk(o[d0][8 * j4 + 6], o[d0][8 * j4 + 7]);
                    pk[(d0 * 2 + j4) * 64] = w; }
        }
    }
    int tid_o = threadIdx.x; asm volatile("" : "+v"(tid_o));
    const int tid = tid_o, wid = __builtin_amdgcn_readfirstlane(tid >> 6), lane = tid & 63, r32 = lane & 31, hi = lane >> 5, wq = wid & 3, half = wid >> 2;
    unsigned op[4][8];
    { const u32x4* pk = park + wid * 512 + lane;
#pragma unroll
        for (int d0 = 0; d0 < 4; ++d0)
#pragma unroll
            for (int j4 = 0; j4 < 2; ++j4) { const u32x4 w = pk[(d0 * 2 + j4) * 64]; op[d0][4 * j4] = w.x; op[d0][4 * j4 + 1] = w.y; op[d0][4 * j4 + 2] = w.z; op[d0][4 * j4 + 3] = w.w; } }
    float q[16];
#pragma unroll
    for (int r = 0; r < 16; ++r) { q[r] = 0.f;
#pragma unroll
        for (int d0 = 0; d0 < 4; ++d0) { const unsigned w = op[d0][r >> 1]; const float a = (r & 1) ? __uint_as_float(w & 0xffff0000u) : __uint_as_float(w << 16);
            const float d = a - lam * o[d0][r]; o[d0][r] = d; q[r] += d * d; } }
#pragma unroll
    for (int r = 0; r < 16; ++r) { q[r] += swz<1>(q[r]); q[r] += swz<2>(q[r]); q[r] += swz<4>(q[r]); q[r] += swz<8>(q[r]); q[r] += swz<16>(q[r]); }
    float* X = (float*)(lds + L_M) + wid * 64; const float* Xp = (const float*)(lds + L_M) + (wid ^ 4) * 64;
    if (r32 == 0) {
#pragma unroll
        for (int r = 0; r < 16; ++r) X[crow(r, hi)] = q[r];
    }
    asm volatile("s_waitcnt lgkmcnt(0)\n\ts_barrier" ::: "memory");
    float g[4];
#pragma unroll
    for (int d0 = 0; d0 < 4; ++d0) g[d0] = gain[half * 128 + d0 * 32 + r32];
    unsigned short* orow = mixrow0 + (size_t)(wq * QBLK) * 2048 + half * 128;
#pragma unroll
    for (int r = 0; r < 16; ++r) { const int rw = crow(r, hi); const float ss = q[r] + Xp[rw]; const float rs = oscale / sqrtf(ss * (1.0f / 256.0f) + 1e-6f);
#pragma unroll
        for (int d0 = 0; d0 < 4; ++d0) { const float v = o[d0][r] * rs * g[d0];
            orow[(size_t)rw * 2048 + d0 * 32 + r32] = (unsigned short)cvtpk(v, v); } }
    asm volatile("s_waitcnt lgkmcnt(0)\n\ts_barrier" ::: "memory");
}
}
constexpr int BATCH = 8, SEQ = 4096, DM = 2048, DEPTH = 2, M = BATCH * SEQ;
constexpr int NZ = 5632, DFF = 5632;
constexpr float RMS_EPS = 1e-6f, LN_EPS = 1e-5f;
constexpr int NWAVES = 8;
#ifndef MK_PER_PHASE
#define MK_PER_PHASE 0
#endif
constexpr int LPH = 6;
constexpr int N_PHASES = 2 + LPH * DEPTH;
#ifndef REP_P0
#define REP_P0 1
#endif
#ifndef REP_GEMM
#define REP_GEMM 1
#endif
#ifndef REP_THIN
#define REP_THIN 1
#endif
#ifndef REP_MIX
#define REP_MIX 1
#endif
#ifndef REP_ATT
#define REP_ATT 1
#endif
constexpr size_t MiB = 1u << 20;
constexpr size_t WS_ROPE = 1 * MiB;
constexpr size_t WS_W = 17 * MiB, W_LAYER = 96 * MiB;
constexpr size_t WO_IN = 0, WO_OUT = 22 * MiB, WO_GU = 30 * MiB, WO_DOWN = 74 * MiB;
constexpr size_t WS_Z = 210 * MiB;
constexpr size_t WS_H = 562 * MiB;
constexpr size_t WS_MIX = 690 * MiB;
constexpr size_t WS_V = 818 * MiB;
constexpr size_t WS_O = 882 * MiB;
constexpr size_t WS_END = 1015 * MiB;
constexpr int LDS_BYTES = 143424;

#define LAS __attribute__((address_space(3)))
typedef unsigned short bf16;
typedef unsigned v4u __attribute__((ext_vector_type(4)));
typedef unsigned v2u __attribute__((ext_vector_type(2)));
typedef float f32x4 __attribute__((ext_vector_type(4)));
typedef short bf16x8 __attribute__((ext_vector_type(8)));
#define LDS_WAIT() asm volatile("s_waitcnt lgkmcnt(0)" ::: "memory")
__device__ __forceinline__ unsigned f2bf(float f) { unsigned u = __builtin_bit_cast(unsigned, f); return (u + 0x7fffu + ((u >> 16) & 1u)) >> 16; }
__device__ __forceinline__ unsigned pk2(float lo, float hi) { return f2bf(lo) | (f2bf(hi) << 16); }
__device__ __forceinline__ float bflo(unsigned w) { return __uint_as_float(w << 16); }
__device__ __forceinline__ float bfhi(unsigned w) { return __uint_as_float(w & 0xffff0000u); }
__device__ __forceinline__ void unpack8(const v4u w, float* f) { f[0] = bflo(w.x); f[1] = bfhi(w.x); f[2] = bflo(w.y); f[3] = bfhi(w.y); f[4] = bflo(w.z); f[5] = bfhi(w.z); f[6] = bflo(w.w); f[7] = bfhi(w.w); }
__device__ __forceinline__ v4u pack8f(const float* f) { v4u w; w.x = pk2(f[0], f[1]); w.y = pk2(f[2], f[3]); w.z = pk2(f[4], f[5]); w.w = pk2(f[6], f[7]); return w; }
__device__ __forceinline__ float wave_sum(float v) { v += swz<1>(v); v += swz<2>(v); v += swz<4>(v); v += swz<8>(v); v += swz<16>(v); return sum32(v); }
__device__ __forceinline__ float gelu_exact(float v) {
    const float av = fabsf(v), t = __builtin_amdgcn_rcpf(av * 0.2316418882f + 1.0f);
    float q = t * 0.5307027145f + (-0.7265760135f); q = q * t + 0.7107068705f; q = q * t + (-0.142248368f); q = q * t + 0.127414796f; q = q * t;
    const float e = __builtin_amdgcn_exp2f((v * v) * (-0.72134752044f));
    const float m = v * (q * e);
    return v < 0.f ? m : v - m;
}

__device__ __forceinline__ void transpose_item(const float* W, int K, int N, bf16* WT, int k0, int n0, int drow0, const float* gain, LAS float* scr, int lane) {
    float wv[32];
    const float* wp = W + (size_t)(k0 + (lane >> 5)) * N + n0 + (lane & 31);
#pragma unroll
    for (int i = 0; i < 32; ++i) wv[i] = wp[(size_t)(2 * i) * N];
    if (gain) {
#pragma unroll
        for (int i = 0; i < 32; ++i) wv[i] *= gain[k0 + 2 * i + (lane >> 5)];
    }
#pragma unroll
    for (int i = 0; i < 32; ++i) scr[(2 * i + (lane >> 5)) * 33 + (lane & 31)] = wv[i];
    LDS_WAIT(); asm volatile("" ::: "memory");
    const int c = lane & 7;
#pragma unroll
    for (int j = 0; j < 4; ++j) { const int n = (lane >> 3) + 8 * j; const LAS float* s = scr + (8 * c) * 33 + n;
        v4u o; o.x = pk2(s[0 * 33], s[1 * 33]); o.y = pk2(s[2 * 33], s[3 * 33]); o.z = pk2(s[4 * 33], s[5 * 33]); o.w = pk2(s[6 * 33], s[7 * 33]);
        *(v4u*)(WT + (size_t)(drow0 + n) * K + k0 + 8 * c) = o; }
    LDS_WAIT(); asm volatile("" ::: "memory");
}
__device__ __forceinline__ void x_row_to_bf16(const float* xrow, bf16* orow, float* ssq, int lane) {
    const f32x4* xr = (const f32x4*)xrow + lane; f32x4 v[8]; float s = 0.f;
#pragma unroll
    for (int j = 0; j < 8; ++j) { v[j] = xr[64 * j]; s += (v[j].x * v[j].x + v[j].y * v[j].y) + (v[j].z * v[j].z + v[j].w * v[j].w); }
    s = wave_sum(s);
#pragma unroll
    for (int j = 0; j < 8; ++j) { v2u w; w.x = pk2(v[j].x, v[j].y); w.y = pk2(v[j].z, v[j].w); ((v2u*)orow + lane)[64 * j] = w; }
    if (lane < 8) ssq[lane] = lane == 0 ? s : 0.f;
}
__device__ __forceinline__ void final_row(const bf16* xrow, float ssq, const float* g, float* orow, int lane) {
    const float rstd = 1.0f / sqrtf(ssq * (1.0f / DM) + RMS_EPS);
#pragma unroll
    for (int j = 0; j < 4; ++j) { const int c = 8 * lane + 512 * j; float x[8]; unpack8(*(const v4u*)(xrow + c), x);
        const f32x4 g0 = *(const f32x4*)(g + c), g1 = *(const f32x4*)(g + c + 4);
        *(f32x4*)(orow + c) = (f32x4){x[0] * rstd * g0[0], x[1] * rstd * g0[1], x[2] * rstd * g0[2], x[3] * rstd * g0[3]};
        *(f32x4*)(orow + c + 4) = (f32x4){x[4] * rstd * g1[0], x[5] * rstd * g1[1], x[6] * rstd * g1[2], x[7] * rstd * g1[3]}; }
}
typedef __attribute__((address_space(1))) unsigned gu32;
constexpr size_t WS_CTL = 0, CTL_ZERO_BYTES = 65536; constexpr int CW_BAR = 4096;
constexpr size_t WS_SSQ = 1010 * MiB;
constexpr int MISC_OFF = 139264, PSTAT_OFF = MISC_OFF + 64;
#define XB_TMO      128
#define XB_XCNT(j)  (256  + 64 * (j))
#define XB_XSUB(j)  (1280 + 64 * (j))
#define XB_XGEN(j)  (2304 + 64 * (j))
#define XB_TOP      3328
#define XB_TOPGEN   3392
#define XCD_BAR_WORDS 3456
#define XB_SPIN_CAP (1u << 18)

__device__ __forceinline__ unsigned xb_ld(unsigned* p)              { return __hip_atomic_load(p, __ATOMIC_RELAXED, __HIP_MEMORY_SCOPE_AGENT); }
__device__ __forceinline__ unsigned xb_add(unsigned* p, unsigned v) { return __hip_atomic_fetch_add(p, v, __ATOMIC_RELAXED, __HIP_MEMORY_SCOPE_AGENT); }
__device__ __forceinline__ unsigned xb_xcc_id() { return (unsigned)__builtin_amdgcn_s_getreg((3 << 11) | 20) & 0xFu; }
#define XB_SPIN(cond, bar) do { unsigned _sp = 0; while (cond) { __builtin_amdgcn_s_sleep(1); \
    if ((++_sp & 255u) == 0u) { if (xb_ld(&(bar)[XB_TMO])) break; if (_sp > XB_SPIN_CAP) { atomicAdd(&(bar)[XB_TMO], 1u); break; } } } } while (0)

struct XcdBarrier {
    unsigned* bar; unsigned x;
    volatile LAS unsigned* st;
};

__device__ __forceinline__ XcdBarrier xcd_barrier_post(unsigned* bar, volatile LAS unsigned* st) {
    XcdBarrier b; b.bar = bar; b.x = xb_xcc_id(); b.st = st;
    if (threadIdx.x == 0) (void)xb_add(&bar[XB_XCNT(b.x)], 1u);
    return b;
}
__device__ __forceinline__ void xcd_barrier_complete(unsigned* bar, unsigned x, unsigned& nloc, unsigned& nx) {
    const unsigned G = gridDim.x * gridDim.y * gridDim.z;
    unsigned sum, cnt, mine, sp = 0u;
    for (;;) {
        sum = 0u; cnt = 0u; mine = 0u;
#pragma unroll
        for (unsigned j = 0; j < 16; ++j) { const unsigned c = xb_ld(&bar[XB_XCNT(j)]); sum += c; cnt += (c > 0u) ? 1u : 0u; mine = (j == x) ? c : mine; }
        if (sum == G) break;
        __builtin_amdgcn_s_sleep(1);
        if ((++sp & 255u) == 0u) { if (xb_ld(&bar[XB_TMO])) break; if (sp > XB_SPIN_CAP) { atomicAdd(&bar[XB_TMO], 1u); break; } }
    }
    nloc = mine > 0u ? mine : 1u; nx = cnt > 0u ? cnt : 1u;
}

__device__ __forceinline__ void xcd_barrier(const XcdBarrier& b) {
    asm volatile("s_waitcnt vmcnt(0)" ::: "memory");
    __syncthreads();
    if (threadIdx.x == 0) {
        unsigned* bar = b.bar;
        __builtin_amdgcn_s_waitcnt(0);
        unsigned nloc = b.st[0], nx = b.st[1];
        if (nloc == 0u) { xcd_barrier_complete(bar, b.x, nloc, nx); b.st[0] = nloc; b.st[1] = nx; }
        const unsigned old = xb_add(&bar[XB_XSUB(b.x)], 1u);
        const unsigned gen = old / nloc;
        if (old + 1u == (gen + 1u) * nloc) {
            __builtin_amdgcn_fence(__ATOMIC_RELEASE, "agent");
            asm volatile("s_waitcnt vmcnt(0)" ::: "memory");
            const unsigned og = xb_add(&bar[XB_TOP], 1u);
            const unsigned tg = og / nx;
            if (og + 1u == (tg + 1u) * nx) xb_add(&bar[XB_TOPGEN], 1u);
            else XB_SPIN(xb_ld(&bar[XB_TOPGEN]) == tg, bar);
            __builtin_amdgcn_fence(__ATOMIC_ACQUIRE, "agent");
            xb_add(&bar[XB_XGEN(b.x)], 1u);
            asm volatile("s_waitcnt vmcnt(0)" ::: "memory");
        } else {
            XB_SPIN(xb_ld(&bar[XB_XGEN(b.x)]) == gen, bar);
            __builtin_amdgcn_fence(__ATOMIC_ACQUIRE, "agent");
            asm volatile("s_waitcnt vmcnt(0)" ::: "memory");
        }
    }
    __syncthreads();
}
struct Args { const void* in[20]; float* out; unsigned char* ws; int ph_lo, ph_hi; };

__device__ __forceinline__ void gmlp_unit(int unit, const bf16* z, bf16* mix, const float* ln_g, const float* ln_b, const float* wsp, const float* bsp, const float* mixn,
                                          LAS unsigned char* lds, int tid, int lane, int wave) {
    const int g = unit & 3, n = (unit >> 2) & 31, b = unit >> 7;
    const size_t row0 = (size_t)b * SEQ + (size_t)n * 128;
    LAS unsigned short* vnT = (LAS unsigned short*)lds;
    {
        const int s = tid >> 2, cq = tid & 3;
        const bf16* src = z + (row0 + s) * NZ + 512 + g * 128 + cq * 32;
        float v[32]; float sum = 0.f;
#pragma unroll
        for (int i = 0; i < 4; ++i) { const v4u w = *(const v4u*)(src + i * 8); unpack8(w, v + i * 8); }
#pragma unroll
        for (int i = 0; i < 32; ++i) { v[i] = gelu_exact(v[i]); sum += v[i]; }
        sum += swz<1>(sum); sum += swz<2>(sum);
        const float mu = sum * (1.0f / 128.0f); float q = 0.f;
#pragma unroll
        for (int i = 0; i < 32; ++i) { v[i] -= mu; q += v[i] * v[i]; }
        q += swz<1>(q); q += swz<2>(q);
        const float rstd = 1.0f / sqrtf(q * (1.0f / 128.0f) + LN_EPS);
        const float* gp = ln_g + g * 128 + cq * 32; const float* bp = ln_b + g * 128 + cq * 32;
#pragma unroll
        for (int i = 0; i < 8; ++i) { const f32x4 gg = *(const f32x4*)(gp + 4 * i), bb = *(const f32x4*)(bp + 4 * i);
#pragma unroll
            for (int e = 0; e < 4; ++e) { const float vn = v[4 * i + e] * rstd * gg[e] + bb[e]; vnT[(cq * 32 + 4 * i + e) * 136 + s] = (unsigned short)f2bf(vn); } }
    }
    __syncthreads();
    {
        const int tcol = lane & 15, quad = lane >> 4, t = 16 * wave + tcol, nks = (wave >> 1) + 1;
        f32x4 acc[8];
#pragma unroll
        for (int ct = 0; ct < 8; ++ct) acc[ct] = (f32x4){0.f, 0.f, 0.f, 0.f};
        const float* wrow = wsp + ((size_t)g * 128 + t) * 128;
        for (int ks = 0; ks < nks; ++ks) {
            const int s0 = 32 * ks + 8 * quad;
            const f32x4 w0 = *(const f32x4*)(wrow + s0), w1 = *(const f32x4*)(wrow + s0 + 4);
            float wf[8] = {w0[0], w0[1], w0[2], w0[3], w1[0], w1[1], w1[2], w1[3]};
#pragma unroll
            for (int e = 0; e < 8; ++e) if (s0 + e > t) wf[e] = 0.f;
            const v4u bw = pack8f(wf); const bf16x8 bfrag = __builtin_bit_cast(bf16x8, bw);
#pragma unroll
            for (int ct = 0; ct < 8; ++ct) { const bf16x8 a = *(const LAS bf16x8*)(vnT + (16 * ct + tcol) * 136 + s0);
                acc[ct] = __builtin_amdgcn_mfma_f32_16x16x32_bf16(a, bfrag, acc[ct], 0, 0, 0); }
        }
        const float bst = bsp[g * 128 + t];
        const size_t m = row0 + t; const bf16* up = z + m * NZ + g * 128 + 4 * quad; float ss = 0.f;
#pragma unroll
        for (int ct = 0; ct < 8; ++ct) { const v2u uw = *(const v2u*)(up + 16 * ct);
            const float u0 = gelu_exact(bflo(uw.x)), u1 = gelu_exact(bfhi(uw.x)), u2 = gelu_exact(bflo(uw.y)), u3 = gelu_exact(bfhi(uw.y));
            acc[ct][0] = u0 * (acc[ct][0] + bst); acc[ct][1] = u1 * (acc[ct][1] + bst); acc[ct][2] = u2 * (acc[ct][2] + bst); acc[ct][3] = u3 * (acc[ct][3] + bst);
            ss += (acc[ct][0] * acc[ct][0] + acc[ct][1] * acc[ct][1]) + (acc[ct][2] * acc[ct][2] + acc[ct][3] * acc[ct][3]); }
        ss += swz<16>(ss); ss = sum32(ss);
        const float r = 1.0f / sqrtf(ss * (1.0f / 128.0f) + RMS_EPS);
        bf16* op = mix + m * DM + g * 128 + 4 * quad; const float* np = mixn + g * 128 + 4 * quad;
        f32x4 gnv[8];
#pragma unroll
        for (int ct = 0; ct < 8; ++ct) gnv[ct] = *(const f32x4*)(np + 16 * ct);
#pragma unroll
        for (int ct = 0; ct < 8; ++ct) { const f32x4 gn = gnv[ct]; v2u w;
            w.x = pk2(acc[ct][0] * r * gn[0], acc[ct][1] * r * gn[1]); w.y = pk2(acc[ct][2] * r * gn[2], acc[ct][3] * r * gn[3]); *(v2u*)(op + 16 * ct) = w; }
    }
    __syncthreads();
}

#define OPQ_V(x) asm volatile("" : "+v"(x))
__global__ void __launch_bounds__(NWAVES * 64, 2) hymba_fwd(Args args) {
    extern __shared__ __attribute__((aligned(16))) unsigned char lds[];
    {
        if (threadIdx.x < 32) ((LAS unsigned*)((LAS unsigned char*)lds + MISC_OFF))[threadIdx.x] = 0u;
        __syncthreads();
        (void)xcd_barrier_post((unsigned*)(args.ws + WS_CTL) + CW_BAR, (volatile LAS unsigned*)((LAS unsigned char*)lds + MISC_OFF));
    }
    if (args.ph_lo == 0) {
        const int p = 0;
        LAS unsigned char* ldsp = (LAS unsigned char*)lds;
        int tid = threadIdx.x; OPQ_V(tid);
        const int lane = tid & 63, wave = __builtin_amdgcn_readfirstlane(tid >> 6);
        int zs = 0; asm volatile("" : "+s"(zs));
        const int G = gridDim.x + zs, bx = blockIdx.x + zs, vcu = (G % 8 == 0) ? (bx % 8) * (G / 8) + bx / 8 : bx;
        const int gw = vcu * NWAVES + wave, NGW = G * NWAVES;
        unsigned char* ws = args.ws;
        float* xo = args.out;
        bf16* Z = (bf16*)(ws + WS_Z); bf16* Hb = (bf16*)(ws + WS_H); bf16* MIX = (bf16*)(ws + WS_MIX); bf16* VB = (bf16*)(ws + WS_V); bf16* OB = (bf16*)(ws + WS_O);
        float* ctab = (float*)(ws + WS_ROPE); float* stab = ctab + (size_t)M * 64;
        const bool fin = (p == N_PHASES - 1); const int l = fin ? 0 : (p - 1) / LPH, kk = (p - 1) % LPH, k = fin ? 7 : (p == 0) ? -1 : (kk <= 2 ? kk : kk + 1);
        float* ssq = (float*)(ws + WS_SSQ); bf16* QKb = (bf16*)args.out;
        unsigned char* wl = ws + WS_W + (size_t)l * W_LAYER;
        const float* mixn = (const float*)args.in[13] + (size_t)l * DM;
        {
            const float* x_in = (const float*)args.in[0]; const int* positions = (const int*)args.in[1];
            LAS float* scr = (LAS float*)(ldsp + wave * 16384);
            constexpr int I_IN = 32 * 176, I_OUT = 32 * 64, I_G = 32 * 176, I_DN = 88 * 64, I_LAYER = I_IN + I_OUT + 2 * I_G + I_DN;
            for (int it = gw; it < DEPTH * I_LAYER; it += NGW) {
                const int ll = it / I_LAYER; int r = it - ll * I_LAYER;
                unsigned char* wll = ws + WS_W + (size_t)ll * W_LAYER;
                if (r < I_IN) { const int kb = r / 176, nb = r % 176, n0 = 32 * nb, o = n0 & 255;
                    const int dr = (n0 >= 1024 && n0 < 3072) ? (n0 & ~255) + 128 * ((o >> 6) & 1) + 64 * (o >> 7) + (o & 63) : n0;
                    transpose_item((const float*)args.in[3] + (size_t)ll * DM * NZ, DM, NZ, (bf16*)(wll + WO_IN), 64 * kb, n0, dr, (const float*)args.in[2] + ll * DM, scr, lane); continue; } r -= I_IN;
                if (r < I_OUT) { const int kb = r / 64, nb = r % 64; transpose_item((const float*)args.in[14] + (size_t)ll * DM * DM, DM, DM, (bf16*)(wll + WO_OUT), 64 * kb, 32 * nb, 32 * nb, nullptr, scr, lane); continue; } r -= I_OUT;
                if (r < 2 * I_G) { const int up = r >= I_G; if (up) r -= I_G; const int kb = r / 176, nb = r % 176, n0 = 32 * nb;
                    transpose_item((const float*)args.in[up ? 17 : 16] + (size_t)ll * DM * DFF, DM, DFF, (bf16*)(wll + WO_GU), 64 * kb, n0, (n0 >> 7) * 256 + (n0 & 127) + (up ? 128 : 0), (const float*)args.in[15] + ll * DM, scr, lane); continue; } r -= 2 * I_G;
                { const int kb = r / 64, nb = r % 64; transpose_item((const float*)args.in[18] + (size_t)ll * DFF * DM, DFF, DM, (bf16*)(wll + WO_DOWN), 64 * kb, 32 * nb, 32 * nb, nullptr, scr, lane); }
            }
            for (int e = vcu * 512 + tid; e < M * 64; e += G * 512) { const int m = e >> 6, j = e & 63;
                const float inv_freq = 1.0f / powf(10000.0f, (float)(2 * j) * (1.0f / 128.0f)); const float ang = (float)positions[m] * inv_freq;
                float sn, cs; sincosf(ang, &sn, &cs); ctab[e] = cs; stab[e] = sn; }
            {
                f32x4 va[8], vb[8];
#define XLD(V, m_) do { const f32x4* xr_ = (const f32x4*)(x_in + (size_t)(m_) * DM) + lane; _Pragma("unroll") for (int j = 0; j < 8; ++j) V[j] = xr_[64 * j]; } while (0)
#define XST(V, m_) do { float s_ = 0.f; _Pragma("unroll") for (int j = 0; j < 8; ++j) s_ += (V[j].x * V[j].x + V[j].y * V[j].y) + (V[j].z * V[j].z + V[j].w * V[j].w); s_ = wave_sum(s_);            \
        v2u* o_ = (v2u*)(Hb + (size_t)(m_) * DM) + lane; _Pragma("unroll") for (int j = 0; j < 8; ++j) { v2u w_; w_.x = pk2(V[j].x, V[j].y); w_.y = pk2(V[j].z, V[j].w); o_[64 * j] = w_; }                 \
        float* q_ = (float*)(ws + WS_SSQ) + (size_t)(m_) * 8; if (lane < 8) q_[lane] = lane == 0 ? s_ : 0.f; } while (0)
                XLD(va, gw);
                for (int m = gw; m < M; m += 2 * NGW) {
                    XLD(vb, m + NGW); XST(va, m);
                    if (m + 2 * NGW < M) XLD(va, m + 2 * NGW);
                    XST(vb, m + NGW); }
#undef XLD
#undef XST
            }
        }
        if (1 < args.ph_hi) { XcdBarrier bar; bar.bar = (unsigned*)(args.ws + WS_CTL) + CW_BAR; bar.x = xb_xcc_id(); bar.st = (volatile LAS unsigned*)((LAS unsigned char*)lds + MISC_OFF); xcd_barrier(bar); }
        if (args.ph_hi < 0) cg::this_grid().sync();
    }
    for (int p = (args.ph_lo == 0 ? 1 : args.ph_lo); p < args.ph_hi; ++p) {
        LAS unsigned char* ldsp = (LAS unsigned char*)lds;
        int zs = 0; asm volatile("" : "+s"(zs));
        const int G = gridDim.x + zs, bx = blockIdx.x + zs, vcu = (G % 8 == 0) ? (bx % 8) * (G / 8) + bx / 8 : bx;
        const int NGW = G * NWAVES;
#define PHASE_IDS() int tid = threadIdx.x; OPQ_V(tid); const int lane = tid & 63, wave = __builtin_amdgcn_readfirstlane(tid >> 6); const int gw = vcu * NWAVES + wave; (void)gw; (void)lane
        unsigned char* ws = args.ws;
        float* xo = args.out;
        bf16* Z = (bf16*)(ws + WS_Z); bf16* Hb = (bf16*)(ws + WS_H); bf16* MIX = (bf16*)(ws + WS_MIX); bf16* VB = (bf16*)(ws + WS_V); bf16* OB = (bf16*)(ws + WS_O);
        float* ctab = (float*)(ws + WS_ROPE); float* stab = ctab + (size_t)M * 64;
        const bool fin = (p == N_PHASES - 1); const int l = fin ? 0 : (p - 1) / LPH, kk = (p - 1) % LPH, k = fin ? 7 : (p == 0) ? -1 : (kk <= 2 ? kk : kk + 1);
        float* ssq = (float*)(ws + WS_SSQ); bf16* QKb = (bf16*)args.out;
        unsigned char* wl = ws + WS_W + (size_t)l * W_LAYER;
        const float* mixn = (const float*)args.in[13] + (size_t)l * DM;
#ifdef ONLY_ATT
        if (k != 2) continue;
#endif
        if (k == 0) {
            pg8::Gemm g{Hb, (const bf16*)(wl + WO_IN), M, NZ, DM}; pg8::StaticOrder S; S.init(M, NZ, G, bx);
            const float* sqp = ssq + (size_t)(2 * l) * M * 8;
            int pmA, pmB; { pg8::Unit u0; S.next(0, u0); pmA = pmB = u0.pm; for (int i = 1; S.next(i, u0); ++i) if (u0.pm != pmA) { pmB = u0.pm; break; } }
            { int t = threadIdx.x; OPQ_V(t); ((LAS float*)(ldsp + PSTAT_OFF))[t] = pg8::row_rstd(sqp, (t < 256 ? pmA : pmB) * 256 + (t & 255)); }
            __syncthreads();
            const pg8::RsTab T{(const LAS float*)(ldsp + PSTAT_OFF), pmA, pmB, sqp};
            pg8::EpiIn E{Z, NZ, T, QKb, VB, ctab, stab};
            pg8::gemm_phase<pg8::EpiIn, pg8::StaticOrder, PG8_ALIGN, PG8_SP2>(ldsp, g, S, E);
        } else if (k == 1) {
            PHASE_IDS();
            {
                const float* cw = (const float*)args.in[12] + (size_t)l * 3 * 512 + lane * 8;
                float w0[8], w1[8], w2[8], gn[8];
#pragma unroll
                for (int h2 = 0; h2 < 2; ++h2) { const f32x4 a = *(const f32x4*)(cw + 4 * h2), b = *(const f32x4*)(cw + 512 + 4 * h2), c = *(const f32x4*)(cw + 1024 + 4 * h2), d = *(const f32x4*)(mixn + 1536 + lane * 8 + 4 * h2);
#pragma unroll
                    for (int e = 0; e < 4; ++e) { w0[4 * h2 + e] = a[e]; w1[4 * h2 + e] = b[e]; w2[4 * h2 + e] = c[e]; gn[4 * h2 + e] = d[e]; } }
                v4u ra[7], rb7[7];
#define CLD(R, m_) do { const int t_ = (m_) & (SEQ - 1); const bf16* zr_ = Z + (size_t)(m_) * NZ + lane * 8; const bf16* z1_ = zr_ - (t_ >= 1 ? NZ : 0); const bf16* z2_ = zr_ - (t_ >= 2 ? 2 * NZ : 0);   \
        R[0] = *(const v4u*)(zr_ + 4096); R[1] = *(const v4u*)(zr_ + 4608); R[2] = *(const v4u*)(zr_ + 5120); R[3] = *(const v4u*)(z1_ + 4608); R[4] = *(const v4u*)(z1_ + 5120);                          \
        R[5] = *(const v4u*)(z2_ + 4608); R[6] = *(const v4u*)(z2_ + 5120); } while (0)
#define CST(R, m_) do { const int t_ = (m_) & (SEQ - 1); const float f1 = t_ >= 1 ? 1.f : 0.f, f2 = t_ >= 2 ? 1.f : 0.f;         \
        float bg[8], y[8], cgv[8], hcv[8]; unpack8(R[0], bg); unpack8(R[1], cgv); unpack8(R[2], hcv);                                                                                                   \
        _Pragma("unroll") for (int e = 0; e < 8; ++e) y[e] = w2[e] * (cgv[e] * hcv[e]);                                                                                                                 \
        unpack8(R[3], cgv); unpack8(R[4], hcv); _Pragma("unroll") for (int e = 0; e < 8; ++e) y[e] += f1 * w1[e] * (cgv[e] * hcv[e]);                                                                    \
        unpack8(R[5], cgv); unpack8(R[6], hcv); _Pragma("unroll") for (int e = 0; e < 8; ++e) y[e] += f2 * w0[e] * (cgv[e] * hcv[e]);                                                                    \
        float ss = 0.f; _Pragma("unroll") for (int e = 0; e < 8; ++e) { y[e] *= bg[e]; ss += y[e] * y[e]; }                                                                                             \
        ss += swz<1>(ss); ss += swz<2>(ss); ss += swz<4>(ss); ss += swz<8>(ss);                                                                                                                         \
        const float r = 1.0f / sqrtf(ss * (1.0f / 128.0f) + RMS_EPS);                                                                                                                                   \
        _Pragma("unroll") for (int e = 0; e < 8; ++e) y[e] = y[e] * r * gn[e];                                                                                                                          \
        *(v4u*)(MIX + (size_t)(m_) * DM + 1536 + lane * 8) = pack8f(y); } while (0)
                CLD(ra, gw);
                for (int m = gw; m < M; m += 2 * NGW) {
                    CLD(rb7, m + NGW); CST(ra, m);
                    if (m + 2 * NGW < M) CLD(ra, m + 2 * NGW);
                    CST(rb7, m + NGW); }
#undef CLD
#undef CST
            }
            __syncthreads();
            for (int u = vcu; u < BATCH * 32 * 4; u += G)
                gmlp_unit(u, Z, MIX, (const float*)args.in[4] + l * 512, (const float*)args.in[5] + l * 512, (const float*)args.in[6] + (size_t)l * 4 * 128 * 128, (const float*)args.in[7] + l * 512, mixn, ldsp, tid, lane, wave);
        } else if (k == 2) {
            PHASE_IDS();
            {
                using ab = att::bf16;
                static_assert(att::PAIR_LDS_BYTES <= MISC_OFF, "attention LDS fits the phase region");
                const float lam_init = 0.8f - 0.6f * expf(-0.3f * (float)l);
                const float* lq1 = (const float*)args.in[8] + l * 128; const float* lk1 = (const float*)args.in[9] + l * 128;
                const float* lq2 = (const float*)args.in[10] + l * 128; const float* lk2 = (const float*)args.in[11] + l * 128;
                const float d1 = wave_sum(lq1[lane] * lk1[lane] + lq1[lane + 64] * lk1[lane + 64]), d2 = wave_sum(lq2[lane] * lk2[lane] + lq2[lane + 64] * lk2[lane + 64]);
                const float lam = expf(d1) - expf(d2) + lam_init;
                constexpr int TOTAL = BATCH * 4 * 16;
                for (int L = vcu; L < TOTAL; L += G) {
                    const int bh = L >> 4, xx = L & 15, b = bh >> 2, h = bh & 3;
                    const ab* Kp = (const ab*)QKb + ((size_t)b * 16 + 8 + h * 2) * SEQ * 128; const ab* V0p = (const ab*)VB + ((size_t)b * 8 + h * 2) * SEQ * 128;
                    for (int pass = 0; pass < 2; ++pass) { const int qb = pass ? 31 - xx : xx;
                        const ab* Qp = (const ab*)QKb + (((size_t)b * 16 + h * 2) * SEQ + (size_t)qb * 128) * 128;
                        att::diff_block(Qp, Kp, V0p, V0p + (size_t)SEQ * 128, qb * 128, (char*)lds, lam, 1.0f - lam_init, mixn + 512 + h * 256,
                                        MIX + ((size_t)b * SEQ + (size_t)qb * 128) * DM + 512 + h * 256, SEQ * 128, (att::u32x4*)OB + (size_t)vcu * 4096); }
                }
            }
        } else if (k == 4 || k == 6) {
            const bool dn = (k == 6);
            pg8::Gemm g{dn ? Z : MIX, (const bf16*)(wl + (dn ? WO_DOWN : WO_OUT)), M, DM, dn ? DFF : DM}; pg8::StaticOrder S; S.init(M, DM, G, bx);
            pg8::EpiRes E{Hb, DM, ssq + (size_t)(2 * l + (dn ? 2 : 1)) * M * 8, (LAS float*)(ldsp + PSTAT_OFF)};
            pg8::gemm_phase<pg8::EpiRes, pg8::StaticOrder, PG8_ALIGN, PG8_SP2>(ldsp, g, S, E);
        } else if (k == 5) {
            pg8::Gemm g{Hb, (const bf16*)(wl + WO_GU), M, 2 * DFF, DM}; pg8::StaticOrder S; S.init(M, 2 * DFF, G, bx);
            const float* sqp = ssq + (size_t)(2 * l + 1) * M * 8;
            int pmA, pmB; { pg8::Unit u0; S.next(0, u0); pmA = pmB = u0.pm; for (int i = 1; S.next(i, u0); ++i) if (u0.pm != pmA) { pmB = u0.pm; break; } }
            { int t = threadIdx.x; OPQ_V(t); ((LAS float*)(ldsp + PSTAT_OFF))[t] = pg8::row_rstd(sqp, (t < 256 ? pmA : pmB) * 256 + (t & 255)); }
            __syncthreads();
            const pg8::RsTab T{(const LAS float*)(ldsp + PSTAT_OFF), pmA, pmB, sqp};
            pg8::EpiSwiGLU E{Z, DFF, T};
            pg8::gemm_phase<pg8::EpiSwiGLU, pg8::StaticOrder, PG8_ALIGN, PG8_SP2>(ldsp, g, S, E);
        } else {
            PHASE_IDS();
            const float* gp = (const float*)args.in[19]; const float* sq = ssq + (size_t)(2 * DEPTH) * M * 8;
            v4u xa[4], xb4[4]; float sa, sb;
#define FLD(X, S_, m_) do { S_ = pg8::row_ssq(sq, (m_)); _Pragma("unroll") for (int j = 0; j < 4; ++j) X[j] = *(const v4u*)(Hb + (size_t)(m_) * DM + 8 * lane + 512 * j); } while (0)
#define FST(X, S_, m_) do { const float rstd = 1.0f / sqrtf(S_ * (1.0f / DM) + RMS_EPS); float* orow = xo + (size_t)(m_) * DM;                                                         \
        _Pragma("unroll") for (int j = 0; j < 4; ++j) { const int c = 8 * lane + 512 * j; float x[8]; unpack8(X[j], x);                                                                \
            *(f32x4*)(orow + c) = (f32x4){x[0] * rstd * gfin[j][0][0], x[1] * rstd * gfin[j][0][1], x[2] * rstd * gfin[j][0][2], x[3] * rstd * gfin[j][0][3]};                            \
            *(f32x4*)(orow + c + 4) = (f32x4){x[4] * rstd * gfin[j][1][0], x[5] * rstd * gfin[j][1][1], x[6] * rstd * gfin[j][1][2], x[7] * rstd * gfin[j][1][3]}; } } while (0)
            f32x4 gfin[4][2];
#pragma unroll
            for (int j = 0; j < 4; ++j) { gfin[j][0] = *(const f32x4*)(gp + 8 * lane + 512 * j); gfin[j][1] = *(const f32x4*)(gp + 8 * lane + 512 * j + 4); }
            FLD(xa, sa, gw);
            for (int m = gw; m < M; m += 2 * NGW) {
                FLD(xb4, sb, m + NGW); FST(xa, sa, m);
                if (m + 2 * NGW < M) FLD(xa, sa, m + 2 * NGW);
                FST(xb4, sb, m + NGW); }
#undef FLD
#undef FST
        }
        if (p + 1 < args.ph_hi) { XcdBarrier bar; bar.bar = (unsigned*)(args.ws + WS_CTL) + CW_BAR; bar.x = xb_xcc_id(); bar.st = (volatile LAS unsigned*)((LAS unsigned char*)lds + MISC_OFF); xcd_barrier(bar); }
    }
}

extern "C" void kernel_launch(void* const* d_in, const int* in_sizes, int n_in, void* d_out, int out_size, void* d_ws, size_t ws_size, hipStream_t stream) {
    static int grid = 0;
    if (grid == 0) {
        if (n_in != 20 || in_sizes[0] != M * DM || out_size != M * DM || ws_size < WS_END) { fprintf(stderr, "kernel_launch: shape/workspace mismatch (n_in %d, in0 %d, out %d, ws %zu)\n", n_in, n_in > 0 ? in_sizes[0] : -1, out_size, ws_size); grid = -1; return; }
        int dev = 0, cus = 0, per_cu = 0;
        if (hipGetDevice(&dev) != hipSuccess || hipDeviceGetAttribute(&cus, hipDeviceAttributeMultiprocessorCount, dev) != hipSuccess) { grid = -1; return; }
        if (hipFuncSetAttribute((const void*)hymba_fwd, hipFuncAttributeMaxDynamicSharedMemorySize, LDS_BYTES) != hipSuccess) { fprintf(stderr, "kernel_launch: hipFuncSetAttribute failed\n"); grid = -1; return; }
        if (hipOccupancyMaxActiveBlocksPerMultiprocessor(&per_cu, (const void*)hymba_fwd, NWAVES * 64, LDS_BYTES) != hipSuccess || per_cu < 1) { fprintf(stderr, "kernel_launch: occupancy query says %d\n", per_cu); per_cu = 1; }
        (void)hipGetLastError();
        grid = cus * 1;
        if (grid != 256) { fprintf(stderr, "kernel_launch: built for 256 CUs (the row-scale tables assume two row panels per workgroup), device has %d; nothing launched\n", cus); grid = -1; return; }
    }
    if (grid < 0) return;
    if (hipMemsetAsync((char*)d_ws + WS_CTL, 0, CTL_ZERO_BYTES, stream) != hipSuccess) { fprintf(stderr, "kernel_launch: memset of control words failed\n"); return; }
    Args a{};
    for (int i = 0; i < 20; ++i) a.in[i] = d_in[i];
    a.out = (float*)d_out; a.ws = (unsigned char*)d_ws;
#if MK_PER_PHASE
    for (int p = 0; p < N_PHASES; ++p) { a.ph_lo = p; a.ph_hi = p + 1;
        const int kk = (p - 1) % LPH, k = (p == 0 || p == N_PHASES - 1) ? -1 : (kk <= 2 ? kk : kk + 1);
        const int nrep = (p == 0) ? REP_P0 : (k == 0 || k == 5) ? REP_GEMM : (k == 2) ? REP_ATT : (k == 1) ? REP_MIX : (k == 3) ? REP_THIN : 1;
        for (int rep = 0; rep < nrep; ++rep) hipLaunchKernelGGL(hymba_fwd, dim3(grid), dim3(NWAVES * 64), LDS_BYTES, stream, a); }
#else
    a.ph_lo = 0; a.ph_hi = N_PHASES;
    void* kargs[] = {&a};
    hipError_t e = hipLaunchCooperativeKernel((const void*)hymba_fwd, dim3(grid), dim3(NWAVES * 64), kargs, LDS_BYTES, stream);
    if (e != hipSuccess) fprintf(stderr, "cooperative launch failed: %s (grid %d)\n", hipGetErrorString(e), grid);
#endif
}
```

```cpp
#include <hip/hip_runtime.h>
#include <hip/hip_cooperative_groups.h>
#include <hip/hip_bf16.h>
#include <cstdio>
#include <cstdint>
#include <cmath>
namespace cg = cooperative_groups;
template <int X> __device__ __forceinline__ float swz(float v) { return __int_as_float(__builtin_amdgcn_ds_swizzle(__float_as_int(v), 0x1f | (X << 10))); }
__device__ __forceinline__ float sum32(float v) { auto rr = __builtin_amdgcn_permlane32_swap(__float_as_uint(v), __float_as_uint(v), false, false); return __uint_as_float(rr[0]) + __uint_as_float(rr[1]); }
namespace pg8 {
#define PG8_LAS __attribute__((address_space(3)))
typedef unsigned short bf16_t;
typedef short bf16x8 __attribute__((ext_vector_type(8)));
typedef float f32x4 __attribute__((ext_vector_type(4)));
typedef unsigned u32x4 __attribute__((ext_vector_type(4)));
constexpr int BM = 256, BK = 64, HALF = 128, HTB = HALF * BK * 2  , STAGE_BYTES = 8 * HTB, NXCD = 8, WGM = 8;

__host__ __device__ __forceinline__ int lds_byte(int r, int c) { const int st = (r >> 4) * 2 + (c >> 5), rr = r & 15, cc = c & 31, ob = rr * 64 + cc * 2; return st * 1024 + (ob ^ (((ob >> 9) & 1) << 5)); }
__host__ __device__ __forceinline__ void stage_rc(int b, int& R, int& C) { const int st = b / 1024, sb = b % 1024, swz = sb ^ (((sb >> 9) & 1) << 5); R = (st >> 1) * 16 + swz / 64; C = (st & 1) * 32 + (swz % 64) / 2; }
__host__ __device__ __forceinline__ int perm32(int rho) { const int n = rho >> 4, i = rho & 15; return 8 * (i >> 2) + 4 * n + (i & 3); }

struct Unit { int pm, pn; };
struct Gemm { const bf16_t* A; const bf16_t* Bt; int M, N, K; };

struct StaticOrder {
    int nM, nN, nwg, G, c;
    __host__ __device__ void init(int M, int N, int G_, int c_) { nM = M / BM; nN = N / BM; nwg = nM * nN; G = G_; c = c_; }
    __host__ __device__ bool next(int i, Unit& u) const {
        const long L = (long)i * G + c; if (L >= nwg) return false;
        int wgid = (int)L; { const int q = nwg / NXCD, r = nwg % NXCD, xcd = wgid % NXCD, off = wgid / NXCD; wgid = (xcd < r ? xcd * (q + 1) : r * (q + 1) + (xcd - r) * q) + off; }
        const int nig = WGM * nN, gid = wgid / nig, fm = gid * WGM, gsz = (nM - fm) < WGM ? (nM - fm) : WGM;
        u.pm = fm + ((wgid % nig) % gsz); u.pn = (wgid % nig) / gsz; return true;
    }
    __device__ __forceinline__ void a_ready(const Unit&) const {}
    __device__ __forceinline__ void done(const Unit&) const {}
};

__device__ __forceinline__ unsigned cvt_pk_bf16(float lo, float hi) { unsigned r; asm volatile("v_cvt_pk_bf16_f32 %0, %1, %2" : "=v"(r) : "v"(lo), "v"(hi)); return r; }
typedef float f32x2 __attribute__((ext_vector_type(2)));
__device__ __forceinline__ float row_ssq(const float* ssqp, int row) { const f32x4 a = *(const f32x4*)(ssqp + (size_t)row * 8), b = *(const f32x4*)(ssqp + (size_t)row * 8 + 4); return ((a[0] + a[1]) + (a[2] + a[3])) + ((b[0] + b[1]) + (b[2] + b[3])); }
__device__ __forceinline__ float row_rstd(const float* ssqp, int row) { return 1.0f / sqrtf(row_ssq(ssqp, row) * (1.0f / 2048.0f) + 1e-6f); }
struct RsTab { const PG8_LAS float* rs; int pmA, pmB; const float* ssq;
    __device__ __forceinline__ float get(int pm, int r) const { return rs[(pm == pmA ? 0 : 256) + r]; } };
struct EpiZ {
    static constexpr bool PERM = true, AFTER_DRAIN = false, HAS_INIT = false;
    bf16_t* O; int ldc; const float* ssq;
    __device__ __forceinline__ void operator()(const f32x4 (&acc)[2][2][4][2], const Unit& u, int wr, int wc, int fr, int fq) const {
        const int row0 = u.pm * BM + wr * 64 + fr, col0 = u.pn * BM + wc * 32 + 8 * fq;
#pragma unroll
        for (int ai = 0; ai < 2; ++ai)
#pragma unroll
            for (int m = 0; m < 4; ++m) { const int row = row0 + ai * HALF + m * 16; const float rs = row_rstd(ssq, row); bf16_t* rowp = O + (size_t)row * ldc + col0;
#pragma unroll
                for (int bj = 0; bj < 2; ++bj) { const f32x4 v0 = acc[ai][bj][m][0] * rs, v1 = acc[ai][bj][m][1] * rs;
                    u32x4 w; w.x = cvt_pk_bf16(v0[0], v0[1]); w.y = cvt_pk_bf16(v0[2], v0[3]); w.z = cvt_pk_bf16(v1[0], v1[1]); w.w = cvt_pk_bf16(v1[2], v1[3]);
                    *(u32x4*)(rowp + bj * HALF) = w; } }
    }
};
struct EpiIn {
    static constexpr bool PERM = true, AFTER_DRAIN = false, HAS_INIT = false;
    bf16_t* Z; int ldc; RsTab T; bf16_t* QK; bf16_t* V; const float* ctab; const float* stab;
    __device__ __forceinline__ void operator()(const f32x4 (&acc)[2][2][4][2], const Unit& u, int wr, int wc, int fr, int fq) const {
        const int row0 = u.pm * BM + wr * 64 + fr, pn = u.pn;
        if (pn < 4 || pn >= 16) {
            const int col0 = pn * BM + wc * 32 + 8 * fq;
#pragma unroll
            for (int ai = 0; ai < 2; ++ai)
#pragma unroll
                for (int m = 0; m < 4; ++m) { const int row = row0 + ai * HALF + m * 16; const float rs = T.get(u.pm, wr * 64 + fr + ai * HALF + m * 16); bf16_t* rowp = Z + (size_t)row * ldc + col0;
#pragma unroll
                    for (int bj = 0; bj < 2; ++bj) { const f32x4 v0 = acc[ai][bj][m][0] * rs, v1 = acc[ai][bj][m][1] * rs;
                        u32x4 w; w.x = cvt_pk_bf16(v0[0], v0[1]); w.y = cvt_pk_bf16(v0[2], v0[3]); w.z = cvt_pk_bf16(v1[0], v1[1]); w.w = cvt_pk_bf16(v1[2], v1[3]);
                        *(u32x4*)(rowp + bj * HALF) = w; } }
        } else if (pn < 12) {
            const int hd = (pn - 4) * 2 + (wc >> 1), j0 = 32 * (wc & 1) + 8 * fq;
#pragma unroll
            for (int ai = 0; ai < 2; ++ai) {
                f32x4 tc[4][4];
#pragma unroll
                for (int m = 0; m < 4; ++m) { const size_t tb = (size_t)(row0 + ai * HALF + m * 16) * 64 + j0;
                    tc[m][0] = *(const f32x4*)(ctab + tb); tc[m][1] = *(const f32x4*)(ctab + tb + 4); tc[m][2] = *(const f32x4*)(stab + tb); tc[m][3] = *(const f32x4*)(stab + tb + 4); }
#pragma unroll
                for (int m = 0; m < 4; ++m) { const int row = row0 + ai * HALF + m * 16; const float rs = T.get(u.pm, wr * 64 + fr + ai * HALF + m * 16);
                    const f32x4 c0 = tc[m][0], c1 = tc[m][1], s0 = tc[m][2], s1 = tc[m][3];
                    const f32x4 a0 = acc[ai][0][m][0] * rs, a1 = acc[ai][0][m][1] * rs, b0 = acc[ai][1][m][0] * rs, b1 = acc[ai][1][m][1] * rs;
                    const f32x4 p0 = a0 * c0 - b0 * s0, p1 = a1 * c1 - b1 * s1, q0 = b0 * c0 + a0 * s0, q1 = b1 * c1 + a1 * s1;
                    bf16_t* dp = QK + (((size_t)(row >> 12) * 16 + hd) * 4096 + (row & 4095)) * 128 + j0;
                    u32x4 w; w.x = cvt_pk_bf16(p0[0], p0[1]); w.y = cvt_pk_bf16(p0[2], p0[3]); w.z = cvt_pk_bf16(p1[0], p1[1]); w.w = cvt_pk_bf16(p1[2], p1[3]); *(u32x4*)dp = w;
                    w.x = cvt_pk_bf16(q0[0], q0[1]); w.y = cvt_pk_bf16(q0[2], q0[3]); w.z = cvt_pk_bf16(q1[0], q1[1]); w.w = cvt_pk_bf16(q1[2], q1[3]); *(u32x4*)(dp + 64) = w; }
            }
        } else {
#pragma unroll
            for (int ai = 0; ai < 2; ++ai)
#pragma unroll
                for (int m = 0; m < 4; ++m) { const int row = row0 + ai * HALF + m * 16; const float rs = T.get(u.pm, wr * 64 + fr + ai * HALF + m * 16);
#pragma unroll
                    for (int bj = 0; bj < 2; ++bj) { const f32x4 v0 = acc[ai][bj][m][0] * rs, v1 = acc[ai][bj][m][1] * rs;
                        bf16_t* dp = V + (((size_t)(row >> 12) * 8 + (pn - 12) * 2 + bj) * 4096 + (row & 4095)) * 128 + wc * 32 + 8 * fq;
                        u32x4 w; w.x = cvt_pk_bf16(v0[0], v0[1]); w.y = cvt_pk_bf16(v0[2], v0[3]); w.z = cvt_pk_bf16(v1[0], v1[1]); w.w = cvt_pk_bf16(v1[2], v1[3]);
                        *(u32x4*)dp = w; } }
        }
    }
};
__device__ __forceinline__ float swiglu1(float g, float u) { return g * u * __builtin_amdgcn_rcpf(1.0f + __builtin_amdgcn_exp2f(-1.4426950408889634f * g)); }
struct EpiSwiGLU {
    static constexpr bool PERM = true, AFTER_DRAIN = false, HAS_INIT = false;
    bf16_t* O; int ldc; RsTab T;
    __device__ __forceinline__ void operator()(const f32x4 (&acc)[2][2][4][2], const Unit& u, int wr, int wc, int fr, int fq) const {
        const int row0 = u.pm * BM + wr * 64 + fr, col0 = u.pn * HALF + wc * 32 + 8 * fq;
#pragma unroll
        for (int ai = 0; ai < 2; ++ai)
#pragma unroll
            for (int m = 0; m < 4; ++m) { const int row = row0 + ai * HALF + m * 16; const float rs = T.get(u.pm, wr * 64 + fr + ai * HALF + m * 16); bf16_t* rowp = O + (size_t)row * ldc + col0;
                const f32x4 g0 = acc[ai][0][m][0] * rs, g1 = acc[ai][0][m][1] * rs, u0 = acc[ai][1][m][0] * rs, u1 = acc[ai][1][m][1] * rs;
                u32x4 w; w.x = cvt_pk_bf16(swiglu1(g0[0], u0[0]), swiglu1(g0[1], u0[1])); w.y = cvt_pk_bf16(swiglu1(g0[2], u0[2]), swiglu1(g0[3], u0[3]));
                w.z = cvt_pk_bf16(swiglu1(g1[0], u1[0]), swiglu1(g1[1], u1[1])); w.w = cvt_pk_bf16(swiglu1(g1[2], u1[2]), swiglu1(g1[3], u1[3]));
                *(u32x4*)rowp = w; }
    }
};
struct EpiRes {
    static constexpr bool PERM = true, AFTER_DRAIN = false, HAS_INIT = true;
    bf16_t* X; int ldc; float* ssqp; PG8_LAS float* P;
    __device__ __forceinline__ void init(f32x4 (&acc)[2][2][4][2], const Unit& u, int wr, int wc, int fr, int fq) const {
        const int row0 = u.pm * BM + wr * 64 + fr, col0 = u.pn * BM + wc * 32 + 8 * fq;
#pragma unroll
        for (int ai = 0; ai < 2; ++ai)
#pragma unroll
            for (int m = 0; m < 4; ++m) { const bf16_t* rp = X + (size_t)(row0 + ai * HALF + m * 16) * ldc + col0;
#pragma unroll
                for (int bj = 0; bj < 2; ++bj) { const u32x4 b = *(const u32x4*)(rp + bj * HALF);
                    acc[ai][bj][m][0] = (f32x4){__uint_as_float(b.x << 16), __uint_as_float(b.x & 0xffff0000u), __uint_as_float(b.y << 16), __uint_as_float(b.y & 0xffff0000u)};
                    acc[ai][bj][m][1] = (f32x4){__uint_as_float(b.z << 16), __uint_as_float(b.z & 0xffff0000u), __uint_as_float(b.w << 16), __uint_as_float(b.w & 0xffff0000u)}; } }
    }
    template <int AI0, int AI1> __device__ __forceinline__ void load_tile(u32x4 (&nx)[2][4][2], const Unit& u, int wr, int wc, int fr, int fq) const {
        const int row0 = u.pm * BM + wr * 64 + fr, col0 = u.pn * BM + wc * 32 + 8 * fq;
#pragma unroll
        for (int ai = AI0; ai < AI1; ++ai)
#pragma unroll
            for (int m = 0; m < 4; ++m) { const bf16_t* rp = X + (size_t)(row0 + ai * HALF + m * 16) * ldc + col0;
#pragma unroll
                for (int bj = 0; bj < 2; ++bj) nx[ai][m][bj] = *(const u32x4*)(rp + bj * HALF); }
    }
    __device__ __forceinline__ void unpack(f32x4 (&acc)[2][2][4][2], const u32x4 (&nx)[2][4][2]) const {
#pragma unroll
        for (int ai = 0; ai < 2; ++ai)
#pragma unroll
            for (int m = 0; m < 4; ++m)
#pragma unroll
                for (int bj = 0; bj < 2; ++bj) { const u32x4 b = nx[ai][m][bj];
                    acc[ai][bj][m][0] = (f32x4){__uint_as_float(b.x << 16), __uint_as_float(b.x & 0xffff0000u), __uint_as_float(b.y << 16), __uint_as_float(b.y & 0xffff0000u)};
                    acc[ai][bj][m][1] = (f32x4){__uint_as_float(b.z << 16), __uint_as_float(b.z & 0xffff0000u), __uint_as_float(b.w << 16), __uint_as_float(b.w & 0xffff0000u)}; }
    }
    __device__ __forceinline__ void fused(f32x4 (&acc)[2][2][4][2], const Unit& u, const Unit& un, bool has_next, int wr, int wc, int fr, int fq) const {
        const int row0 = u.pm * BM + wr * 64 + fr, col0 = u.pn * BM + wc * 32 + 8 * fq;
        u32x4 w[2][4][2];
#pragma unroll
        for (int ai = 0; ai < 2; ++ai)
#pragma unroll
            for (int m = 0; m < 4; ++m) { float part = 0.f;
#pragma unroll
                for (int bj = 0; bj < 2; ++bj) { const f32x4 a0 = acc[ai][bj][m][0], a1 = acc[ai][bj][m][1];
                    part += (a0[0] * a0[0] + a0[1] * a0[1]) + (a0[2] * a0[2] + a0[3] * a0[3]) + (a1[0] * a1[0] + a1[1] * a1[1]) + (a1[2] * a1[2] + a1[3] * a1[3]);
                    w[ai][m][bj].x = cvt_pk_bf16(a0[0], a0[1]); w[ai][m][bj].y = cvt_pk_bf16(a0[2], a0[3]); w[ai][m][bj].z = cvt_pk_bf16(a1[0], a1[1]); w[ai][m][bj].w = cvt_pk_bf16(a1[2], a1[3]); }
                part += swz<16>(part); part = sum32(part);
                if (fq == 0) P[(wr * 64 + ai * HALF + m * 16 + fr) * 4 + wc] = part; }
        asm volatile("" ::: "memory");
        u32x4 nx[2][4][2];
        if (has_next) load_tile<0, 2>(nx, un, wr, wc, fr, fq);
        asm volatile("" ::: "memory");
#pragma unroll
        for (int ai = 0; ai < 2; ++ai)
#pragma unroll
            for (int m = 0; m < 4; ++m) { bf16_t* rowp = X + (size_t)(row0 + ai * HALF + m * 16) * ldc + col0;
#pragma unroll
                for (int bj = 0; bj < 2; ++bj) *(u32x4*)(rowp + bj * HALF) = w[ai][m][bj]; }
        asm volatile("s_waitcnt lgkmcnt(0)" ::: "memory"); __builtin_amdgcn_s_barrier(); asm volatile("" ::: "memory");
        const int t = (wr * 4 + wc) * 64 + fq * 16 + fr;
        if (t < BM) { const f32x4 p = *(const PG8_LAS f32x4*)(P + t * 4); ssqp[((size_t)u.pm * BM + t) * 8 + u.pn] = (p[0] + p[1]) + (p[2] + p[3]); }
        if (has_next) unpack(acc, nx);
    }
    __device__ __forceinline__ void operator()(const f32x4 (&acc)[2][2][4][2], const Unit& u, int wr, int wc, int fr, int fq) const {
        const int row0 = u.pm * BM + wr * 64 + fr, col0 = u.pn * BM + wc * 32 + 8 * fq;
#pragma unroll
        for (int ai = 0; ai < 2; ++ai)
#pragma unroll
            for (int m = 0; m < 4; ++m) { const int row = row0 + ai * HALF + m * 16; bf16_t* rowp = X + (size_t)row * ldc + col0; float part = 0.f;
#pragma unroll
                for (int bj = 0; bj < 2; ++bj) { const f32x4 a0 = acc[ai][bj][m][0], a1 = acc[ai][bj][m][1];
                    part += (a0[0] * a0[0] + a0[1] * a0[1]) + (a0[2] * a0[2] + a0[3] * a0[3]) + (a1[0] * a1[0] + a1[1] * a1[1]) + (a1[2] * a1[2] + a1[3] * a1[3]);
                    u32x4 w; w.x = cvt_pk_bf16(a0[0], a0[1]); w.y = cvt_pk_bf16(a0[2], a0[3]); w.z = cvt_pk_bf16(a1[0], a1[1]); w.w = cvt_pk_bf16(a1[2], a1[3]);
                    *(u32x4*)(rowp + bj * HALF) = w; }
                part += swz<16>(part); part = sum32(part);
                if (fq == 0) P[(wr * 64 + ai * HALF + m * 16 + fr) * 4 + wc] = part; }
        asm volatile("s_waitcnt lgkmcnt(0)" ::: "memory"); __builtin_amdgcn_s_barrier(); asm volatile("" ::: "memory");
        const int t = (wr * 4 + wc) * 64 + fq * 16 + fr;
        if (t < BM) { const f32x4 p = *(const PG8_LAS f32x4*)(P + t * 4); ssqp[((size_t)u.pm * BM + t) * 8 + u.pn] = (p[0] + p[1]) + (p[2] + p[3]); }
    }
};
template <class Epi, class Sched, bool ALIGN_EPI = false, bool SP2 = false>
__device__ __forceinline__ void gemm_phase(PG8_LAS unsigned char* lds, const Gemm g, const Sched& S, const Epi& E) {
    int tid_o = threadIdx.x; asm volatile("" : "+v"(tid_o));
    const int tid = tid_o, wid = __builtin_amdgcn_readfirstlane(tid >> 6), lane = tid & 63, wr = wid >> 2, wc = wid & 3, fr = lane & 15, fq = lane >> 4;
    const int K = g.K, nt = K / BK;
    unsigned voffA[2], voffB[2];
#pragma unroll
    for (int i = 0; i < 2; ++i) { int R, C; stage_rc(tid * 16 + i * 8192, R, C); const int Rb = Epi::PERM ? ((R & ~31) + perm32(R & 31)) : R;
        voffA[i] = (unsigned)(R * K + C) * 2u; voffB[i] = (unsigned)(Rb * K + C) * 2u; }
    const size_t kstep = (size_t)(BK * 2);
    const size_t hstep = (size_t)HALF * K * 2;
    const size_t tstep = 2 * hstep;
    const unsigned ldsw = (unsigned)wid * 1024u;
    const int aoff = lds_byte(wr * 64 + fr, fq * 8), boff = lds_byte(wc * 32 + fr, fq * 8);
#define PG8_SA(b, h) (((b) * 2 + (h)) * HTB)
#define PG8_SB(b, h) ((4 + (b) * 2 + (h)) * HTB)
#define PG8_STAGE(bufoff, gbase, voff) do { _Pragma("unroll") for (int _i = 0; _i < 2; ++_i) \
        __builtin_amdgcn_global_load_lds((const unsigned*)((const char*)(gbase) + (voff)[_i]), (PG8_LAS unsigned*)(lds + (bufoff) + ldsw + _i * 8192), 16, 0, 0); } while (0)
#define PG8_LDA(dst, b, h) do { _Pragma("unroll") for (int m = 0; m < 4; ++m) _Pragma("unroll") for (int k = 0; k < 2; ++k) dst[m][k] = *(const PG8_LAS bf16x8*)(lds + PG8_SA(b, h) + aoff + m * 2048 + k * 1024); } while (0)
#define PG8_LDB(dst, b, h) do { _Pragma("unroll") for (int n = 0; n < 2; ++n) _Pragma("unroll") for (int k = 0; k < 2; ++k) dst[n][k] = *(const PG8_LAS bf16x8*)(lds + PG8_SB(b, h) + boff + n * 2048 + k * 1024); } while (0)
#define PG8_MMA(ai, bj, At, Bt) do { __builtin_amdgcn_s_setprio(1); _Pragma("unroll") for (int m = 0; m < 4; ++m) _Pragma("unroll") for (int n = 0; n < 2; ++n) _Pragma("unroll") for (int k = 0; k < 2; ++k) \
        acc[ai][bj][m][n] = __builtin_amdgcn_mfma_f32_16x16x32_bf16(Bt[n][k], At[m][k], acc[ai][bj][m][n], 0, 0, 0); __builtin_amdgcn_s_setprio(0); } while (0)
#define PG8_WAIT_V(n) asm volatile("s_waitcnt vmcnt(" #n ")" ::: "memory")
#define PG8_WAIT_L(n) asm volatile("s_waitcnt lgkmcnt(" #n ")" ::: "memory")
#define PG8_BAR __builtin_amdgcn_s_barrier()
#define PG8_SCHED __builtin_amdgcn_sched_barrier(0)
    Unit cur, nxt; int ui = 0;
    if (!S.next(0, cur)) return;
    f32x4 acc[2][2][4][2];
    if constexpr (Epi::HAS_INIT) E.init(acc, cur, wr, wc, fr, fq);
    else {
#pragma unroll
    for (int a = 0; a < 2; ++a)
#pragma unroll
        for (int b = 0; b < 2; ++b)
#pragma unroll
            for (int m = 0; m < 4; ++m)
#pragma unroll
                for (int n = 0; n < 2; ++n) acc[a][b][m][n] = (f32x4){0.f, 0.f, 0.f, 0.f};
    }
    bf16x8 At[4][2], B0[2][2], B1[2][2];
    const char* cA = (const char*)g.A + (size_t)cur.pm * tstep; const char* cB = (const char*)g.Bt + (size_t)cur.pn * tstep;
    S.a_ready(cur);
    if constexpr (SP2) {
        PG8_STAGE(PG8_SB(0, 0), cB, voffB); PG8_STAGE(PG8_SB(0, 1), cB + hstep, voffB); PG8_STAGE(PG8_SA(0, 0), cA, voffA); PG8_STAGE(PG8_SA(0, 1), cA + hstep, voffA);
        if (wr == 1) PG8_BAR;
        PG8_WAIT_V(2); PG8_BAR;
        PG8_STAGE(PG8_SB(1, 0), cB + kstep, voffB); PG8_STAGE(PG8_SA(1, 0), cA + kstep, voffA); PG8_STAGE(PG8_SB(1, 1), cB + hstep + kstep, voffB);
        PG8_WAIT_V(6); PG8_BAR;
    } else {
        PG8_STAGE(PG8_SB(0, 0), cB, voffB); PG8_STAGE(PG8_SA(0, 0), cA, voffA); PG8_STAGE(PG8_SB(0, 1), cB + hstep, voffB); PG8_STAGE(PG8_SA(0, 1), cA + hstep, voffA);
        if (wr == 1) PG8_BAR;
        PG8_WAIT_V(4); PG8_BAR;
        PG8_STAGE(PG8_SB(1, 0), cB + kstep, voffB); PG8_STAGE(PG8_SA(1, 0), cA + kstep, voffA); PG8_STAGE(PG8_SB(1, 1), cB + hstep + kstep, voffB);
        PG8_WAIT_V(6); PG8_BAR;
    }
    for (;;) {
        const bool has_next = S.next(ui + 1, nxt);
        const char* nA = has_next ? (const char*)g.A + (size_t)nxt.pm * tstep : cA; const char* nB = has_next ? (const char*)g.Bt + (size_t)nxt.pn * tstep : cB;
        for (int t = 0; t < nt; t += 2) {
            const bool last = (t == nt - 2);
            const char* a1 = cA + (size_t)(t + 1) * kstep;
            const char* a2 = last ? nA : cA + (size_t)(t + 2) * kstep; const char* b2 = last ? nB : cB + (size_t)(t + 2) * kstep;
            const char* a3 = a2 + kstep; const char* b3 = b2 + kstep;
            if (last && has_next) S.a_ready(nxt);
            if constexpr (SP2) {
            PG8_LDB(B0, 0, 0); PG8_LDB(B1, 0, 1); PG8_SCHED; PG8_LDA(At, 0, 0); PG8_STAGE(PG8_SA(1, 1), a1 + hstep, voffA);
            PG8_WAIT_V(8); PG8_WAIT_L(0); PG8_BAR; PG8_MMA(0, 0, At, B0); PG8_MMA(0, 1, At, B1); PG8_BAR; PG8_SCHED;
            PG8_LDA(At, 0, 1); PG8_STAGE(PG8_SB(0, 0), b2, voffB); PG8_STAGE(PG8_SB(0, 1), b2 + hstep, voffB); PG8_STAGE(PG8_SA(0, 0), a2, voffA);
            PG8_WAIT_V(8); PG8_WAIT_L(0); PG8_BAR; PG8_MMA(1, 0, At, B0); PG8_MMA(1, 1, At, B1); PG8_BAR; PG8_SCHED;
            PG8_LDB(B0, 1, 0); PG8_LDB(B1, 1, 1); PG8_SCHED; PG8_LDA(At, 1, 0); PG8_STAGE(PG8_SA(0, 1), a2 + hstep, voffA);
            PG8_WAIT_V(8); PG8_WAIT_L(0); PG8_BAR; PG8_MMA(0, 0, At, B0); PG8_MMA(0, 1, At, B1); PG8_BAR; PG8_SCHED;
            PG8_LDA(At, 1, 1); PG8_STAGE(PG8_SB(1, 0), b3, voffB); PG8_STAGE(PG8_SB(1, 1), b3 + hstep, voffB); PG8_STAGE(PG8_SA(1, 0), a3, voffA);
            PG8_WAIT_V(8); PG8_WAIT_L(0); PG8_BAR; PG8_MMA(1, 0, At, B0); PG8_MMA(1, 1, At, B1); PG8_BAR; PG8_SCHED;
            } else {
            PG8_LDB(B0, 0, 0); PG8_SCHED; PG8_LDA(At, 0, 0); PG8_STAGE(PG8_SA(1, 1), a1 + hstep, voffA);
            PG8_WAIT_L(8); PG8_BAR; PG8_WAIT_L(0); PG8_MMA(0, 0, At, B0); PG8_BAR; PG8_SCHED;
            PG8_LDB(B1, 0, 1); PG8_STAGE(PG8_SB(0, 0), b2, voffB);
            PG8_BAR; PG8_WAIT_L(0); PG8_MMA(0, 1, At, B1); PG8_BAR;
            PG8_LDA(At, 0, 1); PG8_STAGE(PG8_SA(0, 0), a2, voffA);
            PG8_BAR; PG8_WAIT_L(0); PG8_MMA(1, 0, At, B0); PG8_BAR; PG8_SCHED;
            PG8_STAGE(PG8_SB(0, 1), b2 + hstep, voffB);
            PG8_WAIT_V(6); PG8_BAR; PG8_MMA(1, 1, At, B1); PG8_BAR;
            PG8_LDB(B0, 1, 0); PG8_SCHED; PG8_LDA(At, 1, 0); PG8_STAGE(PG8_SA(0, 1), a2 + hstep, voffA);
            PG8_WAIT_L(8); PG8_BAR; PG8_WAIT_L(0); PG8_MMA(0, 0, At, B0); PG8_BAR; PG8_SCHED;
            PG8_LDB(B1, 1, 1); PG8_STAGE(PG8_SB(1, 0), b3, voffB);
            PG8_BAR; PG8_WAIT_L(0); PG8_MMA(0, 1, At, B1); PG8_BAR;
            PG8_LDA(At, 1, 1); PG8_STAGE(PG8_SA(1, 0), a3, voffA);
            PG8_BAR; PG8_WAIT_L(0); PG8_MMA(1, 0, At, B0); PG8_BAR; PG8_SCHED;
            PG8_STAGE(PG8_SB(1, 1), b3 + hstep, voffB);
            PG8_WAIT_V(6); PG8_BAR; PG8_MMA(1, 1, At, B1); PG8_BAR;
            }
        }
        if constexpr (ALIGN_EPI) { if (wr == 0) PG8_BAR; }
        int fr_e = fr, fq_e = fq; asm volatile("" : "+v"(fr_e), "+v"(fq_e));
        if constexpr (Epi::HAS_INIT) { E.fused(acc, cur, nxt, has_next, wr, wc, fr_e, fq_e); S.done(cur); }
        else if constexpr (!Epi::AFTER_DRAIN) { E(acc, cur, wr, wc, fr_e, fq_e); S.done(cur); }
        if (!has_next) break;
        if constexpr (Epi::HAS_INIT) { }
        else {
#pragma unroll
        for (int a = 0; a < 2; ++a)
#pragma unroll
            for (int b = 0; b < 2; ++b)
#pragma unroll
                for (int m = 0; m < 4; ++m)
#pragma unroll
                    for (int n = 0; n < 2; ++n) acc[a][b][m][n] = (f32x4){0.f, 0.f, 0.f, 0.f};
        }
        cur = nxt; cA = nA; cB = nB; ++ui;
        if constexpr (ALIGN_EPI) { if (wr == 1) PG8_BAR; }
    }
    PG8_WAIT_V(0);
    if constexpr (!ALIGN_EPI) { if (wr == 0) PG8_BAR; }
    PG8_BAR;
    if constexpr (Epi::AFTER_DRAIN) { E.fused(acc, cur, wr, wc, fr, fq, lds, wid, lane); S.done(cur); }
#undef PG8_SA
#undef PG8_SB
#undef PG8_STAGE
#undef PG8_LDA
#undef PG8_LDB
#undef PG8_MMA
#undef PG8_WAIT_V
#undef PG8_WAIT_L
#undef PG8_BAR
#undef PG8_SCHED
}
}
#ifndef PG8_SP2
#define PG8_SP2 true
#endif
#ifndef PG8_ALIGN
#define PG8_ALIGN true
#endif
namespace att {
constexpr int D = 128;
constexpr int LDQ = 128, LDKV = 128, LDO = 128;
constexpr float THR = 8.f;
constexpr bool WSKIP = false;
constexpr float SCALE = 0.08838834764831845f;
constexpr int NW = 8, QBLK = 32, KVBLK = 64, QB = NW * QBLK;
constexpr int SHM_V = KVBLK * D * 2, SHM_K = KVBLK * D * 2;
constexpr int LDS_BYTES = 2 * SHM_V + 2 * SHM_K + NW * 64 * 4;
using bf16 = __hip_bfloat16;
typedef short bf16x8 __attribute__((ext_vector_type(8)));
typedef short s16x4 __attribute__((ext_vector_type(4)));
typedef float f32x16 __attribute__((ext_vector_type(16)));
typedef float f32x4 __attribute__((ext_vector_type(4)));
typedef unsigned u32x4 __attribute__((ext_vector_type(4)));
template <class A, class Bt> struct same_t { static constexpr bool v = false; };
template <class A> struct same_t<A, A> { static constexpr bool v = true; };

#define KSWZ(row, colB) ((row) * 256 + ((colB) ^ (((row) & 7) << 4)))
#define SBAR() __builtin_amdgcn_sched_barrier(0)
__device__ __forceinline__ int v_st(int k, int c) { const int kk = (k & ~0xC) | ((k & 4) << 1) | ((k & 8) >> 1); return ((kk >> 3) * 4 + (c >> 5)) * 512 + ((kk & 7) * 32 + (c & 31)) * 2; }
__device__ __forceinline__ int v_rd_base(int lane) { return ((lane & 3) << 3) | (((lane >> 2) & 3) << 6) | (((lane >> 4) & 1) << 5) | (((lane >> 5) & 1) << 8); }
constexpr int v_rd_off(int d0, int ks, int half) { return d0 * 512 + ks * 4096 + half * 2048; }
__device__ __forceinline__ int crow(int r, int hi) { return (r & 3) + 8 * (r >> 2) + 4 * hi; }
__device__ __forceinline__ unsigned cvtpk(float lo, float hi) {
    unsigned r; asm volatile("v_cvt_pk_bf16_f32 %0, %1, %2" : "=v"(r) : "v"(lo), "v"(hi)); return r;
}
__device__ __forceinline__ bf16x8 pack8(f32x4 a, f32x4 b) {
    u32x4 w = {cvtpk(a[0], a[1]), cvtpk(a[2], a[3]), cvtpk(b[0], b[1]), cvtpk(b[2], b[3])};
    return *reinterpret_cast<bf16x8*>(&w);
}
template <class T> __device__ __forceinline__ bf16x8 load8(const T* p) {
    if constexpr (same_t<T, float>::v) { return pack8(*(const f32x4*)p, *(const f32x4*)(p + 4)); }
    else { return *reinterpret_cast<const bf16x8*>(p); }
}
__device__ __forceinline__ void mask_tile(f32x16& p0, f32x16& p1, int dq, unsigned W) {
    const float NEG = -__builtin_inff();
#pragma unroll
    for (int r = 0; r < 16; ++r) {
        const int c = (r & 3) + 8 * (r >> 2);
        if ((unsigned)(dq - c) >= W) p0[r] = NEG;
        if ((unsigned)(dq - c - 32) >= W) p1[r] = NEG;
    }
}
__device__ __forceinline__ void partialSM(f32x16& p0, f32x16& p1, float& m_reg, float& mn, float& alpha) {
    float pmax = p0[0]; for (int r = 1; r < 16; ++r) pmax = fmaxf(pmax, p0[r]); for (int r = 0; r < 16; ++r) pmax = fmaxf(pmax, p1[r]);
    { auto rr = __builtin_amdgcn_permlane32_swap(__float_as_uint(pmax), __float_as_uint(pmax), false, false);
      pmax = fmaxf(__uint_as_float(rr[0]), __uint_as_float(rr[1])); }
    constexpr float C2 = 1.4426950408889634f * SCALE;
    if (__builtin_expect(__all((pmax - m_reg) * SCALE <= THR), 1)) { mn = m_reg; alpha = 1.f; }
    else { mn = fmaxf(m_reg, pmax); alpha = __builtin_amdgcn_exp2f((m_reg - mn) * C2); m_reg = mn; }
    const float mnL = -mn * C2;
    for (int r = 0; r < 16; ++r) p0[r] = fmaf(p0[r], C2, mnL); for (int r = 0; r < 16; ++r) p1[r] = fmaf(p1[r], C2, mnL);
    for (int r = 0; r < 16; ++r) p0[r] = __builtin_amdgcn_exp2f(p0[r]);
}
__device__ __forceinline__ void finishSM(f32x16& p0, f32x16& p1, float alpha, float& l_reg, bf16x8& pa0, bf16x8& pa1, bf16x8& pa2, bf16x8& pa3) {
    for (int r = 0; r < 16; ++r) p1[r] = __builtin_amdgcn_exp2f(p1[r]);
    float ps = 0; for (int r = 0; r < 16; ++r) ps += p0[r]; for (int r = 0; r < 16; ++r) ps += p1[r];
    { auto rr = __builtin_amdgcn_permlane32_swap(__float_as_uint(ps), __float_as_uint(ps), false, false);
      ps = __uint_as_float(rr[0]) + __uint_as_float(rr[1]); }
    l_reg = l_reg * alpha + ps;
#define PK4(P, B_, OUT) do { unsigned a0 = cvtpk(P[B_+0], P[B_+1]), a1 = cvtpk(P[B_+2], P[B_+3]);                          \
        unsigned b0 = cvtpk(P[B_+4], P[B_+5]), b1 = cvtpk(P[B_+6], P[B_+7]);                                             \
        auto r0 = __builtin_amdgcn_permlane32_swap(a0, b0, false, false); auto r1 = __builtin_amdgcn_permlane32_swap(a1, b1, false, false); \
        u32x4 w = {r0[0], r1[0], r0[1], r1[1]}; OUT = *reinterpret_cast<bf16x8*>(&w); } while (0)
    PK4(p0, 0, pa0); PK4(p0, 8, pa1); PK4(p1, 0, pa2); PK4(p1, 8, pa3);
#undef PK4
}
template <int KB, bool SK>
__device__ __forceinline__ void qkt(f32x16& p0, f32x16& p1, const char* K_lds, int r32, int hi, const bf16x8* qr, bool act) {
    if (SK && !act) { const float NEG = -__builtin_inff();
#pragma unroll
        for (int r = 0; r < 16; ++r) { p0[r] = NEG; p1[r] = NEG; } return; }
    p0 = f32x16{}; p1 = f32x16{};
    const char* kb[4];
#pragma unroll
    for (int dd = 0; dd < 4; ++dd) kb[dd] = K_lds + KB * SHM_K + KSWZ(r32, (dd * 16 + hi * 8) * 2);
#pragma unroll
    for (int d0 = 0; d0 < 8; ++d0) { const char* a = kb[d0 & 3] + (d0 >> 2) * 128;
        bf16x8 b0 = *reinterpret_cast<const bf16x8*>(a);
        bf16x8 b1 = *reinterpret_cast<const bf16x8*>(a + 32 * 256);
        p0 = __builtin_amdgcn_mfma_f32_32x32x16_bf16(b0, qr[d0], p0, 0, 0, 0);
        p1 = __builtin_amdgcn_mfma_f32_32x32x16_bf16(b1, qr[d0], p1, 0, 0, 0); }
}
template <int VB, bool SK>
__device__ __forceinline__ void pv_tile(f32x16* o, int vb0, bf16x8 pa0, bf16x8 pa1, bf16x8 pa2, bf16x8 pa3, bool act) {
    if (SK && !act) return;
#define TRRD(dst, off) asm volatile("ds_read_b64_tr_b16 %0, %1 offset:%2" : "=&v"(dst) : "v"(vb0), "i"(off) : "memory")
#define PV_D0(d0) do { s16x4 l0, l1, l2, l3, h0, h1, h2, h3; constexpr int b_ = VB * SHM_V + v_rd_off(d0, 0, 0);     \
        TRRD(l0, b_); TRRD(h0, b_ + 2048); TRRD(l1, b_ + 4096); TRRD(h1, b_ + 6144); TRRD(l2, b_ + 8192); TRRD(h2, b_ + 10240); TRRD(l3, b_ + 12288); TRRD(h3, b_ + 14336); \
        asm volatile("s_waitcnt lgkmcnt(0)" ::: "memory"); SBAR();                 \
        o[d0] = __builtin_amdgcn_mfma_f32_32x32x16_bf16(pa0, (bf16x8){l0[0], l0[1], l0[2], l0[3], h0[0], h0[1], h0[2], h0[3]}, o[d0], 0, 0, 0);   \
        o[d0] = __builtin_amdgcn_mfma_f32_32x32x16_bf16(pa1, (bf16x8){l1[0], l1[1], l1[2], l1[3], h1[0], h1[1], h1[2], h1[3]}, o[d0], 0, 0, 0);   \
        o[d0] = __builtin_amdgcn_mfma_f32_32x32x16_bf16(pa2, (bf16x8){l2[0], l2[1], l2[2], l2[3], h2[0], h2[1], h2[2], h2[3]}, o[d0], 0, 0, 0);   \
        o[d0] = __builtin_amdgcn_mfma_f32_32x32x16_bf16(pa3, (bf16x8){l3[0], l3[1], l3[2], l3[3], h3[0], h3[1], h3[2], h3[3]}, o[d0], 0, 0, 0); } while (0)
    PV_D0(0); PV_D0(1); PV_D0(2); PV_D0(3);
#undef PV_D0
#undef TRRD
}

template <class TIn, class TOut> struct BlockRef { const TIn* Q; const TIn* K; const TIn* V; TOut* O; int P0; };
template <class TIn> struct Seam {
    bf16x8 qr[8];
    bf16x8 st_v0, st_v1, st_k0, st_k1; f32x4 sf0, sf1, sf2, sf3;
    f32x4 tq[16];
};
__device__ __forceinline__ int swa_jlo(int P0, int W) { const int lowk = P0 - W + 1; return lowk > 0 ? lowk / KVBLK : 0; }
#define ROW(p, k0, rr) ((p) + (size_t)((k0) + (rr)) * LDKV + sc)
#define VMW() asm volatile("s_waitcnt vmcnt(0)" ::: "memory")
#define VMWN(n) asm volatile("s_waitcnt vmcnt(%0)" :: "i"(n) : "memory")
#define SLOAD_H(Kp, Vp, k0) do { S.st_v0 = load8<TIn>(ROW(Vp, k0, sr)); S.st_v1 = load8<TIn>(ROW(Vp, k0, 32 + sr));              \
                         S.st_k0 = load8<TIn>(ROW(Kp, k0, sr)); S.st_k1 = load8<TIn>(ROW(Kp, k0, 32 + sr)); } while (0)
#define SWRITE_HK(bf) do { *(bf16x8*)(K_lds + (bf) * SHM_K + kws) = S.st_k0; *(bf16x8*)(K_lds + (bf) * SHM_K + kws + 32 * 256) = S.st_k1; } while (0)
#define SWRITE_HV(bf) do { *(bf16x8*)(V_lds + (bf) * SHM_V + vst0) = S.st_v0; *(bf16x8*)(V_lds + (bf) * SHM_V + vst1) = S.st_v1; } while (0)
#define SWRITE_H(bf) do { SWRITE_HV(bf); SWRITE_HK(bf); } while (0)
#define SLOAD_F(p, k0) do { S.sf0 = *(const f32x4*)ROW(p, k0, sr); S.sf1 = *(const f32x4*)(ROW(p, k0, sr) + 4);                \
                            S.sf2 = *(const f32x4*)ROW(p, k0, 32 + sr); S.sf3 = *(const f32x4*)(ROW(p, k0, 32 + sr) + 4); } while (0)
#define SWRITE_KF(bf) do { *(bf16x8*)(K_lds + (bf) * SHM_K + kws) = pack8(S.sf0, S.sf1); *(bf16x8*)(K_lds + (bf) * SHM_K + kws + 32 * 256) = pack8(S.sf2, S.sf3); } while (0)
#define SWRITE_VF(bf) do { *(bf16x8*)(V_lds + (bf) * SHM_V + vst0) = pack8(S.sf0, S.sf1); *(bf16x8*)(V_lds + (bf) * SHM_V + vst1) = pack8(S.sf2, S.sf3); } while (0)
template <class TIn, class TOut>
__device__ __forceinline__ void causal_swa_prime(const BlockRef<TIn, TOut>& cur, int W, char* lds, Seam<TIn>& S) {
    constexpr bool F32 = same_t<TIn, float>::v;
    int tid_o = threadIdx.x; asm volatile("" : "+v"(tid_o));
    const int tid = tid_o, wid = __builtin_amdgcn_readfirstlane(tid >> 6), lane = tid & 63, r32 = lane & 31, hi = lane >> 5;
    const int sr = tid >> 4, sc = (tid & 15) * 8, kws = KSWZ(sr, sc * 2); char* K_lds = lds + 2 * SHM_V;
    const int kb0 = swa_jlo(cur.P0, W) * KVBLK;
    for (int d0 = 0; d0 < 8; ++d0) S.qr[d0] = load8<TIn>(cur.Q + (size_t)(wid * QBLK + r32) * LDQ + d0 * 16 + hi * 8);
    if constexpr (F32) { SLOAD_F((const float*)cur.K, kb0); VMW(); SWRITE_KF(0); SBAR(); SLOAD_F((const float*)cur.V, kb0); }
    else { SLOAD_H(cur.K, cur.V, kb0); VMW(); SWRITE_HK(0); }
    __syncthreads();
}
template <class TIn, class TOut>
__device__ __forceinline__ void causal_swa_block(const BlockRef<TIn, TOut>& cur, const BlockRef<TIn, TOut>& nxt, int skv, int W, char* lds, Seam<TIn>& S) {
    constexpr bool F32 = same_t<TIn, float>::v;
    int tid_o = threadIdx.x; asm volatile("" : "+v"(tid_o));
    const int tid = tid_o, wid = __builtin_amdgcn_readfirstlane(tid >> 6), lane = tid & 63, r32 = lane & 31, hi = lane >> 5;
    const int j_lo = swa_jlo(cur.P0, W);
    int j_hi = (cur.P0 + QB - 1) / KVBLK + 1; if (j_hi > skv / KVBLK) j_hi = skv / KVBLK;
    const int NT = j_hi - j_lo;
    const int kbn = swa_jlo(nxt.P0, W) * KVBLK;
    const int qlo = cur.P0 + wid * QBLK, qm = qlo + r32 - 4 * hi;
    char* V_lds = lds; char* K_lds = lds + 2 * SHM_V;
    float* ws = (float*)(lds + 2 * SHM_V + 2 * SHM_K) + wid * 64; float* li_l = ws, * al_l = ws + 32;
    float m_reg = -1e30f, l_reg = 0; f32x16 o[4] = {};
    const int sr = tid >> 4, sc = (tid & 15) * 8, vst0 = v_st(sr, sc), vst1 = v_st(32 + sr, sc), kws = KSWZ(sr, sc * 2);
    const int vb0 = (int)(uintptr_t)V_lds + v_rd_base(lane);
    const TIn* Kh = cur.K; const TIn* Vh = cur.V;
#define RESC(a) do { if (__any((a) < 1.f)) { if (hi == 0) al_l[r32] = (a); asm volatile("s_waitcnt lgkmcnt(0)" ::: "memory");              \
                     for (int d_ = 0; d_ < 4; ++d_) for (int r = 0; r < 16; ++r) o[d_][r] *= al_l[crow(r, hi)]; } } while (0)
#define KBASE(t) ((j_lo + (t)) * KVBLK)
#define ACT(t) (KBASE(t) <= qlo + QBLK - 1 && KBASE(t) + KVBLK - 1 >= qlo - W + 1)
#define MASKT(P0_, P1_, t) do { const int kb_ = KBASE(t); if ((!SK || ACT(t)) && (kb_ + KVBLK - 1 > qlo || kb_ <= qlo + QBLK - 1 - W)) mask_tile(P0_, P1_, qm - kb_, (unsigned)W); } while (0)
    constexpr int NQL = F32 ? 16 : 8;
    constexpr bool SK = WSKIP && !F32;
#define SEAM_K0() do { VMWN(NQL); if constexpr (F32) { SWRITE_KF(0); SBAR(); SLOAD_F((const float*)nxt.V, kbn); } else { SWRITE_HK(0); } SBAR(); } while (0)
    f32x16 pA0, pA1, pB0, pB1; float mnA, mnB, alA, alB; bf16x8 pa0, pa1, pa2, pa3;
    if constexpr (F32) { VMW(); SWRITE_VF(0); SBAR(); } else { SWRITE_HV(0); SBAR(); }
    if (NT > 1) { if constexpr (F32) SLOAD_F((const float*)Kh, KBASE(1)); else SLOAD_H(Kh, Vh, KBASE(1)); }
    SBAR(); qkt<0, SK>(pA0, pA1, K_lds, r32, hi, S.qr, ACT(0));
    if constexpr (F32) { if (NT > 1) { VMW(); SWRITE_KF(1); SBAR(); SLOAD_F((const float*)Vh, KBASE(1)); } }
    MASKT(pA0, pA1, 0); partialSM(pA0, pA1, m_reg, mnA, alA);
    if (NT > 1) { VMW(); if constexpr (F32) { SWRITE_VF(1); SBAR(); if (NT > 2) SLOAD_F((const float*)Kh, KBASE(2)); } else SWRITE_H(1); }
    __syncthreads();
#define HALF_STEP(PX0, PX1, mnX, alX, PY0, PY1, alY, t, KB, VB, SB) do {                                                      \
        SBAR(); qkt<KB, SK>(PX0, PX1, K_lds, r32, hi, S.qr, ACT(t));                                             \
        finishSM(PY0, PY1, alY, l_reg, pa0, pa1, pa2, pa3); SBAR();                                                           \
        if ((t) + 1 < NT) { if constexpr (F32) { VMW(); SWRITE_KF(SB); SBAR(); SLOAD_F((const float*)Vh, KBASE((t) + 1)); }  \
                            else { SLOAD_H(Kh, Vh, KBASE((t) + 1)); } SBAR(); }                                               \
        pv_tile<VB, SK>(o, vb0, pa0, pa1, pa2, pa3, ACT((t) - 1)); MASKT(PX0, PX1, (t)); partialSM(PX0, PX1, m_reg, mnX, alX);                                        \
        __syncthreads();                                                                                                      \
        if ((t) + 1 < NT) { VMW(); if constexpr (F32) { SWRITE_VF(SB); SBAR(); if ((t) + 2 < NT) SLOAD_F((const float*)Kh, KBASE((t) + 2)); } \
                            else { SWRITE_H(SB); } }                                                                          \
        RESC(alX); __syncthreads(); } while (0)
    for (int t = 1; t + 1 < NT; t += 2) {
        HALF_STEP(pB0, pB1, mnB, alB, pA0, pA1, alA, t, 1, 0, 0);
        HALF_STEP(pA0, pA1, mnA, alA, pB0, pB1, alB, t + 1, 0, 1, 1);
    }
    const bool even = (NT & 1) == 0;
    if (even) { SBAR(); qkt<1, SK>(pB0, pB1, K_lds, r32, hi, S.qr, ACT(NT - 1)); SBAR(); }
#define QROW(e) (nxt.Q + (size_t)(wid * QBLK + r32) * D + ((e) >> 1) * 16 + hi * 8 + ((e) & 1) * 4)
    if constexpr (F32) { SLOAD_F((const float*)nxt.K, kbn); SBAR();
#pragma unroll
        for (int e = 0; e < 8; ++e) S.tq[e] = *(const f32x4*)QROW(e); }
    else { SLOAD_H(nxt.K, nxt.V, kbn); SBAR();
#pragma unroll
        for (int d0 = 0; d0 < 8; ++d0) S.qr[d0] = load8<TIn>(nxt.Q + (size_t)(wid * QBLK + r32) * LDQ + d0 * 16 + hi * 8); }
    SBAR();
    finishSM(pA0, pA1, alA, l_reg, pa0, pa1, pa2, pa3); SBAR();
    if constexpr (F32) {
#pragma unroll
        for (int e = 8; e < 16; ++e) S.tq[e] = *(const f32x4*)QROW(e); SBAR(); }
#undef QROW
    pv_tile<0, SK>(o, vb0, pa0, pa1, pa2, pa3, ACT(even ? NT - 2 : NT - 1));
    if (even) { MASKT(pB0, pB1, NT - 1); partialSM(pB0, pB1, m_reg, mnB, alB); __syncthreads(); RESC(alB);
        finishSM(pB0, pB1, alB, l_reg, pa0, pa1, pa2, pa3); SBAR(); pv_tile<1, SK>(o, vb0, pa0, pa1, pa2, pa3, ACT(NT - 1)); }
    SBAR(); SEAM_K0();
    if (hi == 0) li_l[r32] = l_reg; asm volatile("s_waitcnt lgkmcnt(0)" ::: "memory");
    float rli[16];
#pragma unroll
    for (int r = 0; r < 16; ++r) rli[r] = __builtin_amdgcn_rcpf(li_l[crow(r, hi)]);
    TOut* Ow = cur.O + (size_t)(wid * QBLK) * LDO;
#pragma unroll
    for (int r = 0; r < 16; ++r) { const int orow = crow(r, hi);
#pragma unroll
        for (int d0 = 0; d0 < 4; ++d0) { const float v = o[d0][r] * rli[r];
            if constexpr (same_t<TOut, float>::v) { Ow[(size_t)orow * LDO + d0 * 32 + r32] = v; }
            else { const float vn = swz<1>(v);
                   if ((r32 & 1) == 0) *(unsigned*)(Ow + (size_t)orow * LDO + d0 * 32 + r32) = cvtpk(v, vn); } } }
    if constexpr (F32) {
#pragma unroll
        for (int d0 = 0; d0 < 8; ++d0) S.qr[d0] = pack8(S.tq[2 * d0], S.tq[2 * d0 + 1]); }
    __syncthreads();
#undef RESC
#undef KBASE
#undef ACT
#undef MASKT
#undef SEAM_K0
#undef HALF_STEP
}
#undef ROW
#undef VMW
#undef VMWN
#undef SLOAD_H
#undef SWRITE_HK
#undef SWRITE_HV
#undef SWRITE_H
#undef SLOAD_F
#undef SWRITE_KF
#undef SWRITE_VF

constexpr int P_QB = 128, SHM_VT = 2 * SHM_V;
constexpr int L_K = 0, L_V = 2 * SHM_K, L_P = L_V + 2 * SHM_VT, L_M = L_P + NW * 2048, L_WS = L_M + 2 * NW * 256, PAIR_LDS_BYTES = L_WS + NW * 256;
template <bool HAVE, bool PRE> __device__ __forceinline__ void pair_core(const bf16* Qp, const bf16* Kp, const bf16* V0p, const bf16* V1p, int P0, char* lds, f32x16 (&o)[4], bf16x8 (&sq)[8], bf16x8& sk0, bf16x8& sk1, const bf16* Qn, const bf16* Kn) {
    int tid_o = threadIdx.x; asm volatile("" : "+v"(tid_o));
    const int tid = tid_o, wid = __builtin_amdgcn_readfirstlane(tid >> 6), lane = tid & 63, r32 = lane & 31, hi = lane >> 5;
    const int wq = wid & 3, half = wid >> 2;
    const int NT = (P0 + P_QB) / KVBLK;
    const int qlo = P0 + wq * QBLK, qm = qlo + r32 - 4 * hi;
    char* K_lds = lds + L_K; char* V_lds = lds + L_V;
    float* ws = (float*)(lds + L_WS) + wid * 64; float* li_l = ws; float* al_l = ws + 32;
    float* Mmine = (float*)(lds + L_M) + wid * 64 + lane; const float* Mpart = (const float*)(lds + L_M) + (wid ^ 4) * 64 + lane;
    u32x4* Pmine = (u32x4*)(lds + L_P + wid * 2048) + lane; const u32x4* Ppart = (const u32x4*)(lds + L_P + (wid ^ 4) * 2048) + lane;
    const int sr = tid >> 4, sc = (tid & 15) * 8, vst0 = v_st(sr, sc), vst1 = v_st(32 + sr, sc), kws = KSWZ(sr, sc * 2);
    const int vb0 = (int)(uintptr_t)V_lds + half * SHM_V + v_rd_base(lane);
    const unsigned sof0 = (unsigned)(sr * D + sc) * 2u;
    bf16x8 qr[8];
    bf16x8 st_k0, st_k1, st_v00, st_v01, st_v10, st_v11;
    if constexpr (HAVE) { st_k0 = sk0; st_k1 = sk1; } else { st_k0 = *(const bf16x8*)((const char*)Kp + sof0); st_k1 = *(const bf16x8*)((const char*)Kp + 32 * D * 2 + sof0); }
#pragma unroll
    for (int d0 = 0; d0 < 8; ++d0) { if constexpr (HAVE) qr[d0] = sq[d0]; else qr[d0] = load8<bf16>(Qp + (size_t)(wq * QBLK + r32) * D + d0 * 16 + hi * 8); }
    const char* kb[4];
#pragma unroll
    for (int dd = 0; dd < 4; ++dd) kb[dd] = K_lds + half * (32 * 256) + KSWZ(r32, (dd * 16 + hi * 8) * 2);
    float m_reg = -1e30f, l_reg = 0.f;
#pragma unroll
    for (int d_ = 0; d_ < 4; ++d_) o[d_] = f32x16{};
#define PLOAD(k0) do { st_k0 = load8<bf16>(Kp + (size_t)((k0) + sr) * D + sc); st_k1 = load8<bf16>(Kp + (size_t)((k0) + 32 + sr) * D + sc);            \
                       st_v00 = load8<bf16>(V0p + (size_t)((k0) + sr) * D + sc); st_v01 = load8<bf16>(V0p + (size_t)((k0) + 32 + sr) * D + sc);        \
                       st_v10 = load8<bf16>(V1p + (size_t)((k0) + sr) * D + sc); st_v11 = load8<bf16>(V1p + (size_t)((k0) + 32 + sr) * D + sc); } while (0)
#define PWRITE(bf) do { *(bf16x8*)(K_lds + (bf) * SHM_K + kws) = st_k0; *(bf16x8*)(K_lds + (bf) * SHM_K + kws + 32 * 256) = st_k1;                       \
                        *(bf16x8*)(V_lds + (bf) * SHM_VT + vst0) = st_v00; *(bf16x8*)(V_lds + (bf) * SHM_VT + vst1) = st_v01;                             \
                        *(bf16x8*)(V_lds + (bf) * SHM_VT + SHM_V + vst0) = st_v10; *(bf16x8*)(V_lds + (bf) * SHM_VT + SHM_V + vst1) = st_v11; } while (0)
#define PTRRD(dst, base, off) asm volatile("ds_read_b64_tr_b16 %0, %1 offset:%2" : "=&v"(dst) : "v"(base), "i"(off) : "memory")
#define PPV_D0(d0) do { s16x4 l0, l1, l2, l3, h0, h1, h2, h3; constexpr int b_ = v_rd_off(d0, 0, 0);                                                        \
        PTRRD(l0, vbo, b_); PTRRD(h0, vbo, b_ + 2048); PTRRD(l1, vbo, b_ + 4096); PTRRD(h1, vbo, b_ + 6144); PTRRD(l2, vbp, b_); PTRRD(h2, vbp, b_ + 2048); PTRRD(l3, vbp, b_ + 4096); PTRRD(h3, vbp, b_ + 6144); \
        asm volatile("s_waitcnt lgkmcnt(0)" ::: "memory"); SBAR(); __builtin_amdgcn_s_setprio(1);                                                             \
        o[d0] = __builtin_amdgcn_mfma_f32_32x32x16_bf16(own0_, (bf16x8){l0[0], l0[1], l0[2], l0[3], h0[0], h0[1], h0[2], h0[3]}, o[d0], 0, 0, 0);             \
        o[d0] = __builtin_amdgcn_mfma_f32_32x32x16_bf16(own1_, (bf16x8){l1[0], l1[1], l1[2], l1[3], h1[0], h1[1], h1[2], h1[3]}, o[d0], 0, 0, 0);             \
        o[d0] = __builtin_amdgcn_mfma_f32_32x32x16_bf16(pt0, (bf16x8){l2[0], l2[1], l2[2], l2[3], h2[0], h2[1], h2[2], h2[3]}, o[d0], 0, 0, 0);               \
        o[d0] = __builtin_amdgcn_mfma_f32_32x32x16_bf16(pt1, (bf16x8){l3[0], l3[1], l3[2], l3[3], h3[0], h3[1], h3[2], h3[3]}, o[d0], 0, 0, 0); __builtin_amdgcn_s_setprio(0); } while (0)
#define PPV(vbuf, own0, own1) do { const u32x4 q0_ = Ppart[0], q1_ = Ppart[64]; const bf16x8 pt0 = __builtin_bit_cast(bf16x8, q0_), pt1 = __builtin_bit_cast(bf16x8, q1_), own0_ = own0, own1_ = own1;   \
        const int vbo = vb0 + (vbuf) * SHM_VT + half * 8192, vbp = vb0 + (vbuf) * SHM_VT + (half ^ 1) * 8192; PPV_D0(0); PPV_D0(1); PPV_D0(2); PPV_D0(3); } while (0)
    constexpr float C2 = 1.4426950408889634f * SCALE;
#define PBAR() asm volatile("s_waitcnt lgkmcnt(0)\n\ts_barrier" ::: "memory")
#define PLOADK(k0) do { const char* kt_ = (const char*)Kp + (size_t)(k0) * (D * 2); st_k0 = *(const bf16x8*)(kt_ + sof0); st_k1 = *(const bf16x8*)(kt_ + 32 * D * 2 + sof0); } while (0)
#define PLOADV(k0) do { const char* v0_ = (const char*)V0p + (size_t)(k0) * (D * 2); const char* v1_ = (const char*)V1p + (size_t)(k0) * (D * 2);                          \
                        st_v00 = *(const bf16x8*)(v0_ + sof0); st_v01 = *(const bf16x8*)(v0_ + 32 * D * 2 + sof0); st_v10 = *(const bf16x8*)(v1_ + sof0); st_v11 = *(const bf16x8*)(v1_ + 32 * D * 2 + sof0); } while (0)
#define PWRITEK(bf) do { *(bf16x8*)(K_lds + (bf) * SHM_K + kws) = st_k0; *(bf16x8*)(K_lds + (bf) * SHM_K + kws + 32 * 256) = st_k1; } while (0)
#define PWRITEV(bf) do { *(bf16x8*)(V_lds + (bf) * SHM_VT + vst0) = st_v00; *(bf16x8*)(V_lds + (bf) * SHM_VT + vst1) = st_v01;                            \
                         *(bf16x8*)(V_lds + (bf) * SHM_VT + SHM_V + vst0) = st_v10; *(bf16x8*)(V_lds + (bf) * SHM_VT + SHM_V + vst1) = st_v11; } while (0)
#define PQKT(P, bf) do { P = f32x16{}; bf16x8 kf_[8];                                                                                                     \
        _Pragma("unroll") for (int d0 = 0; d0 < 8; ++d0) kf_[d0] = *reinterpret_cast<const bf16x8*>(kb[d0 & 3] + (d0 >> 2) * 128 + (bf) * SHM_K);            \
        __builtin_amdgcn_s_setprio(1);                                                                                                                  \
        _Pragma("unroll") for (int d0 = 0; d0 < 8; ++d0) P = __builtin_amdgcn_mfma_f32_32x32x16_bf16(kf_[d0], qr[d0], P, 0, 0, 0);                          \
        __builtin_amdgcn_s_setprio(0); } while (0)
#define PMAX(P, t, LM) do { const int kb_ = (t) * KVBLK + half * 32;                                                                                      \
        if (kb_ + 31 > qlo) { const float NEG = -__builtin_inff(); const int dq = qm - kb_;                                                              \
            _Pragma("unroll") for (int r = 0; r < 16; ++r) { const int c = (r & 3) + 8 * (r >> 2); if (dq - c < 0) P[r] = NEG; } }                       \
        LM = fmaxf(fmaxf(P[0], P[1]), P[2]); _Pragma("unroll") for (int r = 3; r < 15; r += 2) LM = fmaxf(fmaxf(LM, P[r]), P[r + 1]); LM = fmaxf(LM, P[15]);                                                                       \
        { auto rr = __builtin_amdgcn_permlane32_swap(__float_as_uint(LM), __float_as_uint(LM), false, false); LM = fmaxf(__uint_as_float(rr[0]), __uint_as_float(rr[1])); } \
        Mmine[((t) & 1) * (NW * 64)] = LM; } while (0)
#define PPK4(P, B_, OUT) do { unsigned a0 = cvtpk(P[B_ + 0], P[B_ + 1]), a1 = cvtpk(P[B_ + 2], P[B_ + 3]), b0 = cvtpk(P[B_ + 4], P[B_ + 5]), b1 = cvtpk(P[B_ + 6], P[B_ + 7]);  \
        auto r0 = __builtin_amdgcn_permlane32_swap(a0, b0, false, false); auto r1 = __builtin_amdgcn_permlane32_swap(a1, b1, false, false);                  \
        u32x4 w = {r0[0], r1[0], r0[1], r1[1]}; OUT = *reinterpret_cast<bf16x8*>(&w); } while (0)
#define PSOFT(P, tt, LM, AL) do { const float pmax = fmaxf(LM, Mpart[((tt) & 1) * (NW * 64)]);                                                           \
        const bool defer = __all((pmax - m_reg) * SCALE <= THR); const float mn = defer ? m_reg : fmaxf(m_reg, pmax);                                    \
        AL = __builtin_amdgcn_exp2f((m_reg - mn) * C2); m_reg = mn; const float mnL = -mn * C2;                                                          \
        _Pragma("unroll") for (int r = 0; r < 16; ++r) P[r] = __builtin_amdgcn_exp2f(fmaf(P[r], C2, mnL));                                               \
        float ps = 0.f; _Pragma("unroll") for (int r = 0; r < 16; ++r) ps += P[r];                                                                        \
        { auto rr = __builtin_amdgcn_permlane32_swap(__float_as_uint(ps), __float_as_uint(ps), false, false); ps = __uint_as_float(rr[0]) + __uint_as_float(rr[1]); } \
        l_reg = l_reg * AL + ps; PPK4(P, 0, pa_o0); PPK4(P, 8, pa_o1);                                                                                    \
        Pmine[0] = __builtin_bit_cast(u32x4, pa_o0); Pmine[64] = __builtin_bit_cast(u32x4, pa_o1); } while (0)
#define PRESC(AL) do { if (__any((AL) < 1.f)) { if (hi == 0) al_l[r32] = (AL); asm volatile("s_waitcnt lgkmcnt(0)" ::: "memory");                       \
        _Pragma("unroll") for (int d_ = 0; d_ < 4; ++d_) _Pragma("unroll") for (int r = 0; r < 16; ++r) o[d_][r] *= al_l[crow(r, hi)]; } } while (0)
    bf16x8 pa_o0 = {}, pa_o1 = {};
    f32x16 p_old, p_new; float lm_old, lm_new, alpha;
    PWRITEK(0);
    PBAR();
    PLOADK(KVBLK); PLOADV(0);
    PQKT(p_old, 0); PMAX(p_old, 0, lm_old);
    PBAR();
    PWRITEK(1);
    PBAR();
#define PSTEP(PO, LMO, PN, LMN, t_, LAST) do { const int bf = (t_) & 1; const int tn = ((t_) + 1 < NT) ? (t_) + 1 : NT - 1;                                     \
        PWRITEV(bf ^ 1);                                                                                                                                     \
        if (!(LAST)) { PLOADK(tn * KVBLK); PLOADV((t_) * KVBLK); PQKT(PN, bf); }                                                                              \
        PSOFT(PO, (t_) - 1, LMO, alpha);                                                                                                                     \
        if (!(LAST)) { PMAX(PN, (t_), LMN); }                                                                                                                 \
        PRESC(alpha);                                                                                                                                        \
        PBAR();                                                                                                                                              \
        if (!(LAST)) { PWRITEK(bf ^ 1); }                                                                                                                     \
        PPV(bf ^ 1, pa_o0, pa_o1);                                                                                                                           \
        PBAR(); } while (0)
    for (int t = 1; t < NT; t += 2) { PSTEP(p_old, lm_old, p_new, lm_new, t, false); PSTEP(p_new, lm_new, p_old, lm_old, t + 1, (t + 1 == NT)); }
    if constexpr (PRE) {
#pragma unroll
        for (int d0 = 0; d0 < 8; ++d0) sq[d0] = load8<bf16>(Qn + (size_t)(wq * QBLK + r32) * D + d0 * 16 + hi * 8);
        sk0 = *(const bf16x8*)((const char*)Kn + sof0); sk1 = *(const bf16x8*)((const char*)Kn + 32 * D * 2 + sof0);
    }
    *Mmine = l_reg;
    PBAR();
    const float l_tot = l_reg + *Mpart;
    if (hi == 0) li_l[r32] = l_tot; asm volatile("s_waitcnt lgkmcnt(0)" ::: "memory");
    float rli[16];
#pragma unroll
    for (int r = 0; r < 16; ++r) rli[r] = __builtin_amdgcn_rcpf(li_l[crow(r, hi)]);
#pragma unroll
    for (int r = 0; r < 16; ++r)
#pragma unroll
        for (int d0 = 0; d0 < 4; ++d0) o[d0][r] *= rli[r];
    PBAR();
#undef PLOAD
#undef PWRITE
#undef PTRRD
#undef PPV_D0
#undef PPV
#undef PPK4
#undef PBAR
#undef PSTEP
#undef PLOADK
#undef PLOADV
#undef PWRITEK
#undef PWRITEV
#undef PQKT
#undef PMAX
#undef PSOFT
#undef PRESC
}

__device__ __forceinline__ void diff_block(const bf16* Qp, const bf16* Kp, const bf16* V0p, const bf16* V1p, int P0, char* lds, float lam, float oscale, const float* gain, unsigned short* mixrow0, int plane, u32x4* park) {
    f32x16 o[4];
    bf16x8 sq[8], sk0, sk1;
    pair_core<false, true>(Qp, Kp, V0p, V1p, P0, lds, o, sq, sk0, sk1, Qp + (size_t)plane, Kp + (size_t)plane);
    { int t2 = threadIdx.x; asm volatile("" : "+v"(t2)); u32x4* pk = park + (t2 >> 6) * 512 + (t2 & 63);
#pragma unroll
        for (int d0 = 0; d0 < 4; ++d0)
#pragma unroll
            for (int j4 = 0; j4 < 2; ++j4) { u32x4 w; w.x = cvtpk(o[d0][8 * j4], o[d0][8 * j4 + 1]); w.y = cvtpk(o[d0][8 * j4 + 2], o[d0][8 * j4 + 3]); w.z = cvtpk(o[d0][8 * j4 + 4], o[d0][8 * j4 + 5]); w.w = cvtpk(o[d0][8 * j4 + 6], o[d0][8 * j4 + 7]);
                pk[(d0 * 2 + j4) * 64] = w; } }
    pair_core<true, false>(Qp + (size_t)plane, Kp + (size_t)plane, V0p, V1p, P0, lds, o, sq, sk0, sk1, Qp, Kp);
    int tid_o = threadIdx.x; asm volatile("" : "+v"(tid_o));
    const int tid = tid_o, wid = __builtin_amdgcn_readfirstlane(tid >> 6), lane = tid & 63, r32 = lane & 31, hi = lane >> 5, wq = wid & 3, half = wid >> 2;
    unsigned op[4][8];
    { const u32x4* pk = park + wid * 512 + lane;
#pragma unroll
        for (int d0 = 0; d0 < 4; ++d0)
#pragma unroll
            for (int j4 = 0; j4 < 2; ++j4) { const u32x4 w = pk[(d0 * 2 + j4) * 64]; op[d0][4 * j4] = w.x; op[d0][4 * j4 + 1] = w.y; op[d0][4 * j4 + 2] = w.z; op[d0][4 * j4 + 3] = w.w; } }
    float q[16];
#pragma unroll
    for (int r = 0; r < 16; ++r) { q[r] = 0.f;
#pragma unroll
        for (int d0 = 0; d0 < 4; ++d0) { const unsigned w = op[d0][r >> 1]; const float a = (r & 1) ? __uint_as_float(w & 0xffff0000u) : __uint_as_float(w << 16);
            const float d = a - lam * o[d0][r]; o[d0][r] = d; q[r] += d * d; } }
#pragma unroll
    for (int r = 0; r < 16; ++r) { q[r] += swz<1>(q[r]); q[r] += swz<2>(q[r]); q[r] += swz<4>(q[r]); q[r] += swz<8>(q[r]); q[r] += swz<16>(q[r]); }
    float* X = (float*)(lds + L_M) + wid * 64; const float* Xp = (const float*)(lds + L_M) + (wid ^ 4) * 64;
    if (r32 == 0) {
#pragma unroll
        for (int r = 0; r < 16; ++r) X[crow(r, hi)] = q[r];
    }
    asm volatile("s_waitcnt lgkmcnt(0)\n\ts_barrier" ::: "memory");
    float g[4];
#pragma unroll
    for (int d0 = 0; d0 < 4; ++d0) g[d0] = gain[half * 128 + d0 * 32 + r32];
    unsigned short* orow = mixrow0 + (size_t)(wq * QBLK) * 2048 + half * 128;
#pragma unroll
    for (int r = 0; r < 16; ++r) { const int rw = crow(r, hi); const float ss = q[r] + Xp[rw]; const float rs = oscale / sqrtf(ss * (1.0f / 256.0f) + 1e-6f);
#pragma unroll
        for (int d0 = 0; d0 < 4; ++d0) { const float v = o[d0][r] * rs * g[d0];
            orow[(size_t)rw * 2048 + d0 * 32 + r32] = (unsigned short)cvtpk(v, v); } }
    asm volatile("s_waitcnt lgkmcnt(0)\n\ts_barrier" ::: "memory");
}
}
constexpr int BATCH = 8, SEQ = 4096, DM = 2048, DEPTH = 2, M = BATCH * SEQ;
constexpr int NZ = 5632, DFF = 5632;
constexpr float RMS_EPS = 1e-6f, LN_EPS = 1e-5f;
constexpr int NWAVES = 8;
#ifndef MK_PER_PHASE
#define MK_PER_PHASE 0
#endif
constexpr int LPH = 6;
constexpr int N_PHASES = 2 + LPH * DEPTH;
#ifndef REP_P0
#define REP_P0 1
#endif
#ifndef REP_GEMM
#define REP_GEMM 1
#endif
#ifndef REP_THIN
#define REP_THIN 1
#endif
#ifndef REP_MIX
#define REP_MIX 1
#endif
#ifndef REP_ATT
#define REP_ATT 1
#endif
constexpr size_t MiB = 1u << 20;
constexpr size_t WS_ROPE = 1 * MiB;
constexpr size_t WS_W = 17 * MiB, W_LAYER = 96 * MiB;
constexpr size_t WO_IN = 0, WO_OUT = 22 * MiB, WO_GU = 30 * MiB, WO_DOWN = 74 * MiB;
constexpr size_t WS_Z = 210 * MiB;
constexpr size_t WS_H = 562 * MiB;
constexpr size_t WS_MIX = 690 * MiB;
constexpr size_t WS_V = 818 * MiB;
constexpr size_t WS_O = 882 * MiB;
constexpr size_t WS_END = 1015 * MiB;
constexpr int LDS_BYTES = 136192;

#define LAS __attribute__((address_space(3)))
typedef unsigned short bf16;
typedef unsigned v4u __attribute__((ext_vector_type(4)));
typedef unsigned v2u __attribute__((ext_vector_type(2)));
typedef float f32x4 __attribute__((ext_vector_type(4)));
typedef short bf16x8 __attribute__((ext_vector_type(8)));
#define LDS_WAIT() asm volatile("s_waitcnt lgkmcnt(0)" ::: "memory")
__device__ __forceinline__ unsigned f2bf(float f) { unsigned u = __builtin_bit_cast(unsigned, f); return (u + 0x7fffu + ((u >> 16) & 1u)) >> 16; }
__device__ __forceinline__ unsigned pk2(float lo, float hi) { return f2bf(lo) | (f2bf(hi) << 16); }
__device__ __forceinline__ float bflo(unsigned w) { return __uint_as_float(w << 16); }
__device__ __forceinline__ float bfhi(unsigned w) { return __uint_as_float(w & 0xffff0000u); }
__device__ __forceinline__ void unpack8(const v4u w, float* f) { f[0] = bflo(w.x); f[1] = bfhi(w.x); f[2] = bflo(w.y); f[3] = bfhi(w.y); f[4] = bflo(w.z); f[5] = bfhi(w.z); f[6] = bflo(w.w); f[7] = bfhi(w.w); }
__device__ __forceinline__ v4u pack8f(const float* f) { v4u w; w.x = pk2(f[0], f[1]); w.y = pk2(f[2], f[3]); w.z = pk2(f[4], f[5]); w.w = pk2(f[6], f[7]); return w; }
__device__ __forceinline__ float wave_sum(float v) { v += swz<1>(v); v += swz<2>(v); v += swz<4>(v); v += swz<8>(v); v += swz<16>(v); return sum32(v); }
__device__ __forceinline__ float gelu_exact(float v) {
    const float av = fabsf(v), t = __builtin_amdgcn_rcpf(av * 0.2316418882f + 1.0f);
    float q = t * 0.5307027145f + (-0.7265760135f); q = q * t + 0.7107068705f; q = q * t + (-0.142248368f); q = q * t + 0.127414796f; q = q * t;
    const float e = __builtin_amdgcn_exp2f((v * v) * (-0.72134752044f));
    const float m = v * (q * e);
    return v < 0.f ? m : v - m;
}

__device__ __forceinline__ void transpose_item(const float* W, int K, int N, bf16* WT, int k0, int n0, int drow0, const float* gain, LAS float* scr, int lane) {
    float wv[32];
    const float* wp = W + (size_t)(k0 + (lane >> 5)) * N + n0 + (lane & 31);
#pragma unroll
    for (int i = 0; i < 32; ++i) wv[i] = wp[(size_t)(2 * i) * N];
    if (gain) {
#pragma unroll
        for (int i = 0; i < 32; ++i) wv[i] *= gain[k0 + 2 * i + (lane >> 5)];
    }
#pragma unroll
    for (int i = 0; i < 32; ++i) scr[(2 * i + (lane >> 5)) * 33 + (lane & 31)] = wv[i];
    LDS_WAIT(); asm volatile("" ::: "memory");
    const int c = lane & 7;
#pragma unroll
    for (int j = 0; j < 4; ++j) { const int n = (lane >> 3) + 8 * j; const LAS float* s = scr + (8 * c) * 33 + n;
        v4u o; o.x = pk2(s[0 * 33], s[1 * 33]); o.y = pk2(s[2 * 33], s[3 * 33]); o.z = pk2(s[4 * 33], s[5 * 33]); o.w = pk2(s[6 * 33], s[7 * 33]);
        *(v4u*)(WT + (size_t)(drow0 + n) * K + k0 + 8 * c) = o; }
    LDS_WAIT(); asm volatile("" ::: "memory");
}
__device__ __forceinline__ void x_row_to_bf16(const float* xrow, bf16* orow, float* ssq, int lane) {
    const f32x4* xr = (const f32x4*)xrow + lane; f32x4 v[8]; float s = 0.f;
#pragma unroll
    for (int j = 0; j < 8; ++j) { v[j] = xr[64 * j]; s += (v[j].x * v[j].x + v[j].y * v[j].y) + (v[j].z * v[j].z + v[j].w * v[j].w); }
    s = wave_sum(s);
#pragma unroll
    for (int j = 0; j < 8; ++j) { v2u w; w.x = pk2(v[j].x, v[j].y); w.y = pk2(v[j].z, v[j].w); ((v2u*)orow + lane)[64 * j] = w; }
    if (lane < 8) ssq[lane] = lane == 0 ? s : 0.f;
}
__device__ __forceinline__ void final_row(const bf16* xrow, float ssq, const float* g, float* orow, int lane) {
    const float rstd = 1.0f / sqrtf(ssq * (1.0f / DM) + RMS_EPS);
#pragma unroll
    for (int j = 0; j < 4; ++j) { const int c = 8 * lane + 512 * j; float x[8]; unpack8(*(const v4u*)(xrow + c), x);
        const f32x4 g0 = *(const f32x4*)(g + c), g1 = *(const f32x4*)(g + c + 4);
        *(f32x4*)(orow + c) = (f32x4){x[0] * rstd * g0[0], x[1] * rstd * g0[1], x[2] * rstd * g0[2], x[3] * rstd * g0[3]};
        *(f32x4*)(orow + c + 4) = (f32x4){x[4] * rstd * g1[0], x[5] * rstd * g1[1], x[6] * rstd * g1[2], x[7] * rstd * g1[3]}; }
}
typedef __attribute__((address_space(1))) unsigned gu32;
constexpr size_t WS_CTL = 0, CTL_ZERO_BYTES = 65536; constexpr int CW_BAR = 4096;
constexpr size_t WS_SSQ = 1010 * MiB;
constexpr int MISC_OFF = 131072, PSTAT_OFF = 131072 + 64;
#define XB_TMO      128
#define XB_XCNT(j)  (256  + 64 * (j))
#define XB_XSUB(j)  (1280 + 64 * (j))
#define XB_XGEN(j)  (2304 + 64 * (j))
#define XB_TOP      3328
#define XB_TOPGEN   3392
#define XCD_BAR_WORDS 3456
#define XB_SPIN_CAP (1u << 18)

__device__ __forceinline__ unsigned xb_ld(unsigned* p)              { return __hip_atomic_load(p, __ATOMIC_RELAXED, __HIP_MEMORY_SCOPE_AGENT); }
__device__ __forceinline__ unsigned xb_add(unsigned* p, unsigned v) { return __hip_atomic_fetch_add(p, v, __ATOMIC_RELAXED, __HIP_MEMORY_SCOPE_AGENT); }
__device__ __forceinline__ unsigned xb_xcc_id() { return (unsigned)__builtin_amdgcn_s_getreg((3 << 11) | 20) & 0xFu; }
#define XB_SPIN(cond, bar) do { unsigned _sp = 0; while (cond) { __builtin_amdgcn_s_sleep(1); \
    if ((++_sp & 255u) == 0u) { if (xb_ld(&(bar)[XB_TMO])) break; if (_sp > XB_SPIN_CAP) { atomicAdd(&(bar)[XB_TMO], 1u); break; } } } } while (0)

struct XcdBarrier {
    unsigned* bar; unsigned x;
    volatile LAS unsigned* st;
};

__device__ __forceinline__ XcdBarrier xcd_barrier_post(unsigned* bar, volatile LAS unsigned* st) {
    XcdBarrier b; b.bar = bar; b.x = xb_xcc_id(); b.st = st;
    if (threadIdx.x == 0) (void)xb_add(&bar[XB_XCNT(b.x)], 1u);
    return b;
}
__device__ __forceinline__ void xcd_barrier_complete(unsigned* bar, unsigned x, unsigned& nloc, unsigned& nx) {
    const unsigned G = gridDim.x * gridDim.y * gridDim.z;
    unsigned sum, cnt, mine, sp = 0u;
    for (;;) {
        sum = 0u; cnt = 0u; mine = 0u;
#pragma unroll
        for (unsigned j = 0; j < 16; ++j) { const unsigned c = xb_ld(&bar[XB_XCNT(j)]); sum += c; cnt += (c > 0u) ? 1u : 0u; mine = (j == x) ? c : mine; }
        if (sum == G) break;
        __builtin_amdgcn_s_sleep(1);
        if ((++sp & 255u) == 0u) { if (xb_ld(&bar[XB_TMO])) break; if (sp > XB_SPIN_CAP) { atomicAdd(&bar[XB_TMO], 1u); break; } }
    }
    nloc = mine > 0u ? mine : 1u; nx = cnt > 0u ? cnt : 1u;
}

__device__ __forceinline__ void xcd_barrier(const XcdBarrier& b) {
    asm volatile("s_waitcnt vmcnt(0)" ::: "memory");
    __syncthreads();
    if (threadIdx.x == 0) {
        unsigned* bar = b.bar;
        __builtin_amdgcn_s_waitcnt(0);
        unsigned nloc = b.st[0], nx = b.st[1];
        if (nloc == 0u) { xcd_barrier_complete(bar, b.x, nloc, nx); b.st[0] = nloc; b.st[1] = nx; }
        const unsigned old = xb_add(&bar[XB_XSUB(b.x)], 1u);
        const unsigned gen = old / nloc;
        if (old + 1u == (gen + 1u) * nloc) {
            __builtin_amdgcn_fence(__ATOMIC_RELEASE, "agent");
            asm volatile("s_waitcnt vmcnt(0)" ::: "memory");
            const unsigned og = xb_add(&bar[XB_TOP], 1u);
            const unsigned tg = og / nx;
            if (og + 1u == (tg + 1u) * nx) xb_add(&bar[XB_TOPGEN], 1u);
            else XB_SPIN(xb_ld(&bar[XB_TOPGEN]) == tg, bar);
            __builtin_amdgcn_fence(__ATOMIC_ACQUIRE, "agent");
            xb_add(&bar[XB_XGEN(b.x)], 1u);
            asm volatile("s_waitcnt vmcnt(0)" ::: "memory");
        } else {
            XB_SPIN(xb_ld(&bar[XB_XGEN(b.x)]) == gen, bar);
            __builtin_amdgcn_fence(__ATOMIC_ACQUIRE, "agent");
            asm volatile("s_waitcnt vmcnt(0)" ::: "memory");
        }
    }
    __syncthreads();
}
struct Args { const void* in[20]; float* out; unsigned char* ws; int ph_lo, ph_hi; };

__device__ __forceinline__ void gmlp_unit(int unit, const bf16* z, bf16* mix, const float* ln_g, const float* ln_b, const float* wsp, const float* bsp, const float* mixn,
                                          LAS unsigned char* lds, int tid, int lane, int wave) {
    const int g = unit & 3, n = (unit >> 2) & 31, b = unit >> 7;
    const size_t row0 = (size_t)b * SEQ + (size_t)n * 128;
    LAS unsigned short* vnT = (LAS unsigned short*)lds;
    {
        const int s = tid >> 2, cq = tid & 3;
        const bf16* src = z + (row0 + s) * NZ + 512 + g * 128 + cq * 32;
        float v[32]; float sum = 0.f;
#pragma unroll
        for (int i = 0; i < 4; ++i) { const v4u w = *(const v4u*)(src + i * 8); unpack8(w, v + i * 8); }
#pragma unroll
        for (int i = 0; i < 32; ++i) { v[i] = gelu_exact(v[i]); sum += v[i]; }
        sum += swz<1>(sum); sum += swz<2>(sum);
        const float mu = sum * (1.0f / 128.0f); float q = 0.f;
#pragma unroll
        for (int i = 0; i < 32; ++i) { v[i] -= mu; q += v[i] * v[i]; }
        q += swz<1>(q); q += swz<2>(q);
        const float rstd = 1.0f / sqrtf(q * (1.0f / 128.0f) + LN_EPS);
        const float* gp = ln_g + g * 128 + cq * 32; const float* bp = ln_b + g * 128 + cq * 32;
#pragma unroll
        for (int i = 0; i < 8; ++i) { const f32x4 gg = *(const f32x4*)(gp + 4 * i), bb = *(const f32x4*)(bp + 4 * i);
#pragma unroll
            for (int e = 0; e < 4; ++e) { const float vn = v[4 * i + e] * rstd * gg[e] + bb[e]; vnT[(cq * 32 + 4 * i + e) * 136 + s] = (unsigned short)f2bf(vn); } }
    }
    __syncthreads();
    {
        const int tcol = lane & 15, quad = lane >> 4, t = 16 * wave + tcol, nks = (wave >> 1) + 1;
        f32x4 acc[8];
#pragma unroll
        for (int ct = 0; ct < 8; ++ct) acc[ct] = (f32x4){0.f, 0.f, 0.f, 0.f};
        const float* wrow = wsp + ((size_t)g * 128 + t) * 128;
        for (int ks = 0; ks < nks; ++ks) {
            const int s0 = 32 * ks + 8 * quad;
            const f32x4 w0 = *(const f32x4*)(wrow + s0), w1 = *(const f32x4*)(wrow + s0 + 4);
            float wf[8] = {w0[0], w0[1], w0[2], w0[3], w1[0], w1[1], w1[2], w1[3]};
#pragma unroll
            for (int e = 0; e < 8; ++e) if (s0 + e > t) wf[e] = 0.f;
            const v4u bw = pack8f(wf); const bf16x8 bfrag = __builtin_bit_cast(bf16x8, bw);
#pragma unroll
            for (int ct = 0; ct < 8; ++ct) { const bf16x8 a = *(const LAS bf16x8*)(vnT + (16 * ct + tcol) * 136 + s0);
                acc[ct] = __builtin_amdgcn_mfma_f32_16x16x32_bf16(a, bfrag, acc[ct], 0, 0, 0); }
        }
        const float bst = bsp[g * 128 + t];
        const size_t m = row0 + t; const bf16* up = z + m * NZ + g * 128 + 4 * quad; float ss = 0.f;
#pragma unroll
        for (int ct = 0; ct < 8; ++ct) { const v2u uw = *(const v2u*)(up + 16 * ct);
            const float u0 = gelu_exact(bflo(uw.x)), u1 = gelu_exact(bfhi(uw.x)), u2 = gelu_exact(bflo(uw.y)), u3 = gelu_exact(bfhi(uw.y));
            acc[ct][0] = u0 * (acc[ct][0] + bst); acc[ct][1] = u1 * (acc[ct][1] + bst); acc[ct][2] = u2 * (acc[ct][2] + bst); acc[ct][3] = u3 * (acc[ct][3] + bst);
            ss += (acc[ct][0] * acc[ct][0] + acc[ct][1] * acc[ct][1]) + (acc[ct][2] * acc[ct][2] + acc[ct][3] * acc[ct][3]); }
        ss += swz<16>(ss); ss = sum32(ss);
        const float r = 1.0f / sqrtf(ss * (1.0f / 128.0f) + RMS_EPS);
        bf16* op = mix + m * DM + g * 128 + 4 * quad; const float* np = mixn + g * 128 + 4 * quad;
        f32x4 gnv[8];
#pragma unroll
        for (int ct = 0; ct < 8; ++ct) gnv[ct] = *(const f32x4*)(np + 16 * ct);
#pragma unroll
        for (int ct = 0; ct < 8; ++ct) { const f32x4 gn = gnv[ct]; v2u w;
            w.x = pk2(acc[ct][0] * r * gn[0], acc[ct][1] * r * gn[1]); w.y = pk2(acc[ct][2] * r * gn[2], acc[ct][3] * r * gn[3]); *(v2u*)(op + 16 * ct) = w; }
    }
    __syncthreads();
}

#define OPQ_V(x) asm volatile("" : "+v"(x))
__global__ void __launch_bounds__(NWAVES * 64, 2) hymba_fwd(Args args) {
    extern __shared__ __attribute__((aligned(16))) unsigned char lds[];
    {
        if (threadIdx.x < 32) ((LAS unsigned*)((LAS unsigned char*)lds + MISC_OFF))[threadIdx.x] = 0u;
        __syncthreads();
        (void)xcd_barrier_post((unsigned*)(args.ws + WS_CTL) + CW_BAR, (volatile LAS unsigned*)((LAS unsigned char*)lds + MISC_OFF));
    }
    if (args.ph_lo == 0) {
        const int p = 0;
        LAS unsigned char* ldsp = (LAS unsigned char*)lds;
        int tid = threadIdx.x; OPQ_V(tid);
        const int lane = tid & 63, wave = __builtin_amdgcn_readfirstlane(tid >> 6);
        int zs = 0; asm volatile("" : "+s"(zs));
        const int G = gridDim.x + zs, bx = blockIdx.x + zs, vcu = (G % 8 == 0) ? (bx % 8) * (G / 8) + bx / 8 : bx;
        const int gw = vcu * NWAVES + wave, NGW = G * NWAVES;
        unsigned char* ws = args.ws;
        float* xo = args.out;
        bf16* Z = (bf16*)(ws + WS_Z); bf16* Hb = (bf16*)(ws + WS_H); bf16* MIX = (bf16*)(ws + WS_MIX); bf16* VB = (bf16*)(ws + WS_V); bf16* OB = (bf16*)(ws + WS_O);
        float* ctab = (float*)(ws + WS_ROPE); float* stab = ctab + (size_t)M * 64;
        const bool fin = (p == N_PHASES - 1); const int l = fin ? 0 : (p - 1) / LPH, kk = (p - 1) % LPH, k = fin ? 7 : (p == 0) ? -1 : (kk <= 2 ? kk : kk + 1);
        float* ssq = (float*)(ws + WS_SSQ); bf16* QKb = (bf16*)args.out;
        unsigned char* wl = ws + WS_W + (size_t)l * W_LAYER;
        const float* mixn = (const float*)args.in[13] + (size_t)l * DM;
        {
            const float* x_in = (const float*)args.in[0]; const int* positions = (const int*)args.in[1];
            LAS float* scr = (LAS float*)(ldsp + wave * 16384);
            constexpr int I_IN = 32 * 176, I_OUT = 32 * 64, I_G = 32 * 176, I_DN = 88 * 64, I_LAYER = I_IN + I_OUT + 2 * I_G + I_DN;
            for (int it = gw; it < DEPTH * I_LAYER; it += NGW) {
                const int ll = it / I_LAYER; int r = it - ll * I_LAYER;
                unsigned char* wll = ws + WS_W + (size_t)ll * W_LAYER;
                if (r < I_IN) { const int kb = r / 176, nb = r % 176, n0 = 32 * nb, o = n0 & 255;
                    const int dr = (n0 >= 1024 && n0 < 3072) ? (n0 & ~255) + 128 * ((o >> 6) & 1) + 64 * (o >> 7) + (o & 63) : n0;
                    transpose_item((const float*)args.in[3] + (size_t)ll * DM * NZ, DM, NZ, (bf16*)(wll + WO_IN), 64 * kb, n0, dr, (const float*)args.in[2] + ll * DM, scr, lane); continue; } r -= I_IN;
                if (r < I_OUT) { const int kb = r / 64, nb = r % 64; transpose_item((const float*)args.in[14] + (size_t)ll * DM * DM, DM, DM, (bf16*)(wll + WO_OUT), 64 * kb, 32 * nb, 32 * nb, nullptr, scr, lane); continue; } r -= I_OUT;
                if (r < 2 * I_G) { const int up = r >= I_G; if (up) r -= I_G; const int kb = r / 176, nb = r % 176, n0 = 32 * nb;
                    transpose_item((const float*)args.in[up ? 17 : 16] + (size_t)ll * DM * DFF, DM, DFF, (bf16*)(wll + WO_GU), 64 * kb, n0, (n0 >> 7) * 256 + (n0 & 127) + (up ? 128 : 0), (const float*)args.in[15] + ll * DM, scr, lane); continue; } r -= 2 * I_G;
                { const int kb = r / 64, nb = r % 64; transpose_item((const float*)args.in[18] + (size_t)ll * DFF * DM, DFF, DM, (bf16*)(wll + WO_DOWN), 64 * kb, 32 * nb, 32 * nb, nullptr, scr, lane); }
            }
            for (int e = vcu * 512 + tid; e < M * 64; e += G * 512) { const int m = e >> 6, j = e & 63;
                const float inv_freq = 1.0f / powf(10000.0f, (float)(2 * j) * (1.0f / 128.0f)); const float ang = (float)positions[m] * inv_freq;
                float sn, cs; sincosf(ang, &sn, &cs); ctab[e] = cs; stab[e] = sn; }
            {
                f32x4 va[8], vb[8];
#define XLD(V, m_) do { const f32x4* xr_ = (const f32x4*)(x_in + (size_t)(m_) * DM) + lane; _Pragma("unroll") for (int j = 0; j < 8; ++j) V[j] = xr_[64 * j]; } while (0)
#define XST(V, m_) do { float s_ = 0.f; _Pragma("unroll") for (int j = 0; j < 8; ++j) s_ += (V[j].x * V[j].x + V[j].y * V[j].y) + (V[j].z * V[j].z + V[j].w * V[j].w); s_ = wave_sum(s_);            \
        v2u* o_ = (v2u*)(Hb + (size_t)(m_) * DM) + lane; _Pragma("unroll") for (int j = 0; j < 8; ++j) { v2u w_; w_.x = pk2(V[j].x, V[j].y); w_.y = pk2(V[j].z, V[j].w); o_[64 * j] = w_; }                 \
        float* q_ = (float*)(ws + WS_SSQ) + (size_t)(m_) * 8; if (lane < 8) q_[lane] = lane == 0 ? s_ : 0.f; } while (0)
                XLD(va, gw);
                for (int m = gw; m < M; m += 2 * NGW) {
                    XLD(vb, m + NGW); XST(va, m);
                    if (m + 2 * NGW < M) XLD(va, m + 2 * NGW);
                    XST(vb, m + NGW); }
#undef XLD
#undef XST
            }
        }
        if (1 < args.ph_hi) { XcdBarrier bar; bar.bar = (unsigned*)(args.ws + WS_CTL) + CW_BAR; bar.x = xb_xcc_id(); bar.st = (volatile LAS unsigned*)((LAS unsigned char*)lds + MISC_OFF); xcd_barrier(bar); }
        if (args.ph_hi < 0) cg::this_grid().sync();
    }
    for (int p = (args.ph_lo == 0 ? 1 : args.ph_lo); p < args.ph_hi; ++p) {
        LAS unsigned char* ldsp = (LAS unsigned char*)lds;
        int zs = 0; asm volatile("" : "+s"(zs));
        const int G = gridDim.x + zs, bx = blockIdx.x + zs, vcu = (G % 8 == 0) ? (bx % 8) * (G / 8) + bx / 8 : bx;
        const int NGW = G * NWAVES;
#define PHASE_IDS() int tid = threadIdx.x; OPQ_V(tid); const int lane = tid & 63, wave = __builtin_amdgcn_readfirstlane(tid >> 6); const int gw = vcu * NWAVES + wave; (void)gw; (void)lane
        unsigned char* ws = args.ws;
        float* xo = args.out;
        bf16* Z = (bf16*)(ws + WS_Z); bf16* Hb = (bf16*)(ws + WS_H); bf16* MIX = (bf16*)(ws + WS_MIX); bf16* VB = (bf16*)(ws + WS_V); bf16* OB = (bf16*)(ws + WS_O);
        float* ctab = (float*)(ws + WS_ROPE); float* stab = ctab + (size_t)M * 64;
        const bool fin = (p == N_PHASES - 1); const int l = fin ? 0 : (p - 1) / LPH, kk = (p - 1) % LPH, k = fin ? 7 : (p == 0) ? -1 : (kk <= 2 ? kk : kk + 1);
        float* ssq = (float*)(ws + WS_SSQ); bf16* QKb = (bf16*)args.out;
        unsigned char* wl = ws + WS_W + (size_t)l * W_LAYER;
        const float* mixn = (const float*)args.in[13] + (size_t)l * DM;
#ifdef ONLY_ATT
        if (k != 2) continue;
#endif
        if (k == 0) {
            pg8::Gemm g{Hb, (const bf16*)(wl + WO_IN), M, NZ, DM}; pg8::StaticOrder S; S.init(M, NZ, G, bx);
            const float* sqp = ssq + (size_t)(2 * l) * M * 8;
            int pmA, pmB; { pg8::Unit u0; S.next(0, u0); pmA = pmB = u0.pm; for (int i = 1; S.next(i, u0); ++i) if (u0.pm != pmA) { pmB = u0.pm; break; } }
            { int t = threadIdx.x; OPQ_V(t); ((LAS float*)(ldsp + PSTAT_OFF))[t] = pg8::row_rstd(sqp, (t < 256 ? pmA : pmB) * 256 + (t & 255)); }
            __syncthreads();
            const pg8::RsTab T{(const LAS float*)(ldsp + PSTAT_OFF), pmA, pmB, sqp};
            pg8::EpiIn E{Z, NZ, T, QKb, VB, ctab, stab};
            pg8::gemm_phase<pg8::EpiIn, pg8::StaticOrder, PG8_ALIGN, PG8_SP2>(ldsp, g, S, E);
        } else if (k == 1) {
            PHASE_IDS();
            {
                const float* cw = (const float*)args.in[12] + (size_t)l * 3 * 512 + lane * 8;
                float w0[8], w1[8], w2[8], gn[8];
#pragma unroll
                for (int h2 = 0; h2 < 2; ++h2) { const f32x4 a = *(const f32x4*)(cw + 4 * h2), b = *(const f32x4*)(cw + 512 + 4 * h2), c = *(const f32x4*)(cw + 1024 + 4 * h2), d = *(const f32x4*)(mixn + 1536 + lane * 8 + 4 * h2);
#pragma unroll
                    for (int e = 0; e < 4; ++e) { w0[4 * h2 + e] = a[e]; w1[4 * h2 + e] = b[e]; w2[4 * h2 + e] = c[e]; gn[4 * h2 + e] = d[e]; } }
                v4u ra[7], rb7[7];
#define CLD(R, m_) do { const int t_ = (m_) & (SEQ - 1); const bf16* zr_ = Z + (size_t)(m_) * NZ + lane * 8; const bf16* z1_ = zr_ - (t_ >= 1 ? NZ : 0); const bf16* z2_ = zr_ - (t_ >= 2 ? 2 * NZ : 0);   \
        R[0] = *(const v4u*)(zr_ + 4096); R[1] = *(const v4u*)(zr_ + 4608); R[2] = *(const v4u*)(zr_ + 5120); R[3] = *(const v4u*)(z1_ + 4608); R[4] = *(const v4u*)(z1_ + 5120);                          \
        R[5] = *(const v4u*)(z2_ + 4608); R[6] = *(const v4u*)(z2_ + 5120); } while (0)
#define CST(R, m_) do { const int t_ = (m_) & (SEQ - 1); const float f1 = t_ >= 1 ? 1.f : 0.f, f2 = t_ >= 2 ? 1.f : 0.f;         \
        float bg[8], y[8], cgv[8], hcv[8]; unpack8(R[0], bg); unpack8(R[1], cgv); unpack8(R[2], hcv);                                                                                                   \
        _Pragma("unroll") for (int e = 0; e < 8; ++e) y[e] = w2[e] * (cgv[e] * hcv[e]);                                                                                                                 \
        unpack8(R[3], cgv); unpack8(R[4], hcv); _Pragma("unroll") for (int e = 0; e < 8; ++e) y[e] += f1 * w1[e] * (cgv[e] * hcv[e]);                                                                    \
        unpack8(R[5], cgv); unpack8(R[6], hcv); _Pragma("unroll") for (int e = 0; e < 8; ++e) y[e] += f2 * w0[e] * (cgv[e] * hcv[e]);                                                                    \
        float ss = 0.f; _Pragma("unroll") for (int e = 0; e < 8; ++e) { y[e] *= bg[e]; ss += y[e] * y[e]; }                                                                                             \
        ss += swz<1>(ss); ss += swz<2>(ss); ss += swz<4>(ss); ss += swz<8>(ss);                                                                                                                         \
        const float r = 1.0f / sqrtf(ss * (1.0f / 128.0f) + RMS_EPS);                                                                                                                                   \
        _Pragma("unroll") for (int e = 0; e < 8; ++e) y[e] = y[e] * r * gn[e];                                                                                                                          \
        *(v4u*)(MIX + (size_t)(m_) * DM + 1536 + lane * 8) = pack8f(y); } while (0)
                CLD(ra, gw);
                for (int m = gw; m < M; m += 2 * NGW) {
                    CLD(rb7, m + NGW); CST(ra, m);
                    if (m + 2 * NGW < M) CLD(ra, m + 2 * NGW);
                    CST(rb7, m + NGW); }
#undef CLD
#undef CST
            }
            __syncthreads();
            for (int u = vcu; u < BATCH * 32 * 4; u += G)
                gmlp_unit(u, Z, MIX, (const float*)args.in[4] + l * 512, (const float*)args.in[5] + l * 512, (const float*)args.in[6] + (size_t)l * 4 * 128 * 128, (const float*)args.in[7] + l * 512, mixn, ldsp, tid, lane, wave);
        } else if (k == 2) {
            PHASE_IDS();
            {
                using ab = att::bf16;
                static_assert(att::PAIR_LDS_BYTES <= 131072, "attention LDS fits the phase region");
                const float lam_init = 0.8f - 0.6f * expf(-0.3f * (float)l);
                const float* lq1 = (const float*)args.in[8] + l * 128; const float* lk1 = (const float*)args.in[9] + l * 128;
                const float* lq2 = (const float*)args.in[10] + l * 128; const float* lk2 = (const float*)args.in[11] + l * 128;
                const float d1 = wave_sum(lq1[lane] * lk1[lane] + lq1[lane + 64] * lk1[lane + 64]), d2 = wave_sum(lq2[lane] * lk2[lane] + lq2[lane + 64] * lk2[lane + 64]);
                const float lam = expf(d1) - expf(d2) + lam_init;
                constexpr int TOTAL = BATCH * 4 * 16;
                for (int L = vcu; L < TOTAL; L += G) {
                    const int bh = L >> 4, xx = L & 15, b = bh >> 2, h = bh & 3;
                    const ab* Kp = (const ab*)QKb + ((size_t)b * 16 + 8 + h * 2) * SEQ * 128; const ab* V0p = (const ab*)VB + ((size_t)b * 8 + h * 2) * SEQ * 128;
                    for (int pass = 0; pass < 2; ++pass) { const int qb = pass ? 31 - xx : xx;
                        const ab* Qp = (const ab*)QKb + (((size_t)b * 16 + h * 2) * SEQ + (size_t)qb * 128) * 128;
                        att::diff_block(Qp, Kp, V0p, V0p + (size_t)SEQ * 128, qb * 128, (char*)lds, lam, 1.0f - lam_init, mixn + 512 + h * 256,
                                        MIX + ((size_t)b * SEQ + (size_t)qb * 128) * DM + 512 + h * 256, SEQ * 128, (att::u32x4*)OB + (size_t)vcu * 4096); }
                }
            }
        } else if (k == 4 || k == 6) {
            const bool dn = (k == 6);
            pg8::Gemm g{dn ? Z : MIX, (const bf16*)(wl + (dn ? WO_DOWN : WO_OUT)), M, DM, dn ? DFF : DM}; pg8::StaticOrder S; S.init(M, DM, G, bx);
            pg8::EpiRes E{Hb, DM, ssq + (size_t)(2 * l + (dn ? 2 : 1)) * M * 8, (LAS float*)(ldsp + PSTAT_OFF)};
            pg8::gemm_phase<pg8::EpiRes, pg8::StaticOrder, PG8_ALIGN, PG8_SP2>(ldsp, g, S, E);
        } else if (k == 5) {
            pg8::Gemm g{Hb, (const bf16*)(wl + WO_GU), M, 2 * DFF, DM}; pg8::StaticOrder S; S.init(M, 2 * DFF, G, bx);
            const float* sqp = ssq + (size_t)(2 * l + 1) * M * 8;
            int pmA, pmB; { pg8::Unit u0; S.next(0, u0); pmA = pmB = u0.pm; for (int i = 1; S.next(i, u0); ++i) if (u0.pm != pmA) { pmB = u0.pm; break; } }
            { int t = threadIdx.x; OPQ_V(t); ((LAS float*)(ldsp + PSTAT_OFF))[t] = pg8::row_rstd(sqp, (t < 256 ? pmA : pmB) * 256 + (t & 255)); }
            __syncthreads();
            const pg8::RsTab T{(const LAS float*)(ldsp + PSTAT_OFF), pmA, pmB, sqp};
            pg8::EpiSwiGLU E{Z, DFF, T};
            pg8::gemm_phase<pg8::EpiSwiGLU, pg8::StaticOrder, PG8_ALIGN, PG8_SP2>(ldsp, g, S, E);
        } else {
            PHASE_IDS();
            const float* gp = (const float*)args.in[19]; const float* sq = ssq + (size_t)(2 * DEPTH) * M * 8;
            v4u xa[4], xb4[4]; float sa, sb;
#define FLD(X, S_, m_) do { S_ = pg8::row_ssq(sq, (m_)); _Pragma("unroll") for (int j = 0; j < 4; ++j) X[j] = *(const v4u*)(Hb + (size_t)(m_) * DM + 8 * lane + 512 * j); } while (0)
#define FST(X, S_, m_) do { const float rstd = 1.0f / sqrtf(S_ * (1.0f / DM) + RMS_EPS); float* orow = xo + (size_t)(m_) * DM;                                                         \
        _Pragma("unroll") for (int j = 0; j < 4; ++j) { const int c = 8 * lane + 512 * j; float x[8]; unpack8(X[j], x);                                                                \
            *(f32x4*)(orow + c) = (f32x4){x[0] * rstd * gfin[j][0][0], x[1] * rstd * gfin[j][0][1], x[2] * rstd * gfin[j][0][2], x[3] * rstd * gfin[j][0][3]};                            \
            *(f32x4*)(orow + c + 4) = (f32x4){x[4] * rstd * gfin[j][1][0], x[5] * rstd * gfin[j][1][1], x[6] * rstd * gfin[j][1][2], x[7] * rstd * gfin[j][1][3]}; } } while (0)
            f32x4 gfin[4][2];
#pragma unroll
            for (int j = 0; j < 4; ++j) { gfin[j][0] = *(const f32x4*)(gp + 8 * lane + 512 * j); gfin[j][1] = *(const f32x4*)(gp + 8 * lane + 512 * j + 4); }
            FLD(xa, sa, gw);
            for (int m = gw; m < M; m += 2 * NGW) {
                FLD(xb4, sb, m + NGW); FST(xa, sa, m);
                if (m + 2 * NGW < M) FLD(xa, sa, m + 2 * NGW);
                FST(xb4, sb, m + NGW); }
#undef FLD
#undef FST
        }
        if (p + 1 < args.ph_hi) { XcdBarrier bar; bar.bar = (unsigned*)(args.ws + WS_CTL) + CW_BAR; bar.x = xb_xcc_id(); bar.st = (volatile LAS unsigned*)((LAS unsigned char*)lds + MISC_OFF); xcd_barrier(bar); }
    }
}

extern "C" void kernel_launch(void* const* d_in, const int* in_sizes, int n_in, void* d_out, int out_size, void* d_ws, size_t ws_size, hipStream_t stream) {
    static int grid = 0;
    if (grid == 0) {
        if (n_in != 20 || in_sizes[0] != M * DM || out_size != M * DM || ws_size < WS_END) { fprintf(stderr, "kernel_launch: shape/workspace mismatch (n_in %d, in0 %d, out %d, ws %zu)\n", n_in, n_in > 0 ? in_sizes[0] : -1, out_size, ws_size); grid = -1; return; }
        int dev = 0, cus = 0, per_cu = 0;
        if (hipGetDevice(&dev) != hipSuccess || hipDeviceGetAttribute(&cus, hipDeviceAttributeMultiprocessorCount, dev) != hipSuccess) { grid = -1; return; }
        if (hipFuncSetAttribute((const void*)hymba_fwd, hipFuncAttributeMaxDynamicSharedMemorySize, LDS_BYTES) != hipSuccess) { fprintf(stderr, "kernel_launch: hipFuncSetAttribute failed\n"); grid = -1; return; }
        if (hipOccupancyMaxActiveBlocksPerMultiprocessor(&per_cu, (const void*)hymba_fwd, NWAVES * 64, LDS_BYTES) != hipSuccess || per_cu < 1) { fprintf(stderr, "kernel_launch: occupancy query says %d\n", per_cu); per_cu = 1; }
        (void)hipGetLastError();
        grid = cus * 1;
        if (grid != 256) { fprintf(stderr, "kernel_launch: built for 256 CUs (the row-scale tables assume two row panels per workgroup), device has %d; nothing launched\n", cus); grid = -1; return; }
    }
    if (grid < 0) return;
    if (hipMemsetAsync((char*)d_ws + WS_CTL, 0, CTL_ZERO_BYTES, stream) != hipSuccess) { fprintf(stderr, "kernel_launch: memset of control words failed\n"); return; }
    Args a{};
    for (int i = 0; i < 20; ++i) a.in[i] = d_in[i];
    a.out = (float*)d_out; a.ws = (unsigned char*)d_ws;
#if MK_PER_PHASE
    for (int p = 0; p < N_PHASES; ++p) { a.ph_lo = p; a.ph_hi = p + 1;
        const int kk = (p - 1) % LPH, k = (p == 0 || p == N_PHASES - 1) ? -1 : (kk <= 2 ? kk : kk + 1);
        const int nrep = (p == 0) ? REP_P0 : (k == 0 || k == 5) ? REP_GEMM : (k == 2) ? REP_ATT : (k == 1) ? REP_MIX : (k == 3) ? REP_THIN : 1;
        for (int rep = 0; rep < nrep; ++rep) hipLaunchKernelGGL(hymba_fwd, dim3(grid), dim3(NWAVES * 64), LDS_BYTES, stream, a); }
#else
    a.ph_lo = 0; a.ph_hi = N_PHASES;
    void* kargs[] = {&a};
    hipError_t e = hipLaunchCooperativeKernel((const void*)hymba_fwd, dim3(grid), dim3(NWAVES * 64), kargs, LDS_BYTES, stream);
    if (e != hipSuccess) fprintf(stderr, "cooperative launch failed: %s (grid %d)\n", hipGetErrorString(e), grid);
#endif
}
```

```cpp
#include <hip/hip_runtime.h>
#include <hip/hip_cooperative_groups.h>
#include <hip/hip_bf16.h>
#include <cstdio>
#include <cstdint>
#include <cmath>
namespace cg = cooperative_groups;
template <int X> __device__ __forceinline__ float swz(float v) { return __int_as_float(__builtin_amdgcn_ds_swizzle(__float_as_int(v), 0x1f | (X << 10))); }
__device__ __forceinline__ float sum32(float v) { auto rr = __builtin_amdgcn_permlane32_swap(__float_as_uint(v), __float_as_uint(v), false, false); return __uint_as_float(rr[0]) + __uint_as_float(rr[1]); }
namespace pg8 {
#define PG8_LAS __attribute__((address_space(3)))
typedef unsigned short bf16_t;
typedef short bf16x8 __attribute__((ext_vector_type(8)));
typedef float f32x4 __attribute__((ext_vector_type(4)));
typedef unsigned u32x4 __attribute__((ext_vector_type(4)));
constexpr int BM = 256, BK = 64, HALF = 128, HTB = HALF * BK * 2  , STAGE_BYTES = 8 * HTB, NXCD = 8, WGM = 8;

__host__ __device__ __forceinline__ int lds_byte(int r, int c) { const int st = (r >> 4) * 2 + (c >> 5), rr = r & 15, cc = c & 31, ob = rr * 64 + cc * 2; return st * 1024 + (ob ^ (((ob >> 9) & 1) << 5)); }
__host__ __device__ __forceinline__ void stage_rc(int b, int& R, int& C) { const int st = b / 1024, sb = b % 1024, swz = sb ^ (((sb >> 9) & 1) << 5); R = (st >> 1) * 16 + swz / 64; C = (st & 1) * 32 + (swz % 64) / 2; }
__host__ __device__ __forceinline__ int perm32(int rho) { const int n = rho >> 4, i = rho & 15; return 8 * (i >> 2) + 4 * n + (i & 3); }

struct Unit { int pm, pn; };
struct Gemm { const bf16_t* A; const bf16_t* Bt; int M, N, K; };

struct StaticOrder {
    int nM, nN, nwg, G, c;
    __host__ __device__ void init(int M, int N, int G_, int c_) { nM = M / BM; nN = N / BM; nwg = nM * nN; G = G_; c = c_; }
    __host__ __device__ bool next(int i, Unit& u) const {
        const long L = (long)i * G + c; if (L >= nwg) return false;
        int wgid = (int)L; { const int q = nwg / NXCD, r = nwg % NXCD, xcd = wgid % NXCD, off = wgid / NXCD; wgid = (xcd < r ? xcd * (q + 1) : r * (q + 1) + (xcd - r) * q) + off; }
        const int nig = WGM * nN, gid = wgid / nig, fm = gid * WGM, gsz = (nM - fm) < WGM ? (nM - fm) : WGM;
        u.pm = fm + ((wgid % nig) % gsz); u.pn = (wgid % nig) / gsz; return true;
    }
    __device__ __forceinline__ void a_ready(const Unit&) const {}
    __device__ __forceinline__ void done(const Unit&) const {}
};

__device__ __forceinline__ unsigned cvt_pk_bf16(float lo, float hi) { unsigned r; asm volatile("v_cvt_pk_bf16_f32 %0, %1, %2" : "=v"(r) : "v"(lo), "v"(hi)); return r; }
typedef float f32x2 __attribute__((ext_vector_type(2)));
__device__ __forceinline__ float row_ssq(const float* ssqp, int row) { const f32x4 a = *(const f32x4*)(ssqp + (size_t)row * 8), b = *(const f32x4*)(ssqp + (size_t)row * 8 + 4); return ((a[0] + a[1]) + (a[2] + a[3])) + ((b[0] + b[1]) + (b[2] + b[3])); }
__device__ __forceinline__ float row_rstd(const float* ssqp, int row) { return 1.0f / sqrtf(row_ssq(ssqp, row) * (1.0f / 2048.0f) + 1e-6f); }
struct RsTab { const PG8_LAS float* rs; int pmA, pmB; const float* ssq;
    __device__ __forceinline__ float get(int pm, int r) const { return rs[(pm == pmA ? 0 : 256) + r]; } };
struct EpiZ {
    static constexpr bool PERM = true, AFTER_DRAIN = false, HAS_INIT = false;
    bf16_t* O; int ldc; const float* ssq;
    __device__ __forceinline__ void operator()(const f32x4 (&acc)[2][2][4][2], const Unit& u, int wr, int wc, int fr, int fq) const {
        const int row0 = u.pm * BM + wr * 64 + fr, col0 = u.pn * BM + wc * 32 + 8 * fq;
#pragma unroll
        for (int ai = 0; ai < 2; ++ai)
#pragma unroll
            for (int m = 0; m < 4; ++m) { const int row = row0 + ai * HALF + m * 16; const float rs = row_rstd(ssq, row); bf16_t* rowp = O + (size_t)row * ldc + col0;
#pragma unroll
                for (int bj = 0; bj < 2; ++bj) { const f32x4 v0 = acc[ai][bj][m][0] * rs, v1 = acc[ai][bj][m][1] * rs;
                    u32x4 w; w.x = cvt_pk_bf16(v0[0], v0[1]); w.y = cvt_pk_bf16(v0[2], v0[3]); w.z = cvt_pk_bf16(v1[0], v1[1]); w.w = cvt_pk_bf16(v1[2], v1[3]);
                    *(u32x4*)(rowp + bj * HALF) = w; } }
    }
};
struct EpiIn {
    static constexpr bool PERM = true, AFTER_DRAIN = false, HAS_INIT = false;
    bf16_t* Z; int ldc; RsTab T; bf16_t* QK; bf16_t* V; const float* ctab; const float* stab;
    __device__ __forceinline__ void operator()(const f32x4 (&acc)[2][2][4][2], const Unit& u, int wr, int wc, int fr, int fq) const {
        const int row0 = u.pm * BM + wr * 64 + fr, pn = u.pn;
        if (pn < 4 || pn >= 16) {
            const int col0 = pn * BM + wc * 32 + 8 * fq;
#pragma unroll
            for (int ai = 0; ai < 2; ++ai)
#pragma unroll
                for (int m = 0; m < 4; ++m) { const int row = row0 + ai * HALF + m * 16; const float rs = T.get(u.pm, wr * 64 + fr + ai * HALF + m * 16); bf16_t* rowp = Z + (size_t)row * ldc + col0;
#pragma unroll
                    for (int bj = 0; bj < 2; ++bj) { const f32x4 v0 = acc[ai][bj][m][0] * rs, v1 = acc[ai][bj][m][1] * rs;
                        u32x4 w; w.x = cvt_pk_bf16(v0[0], v0[1]); w.y = cvt_pk_bf16(v0[2], v0[3]); w.z = cvt_pk_bf16(v1[0], v1[1]); w.w = cvt_pk_bf16(v1[2], v1[3]);
                        *(u32x4*)(rowp + bj * HALF) = w; } }
        } else if (pn < 12) {
            const int hd = (pn - 4) * 2 + (wc >> 1), j0 = 32 * (wc & 1) + 8 * fq;
#pragma unroll
            for (int ai = 0; ai < 2; ++ai) {
                f32x4 tc[4][4];
#pragma unroll
                for (int m = 0; m < 4; ++m) { const size_t tb = (size_t)(row0 + ai * HALF + m * 16) * 64 + j0;
                    tc[m][0] = *(const f32x4*)(ctab + tb); tc[m][1] = *(const f32x4*)(ctab + tb + 4); tc[m][2] = *(const f32x4*)(stab + tb); tc[m][3] = *(const f32x4*)(stab + tb + 4); }
#pragma unroll
                for (int m = 0; m < 4; ++m) { const int row = row0 + ai * HALF + m * 16; const float rs = T.get(u.pm, wr * 64 + fr + ai * HALF + m * 16);
                    const f32x4 c0 = tc[m][0], c1 = tc[m][1], s0 = tc[m][2], s1 = tc[m][3];
                    const f32x4 a0 = acc[ai][0][m][0] * rs, a1 = acc[ai][0][m][1] * rs, b0 = acc[ai][1][m][0] * rs, b1 = acc[ai][1][m][1] * rs;
                    const f32x4 p0 = a0 * c0 - b0 * s0, p1 = a1 * c1 - b1 * s1, q0 = b0 * c0 + a0 * s0, q1 = b1 * c1 + a1 * s1;
                    bf16_t* dp = QK + (((size_t)(row >> 12) * 16 + hd) * 4096 + (row & 4095)) * 128 + j0;
                    u32x4 w; w.x = cvt_pk_bf16(p0[0], p0[1]); w.y = cvt_pk_bf16(p0[2], p0[3]); w.z = cvt_pk_bf16(p1[0], p1[1]); w.w = cvt_pk_bf16(p1[2], p1[3]); *(u32x4*)dp = w;
                    w.x = cvt_pk_bf16(q0[0], q0[1]); w.y = cvt_pk_bf16(q0[2], q0[3]); w.z = cvt_pk_bf16(q1[0], q1[1]); w.w = cvt_pk_bf16(q1[2], q1[3]); *(u32x4*)(dp + 64) = w; }
            }
        } else {
#pragma unroll
            for (int ai = 0; ai < 2; ++ai)
#pragma unroll
                for (int m = 0; m < 4; ++m) { const int row = row0 + ai * HALF + m * 16; const float rs = T.get(u.pm, wr * 64 + fr + ai * HALF + m * 16);
#pragma unroll
                    for (int bj = 0; bj < 2; ++bj) { const f32x4 v0 = acc[ai][bj][m][0] * rs, v1 = acc[ai][bj][m][1] * rs;
                        bf16_t* dp = V + (((size_t)(row >> 12) * 8 + (pn - 12) * 2 + bj) * 4096 + (row & 4095)) * 128 + wc * 32 + 8 * fq;
                        u32x4 w; w.x = cvt_pk_bf16(v0[0], v0[1]); w.y = cvt_pk_bf16(v0[2], v0[3]); w.z = cvt_pk_bf16(v1[0], v1[1]); w.w = cvt_pk_bf16(v1[2], v1[3]);
                        *(u32x4*)dp = w; } }
        }
    }
};
__device__ __forceinline__ float swiglu1(float g, float u) { return g * u * __builtin_amdgcn_rcpf(1.0f + __builtin_amdgcn_exp2f(-1.4426950408889634f * g)); }
struct EpiSwiGLU {
    static constexpr bool PERM = true, AFTER_DRAIN = false, HAS_INIT = false;
    bf16_t* O; int ldc; RsTab T;
    __device__ __forceinline__ void operator()(const f32x4 (&acc)[2][2][4][2], const Unit& u, int wr, int wc, int fr, int fq) const {
        const int row0 = u.pm * BM + wr * 64 + fr, col0 = u.pn * HALF + wc * 32 + 8 * fq;
#pragma unroll
        for (int ai = 0; ai < 2; ++ai)
#pragma unroll
            for (int m = 0; m < 4; ++m) { const int row = row0 + ai * HALF + m * 16; const float rs = T.get(u.pm, wr * 64 + fr + ai * HALF + m * 16); bf16_t* rowp = O + (size_t)row * ldc + col0;
                const f32x4 g0 = acc[ai][0][m][0] * rs, g1 = acc[ai][0][m][1] * rs, u0 = acc[ai][1][m][0] * rs, u1 = acc[ai][1][m][1] * rs;
                u32x4 w; w.x = cvt_pk_bf16(swiglu1(g0[0], u0[0]), swiglu1(g0[1], u0[1])); w.y = cvt_pk_bf16(swiglu1(g0[2], u0[2]), swiglu1(g0[3], u0[3]));
                w.z = cvt_pk_bf16(swiglu1(g1[0], u1[0]), swiglu1(g1[1], u1[1])); w.w = cvt_pk_bf16(swiglu1(g1[2], u1[2]), swiglu1(g1[3], u1[3]));
                *(u32x4*)rowp = w; }
    }
};
struct EpiRes {
    static constexpr bool PERM = true, AFTER_DRAIN = false, HAS_INIT = true;
    bf16_t* X; int ldc; float* ssqp; PG8_LAS float* P;
    __device__ __forceinline__ void init(f32x4 (&acc)[2][2][4][2], const Unit& u, int wr, int wc, int fr, int fq) const {
        const int row0 = u.pm * BM + wr * 64 + fr, col0 = u.pn * BM + wc * 32 + 8 * fq;
#pragma unroll
        for (int ai = 0; ai < 2; ++ai)
#pragma unroll
            for (int m = 0; m < 4; ++m) { const bf16_t* rp = X + (size_t)(row0 + ai * HALF + m * 16) * ldc + col0;
#pragma unroll
                for (int bj = 0; bj < 2; ++bj) { const u32x4 b = *(const u32x4*)(rp + bj * HALF);
                    acc[ai][bj][m][0] = (f32x4){__uint_as_float(b.x << 16), __uint_as_float(b.x & 0xffff0000u), __uint_as_float(b.y << 16), __uint_as_float(b.y & 0xffff0000u)};
                    acc[ai][bj][m][1] = (f32x4){__uint_as_float(b.z << 16), __uint_as_float(b.z & 0xffff0000u), __uint_as_float(b.w << 16), __uint_as_float(b.w & 0xffff0000u)}; } }
    }
    template <int AI0, int AI1> __device__ __forceinline__ void load_tile(u32x4 (&nx)[2][4][2], const Unit& u, int wr, int wc, int fr, int fq) const {
        const int row0 = u.pm * BM + wr * 64 + fr, col0 = u.pn * BM + wc * 32 + 8 * fq;
#pragma unroll
        for (int ai = AI0; ai < AI1; ++ai)
#pragma unroll
            for (int m = 0; m < 4; ++m) { const bf16_t* rp = X + (size_t)(row0 + ai * HALF + m * 16) * ldc + col0;
#pragma unroll
                for (int bj = 0; bj < 2; ++bj) nx[ai][m][bj] = *(const u32x4*)(rp + bj * HALF); }
    }
    __device__ __forceinline__ void unpack(f32x4 (&acc)[2][2][4][2], const u32x4 (&nx)[2][4][2]) const {
#pragma unroll
        for (int ai = 0; ai < 2; ++ai)
#pragma unroll
            for (int m = 0; m < 4; ++m)
#pragma unroll
                for (int bj = 0; bj < 2; ++bj) { const u32x4 b = nx[ai][m][bj];
                    acc[ai][bj][m][0] = (f32x4){__uint_as_float(b.x << 16), __uint_as_float(b.x & 0xffff0000u), __uint_as_float(b.y << 16), __uint_as_float(b.y & 0xffff0000u)};
                    acc[ai][bj][m][1] = (f32x4){__uint_as_float(b.z << 16), __uint_as_float(b.z & 0xffff0000u), __uint_as_float(b.w << 16), __uint_as_float(b.w & 0xffff0000u)}; }
    }
    __device__ __forceinline__ void fused(f32x4 (&acc)[2][2][4][2], const Unit& u, const Unit& un, bool has_next, int wr, int wc, int fr, int fq) const {
        const int row0 = u.pm * BM + wr * 64 + fr, col0 = u.pn * BM + wc * 32 + 8 * fq;
        u32x4 w[2][4][2];
#pragma unroll
        for (int ai = 0; ai < 2; ++ai)
#pragma unroll
            for (int m = 0; m < 4; ++m) { float part = 0.f;
#pragma unroll
                for (int bj = 0; bj < 2; ++bj) { const f32x4 a0 = acc[ai][bj][m][0], a1 = acc[ai][bj][m][1];
                    part += (a0[0] * a0[0] + a0[1] * a0[1]) + (a0[2] * a0[2] + a0[3] * a0[3]) + (a1[0] * a1[0] + a1[1] * a1[1]) + (a1[2] * a1[2] + a1[3] * a1[3]);
                    w[ai][m][bj].x = cvt_pk_bf16(a0[0], a0[1]); w[ai][m][bj].y = cvt_pk_bf16(a0[2], a0[3]); w[ai][m][bj].z = cvt_pk_bf16(a1[0], a1[1]); w[ai][m][bj].w = cvt_pk_bf16(a1[2], a1[3]); }
                part += swz<16>(part); part = sum32(part);
                if (fq == 0) P[(wr * 64 + ai * HALF + m * 16 + fr) * 4 + wc] = part; }
        asm volatile("" ::: "memory");
        u32x4 nx[2][4][2];
        if (has_next) load_tile<0, 2>(nx, un, wr, wc, fr, fq);
        asm volatile("" ::: "memory");
#pragma unroll
        for (int ai = 0; ai < 2; ++ai)
#pragma unroll
            for (int m = 0; m < 4; ++m) { bf16_t* rowp = X + (size_t)(row0 + ai * HALF + m * 16) * ldc + col0;
#pragma unroll
                for (int bj = 0; bj < 2; ++bj) *(u32x4*)(rowp + bj * HALF) = w[ai][m][bj]; }
        asm volatile("s_waitcnt lgkmcnt(0)" ::: "memory"); __builtin_amdgcn_s_barrier(); asm volatile("" ::: "memory");
        const int t = (wr * 4 + wc) * 64 + fq * 16 + fr;
        if (t < BM) { const f32x4 p = *(const PG8_LAS f32x4*)(P + t * 4); ssqp[((size_t)u.pm * BM + t) * 8 + u.pn] = (p[0] + p[1]) + (p[2] + p[3]); }
        if (has_next) unpack(acc, nx);
    }
    __device__ __forceinline__ void operator()(const f32x4 (&acc)[2][2][4][2], const Unit& u, int wr, int wc, int fr, int fq) const {
        const int row0 = u.pm * BM + wr * 64 + fr, col0 = u.pn * BM + wc * 32 + 8 * fq;
#pragma unroll
        for (int ai = 0; ai < 2; ++ai)
#pragma unroll
            for (int m = 0; m < 4; ++m) { const int row = row0 + ai * HALF + m * 16; bf16_t* rowp = X + (size_t)row * ldc + col0; float part = 0.f;
#pragma unroll
                for (int bj = 0; bj < 2; ++bj) { const f32x4 a0 = acc[ai][bj][m][0], a1 = acc[ai][bj][m][1];
                    part += (a0[0] * a0[0] + a0[1] * a0[1]) + (a0[2] * a0[2] + a0[3] * a0[3]) + (a1[0] * a1[0] + a1[1] * a1[1]) + (a1[2] * a1[2] + a1[3] * a1[3]);
                    u32x4 w; w.x = cvt_pk_bf16(a0[0], a0[1]); w.y = cvt_pk_bf16(a0[2], a0[3]); w.z = cvt_pk_bf16(a1[0], a1[1]); w.w = cvt_pk_bf16(a1[2], a1[3]);
                    *(u32x4*)(rowp + bj * HALF) = w; }
                part += swz<16>(part); part = sum32(part);
                if (fq == 0) P[(wr * 64 + ai * HALF + m * 16 + fr) * 4 + wc] = part; }
        asm volatile("s_waitcnt lgkmcnt(0)" ::: "memory"); __builtin_amdgcn_s_barrier(); asm volatile("" ::: "memory");
        const int t = (wr * 4 + wc) * 64 + fq * 16 + fr;
        if (t < BM) { const f32x4 p = *(const PG8_LAS f32x4*)(P + t * 4); ssqp[((size_t)u.pm * BM + t) * 8 + u.pn] = (p[0] + p[1]) + (p[2] + p[3]); }
    }
};
template <class Epi, class Sched, bool ALIGN_EPI = false, bool SP2 = false>
__device__ __forceinline__ void gemm_phase(PG8_LAS unsigned char* lds, const Gemm g, const Sched& S, const Epi& E) {
    int tid_o = threadIdx.x; asm volatile("" : "+v"(tid_o));
    const int tid = tid_o, wid = __builtin_amdgcn_readfirstlane(tid >> 6), lane = tid & 63, wr = wid >> 2, wc = wid & 3, fr = lane & 15, fq = lane >> 4;
    const int K = g.K, nt = K / BK;
    unsigned voffA[2], voffB[2];
#pragma unroll
    for (int i = 0; i < 2; ++i) { int R, C; stage_rc(tid * 16 + i * 8192, R, C); const int Rb = Epi::PERM ? ((R & ~31) + perm32(R & 31)) : R;
        voffA[i] = (unsigned)(R * K + C) * 2u; voffB[i] = (unsigned)(Rb * K + C) * 2u; }
    const size_t kstep = (size_t)(BK * 2);
    const size_t hstep = (size_t)HALF * K * 2;
    const size_t tstep = 2 * hstep;
    const unsigned ldsw = (unsigned)wid * 1024u;
    const int aoff = lds_byte(wr * 64 + fr, fq * 8), boff = lds_byte(wc * 32 + fr, fq * 8);
#define PG8_SA(b, h) (((b) * 2 + (h)) * HTB)
#define PG8_SB(b, h) ((4 + (b) * 2 + (h)) * HTB)
#define PG8_STAGE(bufoff, gbase, voff) do { _Pragma("unroll") for (int _i = 0; _i < 2; ++_i) \
        __builtin_amdgcn_global_load_lds((const unsigned*)((const char*)(gbase) + (voff)[_i]), (PG8_LAS unsigned*)(lds + (bufoff) + ldsw + _i * 8192), 16, 0, 0); } while (0)
#define PG8_LDA(dst, b, h) do { _Pragma("unroll") for (int m = 0; m < 4; ++m) _Pragma("unroll") for (int k = 0; k < 2; ++k) dst[m][k] = *(const PG8_LAS bf16x8*)(lds + PG8_SA(b, h) + aoff + m * 2048 + k * 1024); } while (0)
#define PG8_LDB(dst, b, h) do { _Pragma("unroll") for (int n = 0; n < 2; ++n) _Pragma("unroll") for (int k = 0; k < 2; ++k) dst[n][k] = *(const PG8_LAS bf16x8*)(lds + PG8_SB(b, h) + boff + n * 2048 + k * 1024); } while (0)
#define PG8_MMA(ai, bj, At, Bt) do { __builtin_amdgcn_s_setprio(1); _Pragma("unroll") for (int m = 0; m < 4; ++m) _Pragma("unroll") for (int n = 0; n < 2; ++n) _Pragma("unroll") for (int k = 0; k < 2; ++k) \
        acc[ai][bj][m][n] = __builtin_amdgcn_mfma_f32_16x16x32_bf16(Bt[n][k], At[m][k], acc[ai][bj][m][n], 0, 0, 0); __builtin_amdgcn_s_setprio(0); } while (0)
#define PG8_WAIT_V(n) asm volatile("s_waitcnt vmcnt(" #n ")" ::: "memory")
#define PG8_WAIT_L(n) asm volatile("s_waitcnt lgkmcnt(" #n ")" ::: "memory")
#define PG8_BAR __builtin_amdgcn_s_barrier()
#define PG8_SCHED __builtin_amdgcn_sched_barrier(0)
    Unit cur, nxt; int ui = 0;
    if (!S.next(0, cur)) return;
    f32x4 acc[2][2][4][2];
    if constexpr (Epi::HAS_INIT) E.init(acc, cur, wr, wc, fr, fq);
    else {
#pragma unroll
    for (int a = 0; a < 2; ++a)
#pragma unroll
        for (int b = 0; b < 2; ++b)
#pragma unroll
            for (int m = 0; m < 4; ++m)
#pragma unroll
                for (int n = 0; n < 2; ++n) acc[a][b][m][n] = (f32x4){0.f, 0.f, 0.f, 0.f};
    }
    bf16x8 At[4][2], B0[2][2], B1[2][2];
    const char* cA = (const char*)g.A + (size_t)cur.pm * tstep; const char* cB = (const char*)g.Bt + (size_t)cur.pn * tstep;
    S.a_ready(cur);
    if constexpr (SP2) {
        PG8_STAGE(PG8_SB(0, 0), cB, voffB); PG8_STAGE(PG8_SB(0, 1), cB + hstep, voffB); PG8_STAGE(PG8_SA(0, 0), cA, voffA); PG8_STAGE(PG8_SA(0, 1), cA + hstep, voffA);
        if (wr == 1) PG8_BAR;
        PG8_WAIT_V(2); PG8_BAR;
        PG8_STAGE(PG8_SB(1, 0), cB + kstep, voffB); PG8_STAGE(PG8_SA(1, 0), cA + kstep, voffA); PG8_STAGE(PG8_SB(1, 1), cB + hstep + kstep, voffB);
        PG8_WAIT_V(6); PG8_BAR;
    } else {
        PG8_STAGE(PG8_SB(0, 0), cB, voffB); PG8_STAGE(PG8_SA(0, 0), cA, voffA); PG8_STAGE(PG8_SB(0, 1), cB + hstep, voffB); PG8_STAGE(PG8_SA(0, 1), cA + hstep, voffA);
        if (wr == 1) PG8_BAR;
        PG8_WAIT_V(4); PG8_BAR;
        PG8_STAGE(PG8_SB(1, 0), cB + kstep, voffB); PG8_STAGE(PG8_SA(1, 0), cA + kstep, voffA); PG8_STAGE(PG8_SB(1, 1), cB + hstep + kstep, voffB);
        PG8_WAIT_V(6); PG8_BAR;
    }
    for (;;) {
        const bool has_next = S.next(ui + 1, nxt);
        const char* nA = has_next ? (const char*)g.A + (size_t)nxt.pm * tstep : cA; const char* nB = has_next ? (const char*)g.Bt + (size_t)nxt.pn * tstep : cB;
        for (int t = 0; t < nt; t += 2) {
            const bool last = (t == nt - 2);
            const char* a1 = cA + (size_t)(t + 1) * kstep;
            const char* a2 = last ? nA : cA + (size_t)(t + 2) * kstep; const char* b2 = last ? nB : cB + (size_t)(t + 2) * kstep;
            const char* a3 = a2 + kstep; const char* b3 = b2 + kstep;
            if (last && has_next) S.a_ready(nxt);
            if constexpr (SP2) {
            PG8_LDB(B0, 0, 0); PG8_LDB(B1, 0, 1); PG8_SCHED; PG8_LDA(At, 0, 0); PG8_STAGE(PG8_SA(1, 1), a1 + hstep, voffA);
            PG8_WAIT_V(8); PG8_WAIT_L(0); PG8_BAR; PG8_MMA(0, 0, At, B0); PG8_MMA(0, 1, At, B1); PG8_BAR; PG8_SCHED;
            PG8_LDA(At, 0, 1); PG8_STAGE(PG8_SB(0, 0), b2, voffB); PG8_STAGE(PG8_SB(0, 1), b2 + hstep, voffB); PG8_STAGE(PG8_SA(0, 0), a2, voffA);
            PG8_WAIT_V(8); PG8_WAIT_L(0); PG8_BAR; PG8_MMA(1, 0, At, B0); PG8_MMA(1, 1, At, B1); PG8_BAR; PG8_SCHED;
            PG8_LDB(B0, 1, 0); PG8_LDB(B1, 1, 1); PG8_SCHED; PG8_LDA(At, 1, 0); PG8_STAGE(PG8_SA(0, 1), a2 + hstep, voffA);
            PG8_WAIT_V(8); PG8_WAIT_L(0); PG8_BAR; PG8_MMA(0, 0, At, B0); PG8_MMA(0, 1, At, B1); PG8_BAR; PG8_SCHED;
            PG8_LDA(At, 1, 1); PG8_STAGE(PG8_SB(1, 0), b3, voffB); PG8_STAGE(PG8_SB(1, 1), b3 + hstep, voffB); PG8_STAGE(PG8_SA(1, 0), a3, voffA);
            PG8_WAIT_V(8); PG8_WAIT_L(0); PG8_BAR; PG8_MMA(1, 0, At, B0); PG8_MMA(1, 1, At, B1); PG8_BAR; PG8_SCHED;
            } else {
            PG8_LDB(B0, 0, 0); PG8_SCHED; PG8_LDA(At, 0, 0); PG8_STAGE(PG8_SA(1, 1), a1 + hstep, voffA);
            PG8_WAIT_L(8); PG8_BAR; PG8_WAIT_L(0); PG8_MMA(0, 0, At, B0); PG8_BAR; PG8_SCHED;
            PG8_LDB(B1, 0, 1); PG8_STAGE(PG8_SB(0, 0), b2, voffB);
            PG8_BAR; PG8_WAIT_L(0); PG8_MMA(0, 1, At, B1); PG8_BAR;
            PG8_LDA(At, 0, 1); PG8_STAGE(PG8_SA(0, 0), a2, voffA);
            PG8_BAR; PG8_WAIT_L(0); PG8_MMA(1, 0, At, B0); PG8_BAR; PG8_SCHED;
            PG8_STAGE(PG8_SB(0, 1), b2 + hstep, voffB);
            PG8_WAIT_V(6); PG8_BAR; PG8_MMA(1, 1, At, B1); PG8_BAR;
            PG8_LDB(B0, 1, 0); PG8_SCHED; PG8_LDA(At, 1, 0); PG8_STAGE(PG8_SA(0, 1), a2 + hstep, voffA);
            PG8_WAIT_L(8); PG8_BAR; PG8_WAIT_L(0); PG8_MMA(0, 0, At, B0); PG8_BAR; PG8_SCHED;
            PG8_LDB(B1, 1, 1); PG8_STAGE(PG8_SB(1, 0), b3, voffB);
            PG8_BAR; PG8_WAIT_L(0); PG8_MMA(0, 1, At, B1); PG8_BAR;
            PG8_LDA(At, 1, 1); PG8_STAGE(PG8_SA(1, 0), a3, voffA);
            PG8_BAR; PG8_WAIT_L(0); PG8_MMA(1, 0, At, B0); PG8_BAR; PG8_SCHED;
            PG8_STAGE(PG8_SB(1, 1), b3 + hstep, voffB);
            PG8_WAIT_V(6); PG8_BAR; PG8_MMA(1, 1, At, B1); PG8_BAR;
            }
        }
        if constexpr (ALIGN_EPI) { if (wr == 0) PG8_BAR; }
        int fr_e = fr, fq_e = fq; asm volatile("" : "+v"(fr_e), "+v"(fq_e));
        if constexpr (Epi::HAS_INIT) { E.fused(acc, cur, nxt, has_next, wr, wc, fr_e, fq_e); S.done(cur); }
        else if constexpr (!Epi::AFTER_DRAIN) { E(acc, cur, wr, wc, fr_e, fq_e); S.done(cur); }
        if (!has_next) break;
        if constexpr (Epi::HAS_INIT) { }
        else {
#pragma unroll
        for (int a = 0; a < 2; ++a)
#pragma unroll
            for (int b = 0; b < 2; ++b)
#pragma unroll
                for (int m = 0; m < 4; ++m)
#pragma unroll
                    for (int n = 0; n < 2; ++n) acc[a][b][m][n] = (f32x4){0.f, 0.f, 0.f, 0.f};
        }
        cur = nxt; cA = nA; cB = nB; ++ui;
        if constexpr (ALIGN_EPI) { if (wr == 1) PG8_BAR; }
    }
    PG8_WAIT_V(0);
    if constexpr (!ALIGN_EPI) { if (wr == 0) PG8_BAR; }
    PG8_BAR;
    if constexpr (Epi::AFTER_DRAIN) { E.fused(acc, cur, wr, wc, fr, fq, lds, wid, lane); S.done(cur); }
#undef PG8_SA
#undef PG8_SB
#undef PG8_STAGE
#undef PG8_LDA
#undef PG8_LDB
#undef PG8_MMA
#undef PG8_WAIT_V
#undef PG8_WAIT_L
#undef PG8_BAR
#undef PG8_SCHED
}
}
#ifndef PG8_SP2
#define PG8_SP2 true
#endif
#ifndef PG8_ALIGN
#define PG8_ALIGN true
#endif
namespace att {
constexpr int D = 128;
constexpr int LDQ = 128, LDKV = 128, LDO = 128;
constexpr float THR = 8.f;
constexpr bool WSKIP = false;
constexpr float SCALE = 0.08838834764831845f;
constexpr int NW = 8, QBLK = 32, KVBLK = 64, QB = NW * QBLK;
constexpr int SHM_V = KVBLK * D * 2, SHM_K = KVBLK * D * 2;
constexpr int LDS_BYTES = 2 * SHM_V + 2 * SHM_K + NW * 64 * 4;
using bf16 = __hip_bfloat16;
typedef short bf16x8 __attribute__((ext_vector_type(8)));
typedef short s16x4 __attribute__((ext_vector_type(4)));
typedef float f32x16 __attribute__((ext_vector_type(16)));
typedef float f32x4 __attribute__((ext_vector_type(4)));
typedef unsigned u32x4 __attribute__((ext_vector_type(4)));
template <class A, class Bt> struct same_t { static constexpr bool v = false; };
template <class A> struct same_t<A, A> { static constexpr bool v = true; };

#define KSWZ(row, colB) ((row) * 256 + ((colB) ^ (((row) & 7) << 4)))
#define SBAR() __builtin_amdgcn_sched_barrier(0)
__device__ __forceinline__ int v_st(int k, int c) { const int kk = (k & ~0xC) | ((k & 4) << 1) | ((k & 8) >> 1); return ((kk >> 3) * 4 + (c >> 5)) * 512 + ((kk & 7) * 32 + (c & 31)) * 2; }
__device__ __forceinline__ int v_rd_base(int lane) { return ((lane & 3) << 3) | (((lane >> 2) & 3) << 6) | (((lane >> 4) & 1) << 5) | (((lane >> 5) & 1) << 8); }
constexpr int v_rd_off(int d0, int ks, int half) { return d0 * 512 + ks * 4096 + half * 2048; }
__device__ __forceinline__ int crow(int r, int hi) { return (r & 3) + 8 * (r >> 2) + 4 * hi; }
__device__ __forceinline__ unsigned cvtpk(float lo, float hi) {
    unsigned r; asm volatile("v_cvt_pk_bf16_f32 %0, %1, %2" : "=v"(r) : "v"(lo), "v"(hi)); return r;
}
__device__ __forceinline__ bf16x8 pack8(f32x4 a, f32x4 b) {
    u32x4 w = {cvtpk(a[0], a[1]), cvtpk(a[2], a[3]), cvtpk(b[0], b[1]), cvtpk(b[2], b[3])};
    return *reinterpret_cast<bf16x8*>(&w);
}
template <class T> __device__ __forceinline__ bf16x8 load8(const T* p) {
    if constexpr (same_t<T, float>::v) { return pack8(*(const f32x4*)p, *(const f32x4*)(p + 4)); }
    else { return *reinterpret_cast<const bf16x8*>(p); }
}
__device__ __forceinline__ void mask_tile(f32x16& p0, f32x16& p1, int dq, unsigned W) {
    const float NEG = -__builtin_inff();
#pragma unroll
    for (int r = 0; r < 16; ++r) {
        const int c = (r & 3) + 8 * (r >> 2);
        if ((unsigned)(dq - c) >= W) p0[r] = NEG;
        if ((unsigned)(dq - c - 32) >= W) p1[r] = NEG;
    }
}
__device__ __forceinline__ void partialSM(f32x16& p0, f32x16& p1, float& m_reg, float& mn, float& alpha) {
    float pmax = p0[0]; for (int r = 1; r < 16; ++r) pmax = fmaxf(pmax, p0[r]); for (int r = 0; r < 16; ++r) pmax = fmaxf(pmax, p1[r]);
    { auto rr = __builtin_amdgcn_permlane32_swap(__float_as_uint(pmax), __float_as_uint(pmax), false, false);
      pmax = fmaxf(__uint_as_float(rr[0]), __uint_as_float(rr[1])); }
    constexpr float C2 = 1.4426950408889634f * SCALE;
    if (__builtin_expect(__all((pmax - m_reg) * SCALE <= THR), 1)) { mn = m_reg; alpha = 1.f; }
    else { mn = fmaxf(m_reg, pmax); alpha = __builtin_amdgcn_exp2f((m_reg - mn) * C2); m_reg = mn; }
    const float mnL = -mn * C2;
    for (int r = 0; r < 16; ++r) p0[r] = fmaf(p0[r], C2, mnL); for (int r = 0; r < 16; ++r) p1[r] = fmaf(p1[r], C2, mnL);
    for (int r = 0; r < 16; ++r) p0[r] = __builtin_amdgcn_exp2f(p0[r]);
}
__device__ __forceinline__ void finishSM(f32x16& p0, f32x16& p1, float alpha, float& l_reg, bf16x8& pa0, bf16x8& pa1, bf16x8& pa2, bf16x8& pa3) {
    for (int r = 0; r < 16; ++r) p1[r] = __builtin_amdgcn_exp2f(p1[r]);
    float ps = 0; for (int r = 0; r < 16; ++r) ps += p0[r]; for (int r = 0; r < 16; ++r) ps += p1[r];
    { auto rr = __builtin_amdgcn_permlane32_swap(__float_as_uint(ps), __float_as_uint(ps), false, false);
      ps = __uint_as_float(rr[0]) + __uint_as_float(rr[1]); }
    l_reg = l_reg * alpha + ps;
#define PK4(P, B_, OUT) do { unsigned a0 = cvtpk(P[B_+0], P[B_+1]), a1 = cvtpk(P[B_+2], P[B_+3]);                          \
        unsigned b0 = cvtpk(P[B_+4], P[B_+5]), b1 = cvtpk(P[B_+6], P[B_+7]);                                             \
        auto r0 = __builtin_amdgcn_permlane32_swap(a0, b0, false, false); auto r1 = __builtin_amdgcn_permlane32_swap(a1, b1, false, false); \
        u32x4 w = {r0[0], r1[0], r0[1], r1[1]}; OUT = *reinterpret_cast<bf16x8*>(&w); } while (0)
    PK4(p0, 0, pa0); PK4(p0, 8, pa1); PK4(p1, 0, pa2); PK4(p1, 8, pa3);
#undef PK4
}
template <int KB, bool SK>
__device__ __forceinline__ void qkt(f32x16& p0, f32x16& p1, const char* K_lds, int r32, int hi, const bf16x8* qr, bool act) {
    if (SK && !act) { const float NEG = -__builtin_inff();
#pragma unroll
        for (int r = 0; r < 16; ++r) { p0[r] = NEG; p1[r] = NEG; } return; }
    p0 = f32x16{}; p1 = f32x16{};
    const char* kb[4];
#pragma unroll
    for (int dd = 0; dd < 4; ++dd) kb[dd] = K_lds + KB * SHM_K + KSWZ(r32, (dd * 16 + hi * 8) * 2);
#pragma unroll
    for (int d0 = 0; d0 < 8; ++d0) { const char* a = kb[d0 & 3] + (d0 >> 2) * 128;
        bf16x8 b0 = *reinterpret_cast<const bf16x8*>(a);
        bf16x8 b1 = *reinterpret_cast<const bf16x8*>(a + 32 * 256);
        p0 = __builtin_amdgcn_mfma_f32_32x32x16_bf16(b0, qr[d0], p0, 0, 0, 0);
        p1 = __builtin_amdgcn_mfma_f32_32x32x16_bf16(b1, qr[d0], p1, 0, 0, 0); }
}
template <int VB, bool SK>
__device__ __forceinline__ void pv_tile(f32x16* o, int vb0, bf16x8 pa0, bf16x8 pa1, bf16x8 pa2, bf16x8 pa3, bool act) {
    if (SK && !act) return;
#define TRRD(dst, off) asm volatile("ds_read_b64_tr_b16 %0, %1 offset:%2" : "=&v"(dst) : "v"(vb0), "i"(off) : "memory")
#define PV_D0(d0) do { s16x4 l0, l1, l2, l3, h0, h1, h2, h3; constexpr int b_ = VB * SHM_V + v_rd_off(d0, 0, 0);     \
        TRRD(l0, b_); TRRD(h0, b_ + 2048); TRRD(l1, b_ + 4096); TRRD(h1, b_ + 6144); TRRD(l2, b_ + 8192); TRRD(h2, b_ + 10240); TRRD(l3, b_ + 12288); TRRD(h3, b_ + 14336); \
        asm volatile("s_waitcnt lgkmcnt(0)" ::: "memory"); SBAR();                 \
        o[d0] = __builtin_amdgcn_mfma_f32_32x32x16_bf16(pa0, (bf16x8){l0[0], l0[1], l0[2], l0[3], h0[0], h0[1], h0[2], h0[3]}, o[d0], 0, 0, 0);   \
        o[d0] = __builtin_amdgcn_mfma_f32_32x32x16_bf16(pa1, (bf16x8){l1[0], l1[1], l1[2], l1[3], h1[0], h1[1], h1[2], h1[3]}, o[d0], 0, 0, 0);   \
        o[d0] = __builtin_amdgcn_mfma_f32_32x32x16_bf16(pa2, (bf16x8){l2[0], l2[1], l2[2], l2[3], h2[0], h2[1], h2[2], h2[3]}, o[d0], 0, 0, 0);   \
        o[d0] = __builtin_amdgcn_mfma_f32_32x32x16_bf16(pa3, (bf16x8){l3[0], l3[1], l3[2], l3[3], h3[0], h3[1], h3[2], h3[3]}, o[d0], 0, 0, 0); } while (0)
    PV_D0(0); PV_D0(1); PV_D0(2); PV_D0(3);
#undef PV_D0
#undef TRRD
}

template <class TIn, class TOut> struct BlockRef { const TIn* Q; const TIn* K; const TIn* V; TOut* O; int P0; };
template <class TIn> struct Seam {
    bf16x8 qr[8];
    bf16x8 st_v0, st_v1, st_k0, st_k1; f32x4 sf0, sf1, sf2, sf3;
    f32x4 tq[16];
};
__device__ __forceinline__ int swa_jlo(int P0, int W) { const int lowk = P0 - W + 1; return lowk > 0 ? lowk / KVBLK : 0; }
#define ROW(p, k0, rr) ((p) + (size_t)((k0) + (rr)) * LDKV + sc)
#define VMW() asm volatile("s_waitcnt vmcnt(0)" ::: "memory")
#define VMWN(n) asm volatile("s_waitcnt vmcnt(%0)" :: "i"(n) : "memory")
#define SLOAD_H(Kp, Vp, k0) do { S.st_v0 = load8<TIn>(ROW(Vp, k0, sr)); S.st_v1 = load8<TIn>(ROW(Vp, k0, 32 + sr));              \
                         S.st_k0 = load8<TIn>(ROW(Kp, k0, sr)); S.st_k1 = load8<TIn>(ROW(Kp, k0, 32 + sr)); } while (0)
#define SWRITE_HK(bf) do { *(bf16x8*)(K_lds + (bf) * SHM_K + kws) = S.st_k0; *(bf16x8*)(K_lds + (bf) * SHM_K + kws + 32 * 256) = S.st_k1; } while (0)
#define SWRITE_HV(bf) do { *(bf16x8*)(V_lds + (bf) * SHM_V + vst0) = S.st_v0; *(bf16x8*)(V_lds + (bf) * SHM_V + vst1) = S.st_v1; } while (0)
#define SWRITE_H(bf) do { SWRITE_HV(bf); SWRITE_HK(bf); } while (0)
#define SLOAD_F(p, k0) do { S.sf0 = *(const f32x4*)ROW(p, k0, sr); S.sf1 = *(const f32x4*)(ROW(p, k0, sr) + 4);                \
                            S.sf2 = *(const f32x4*)ROW(p, k0, 32 + sr); S.sf3 = *(const f32x4*)(ROW(p, k0, 32 + sr) + 4); } while (0)
#define SWRITE_KF(bf) do { *(bf16x8*)(K_lds + (bf) * SHM_K + kws) = pack8(S.sf0, S.sf1); *(bf16x8*)(K_lds + (bf) * SHM_K + kws + 32 * 256) = pack8(S.sf2, S.sf3); } while (0)
#define SWRITE_VF(bf) do { *(bf16x8*)(V_lds + (bf) * SHM_V + vst0) = pack8(S.sf0, S.sf1); *(bf16x8*)(V_lds + (bf) * SHM_V + vst1) = pack8(S.sf2, S.sf3); } while (0)
template <class TIn, class TOut>
__device__ __forceinline__ void causal_swa_prime(const BlockRef<TIn, TOut>& cur, int W, char* lds, Seam<TIn>& S) {
    constexpr bool F32 = same_t<TIn, float>::v;
    int tid_o = threadIdx.x; asm volatile("" : "+v"(tid_o));
    const int tid = tid_o, wid = __builtin_amdgcn_readfirstlane(tid >> 6), lane = tid & 63, r32 = lane & 31, hi = lane >> 5;
    const int sr = tid >> 4, sc = (tid & 15) * 8, kws = KSWZ(sr, sc * 2); char* K_lds = lds + 2 * SHM_V;
    const int kb0 = swa_jlo(cur.P0, W) * KVBLK;
    for (int d0 = 0; d0 < 8; ++d0) S.qr[d0] = load8<TIn>(cur.Q + (size_t)(wid * QBLK + r32) * LDQ + d0 * 16 + hi * 8);
    if constexpr (F32) { SLOAD_F((const float*)cur.K, kb0); VMW(); SWRITE_KF(0); SBAR(); SLOAD_F((const float*)cur.V, kb0); }
    else { SLOAD_H(cur.K, cur.V, kb0); VMW(); SWRITE_HK(0); }
    __syncthreads();
}
template <class TIn, class TOut>
__device__ __forceinline__ void causal_swa_block(const BlockRef<TIn, TOut>& cur, const BlockRef<TIn, TOut>& nxt, int skv, int W, char* lds, Seam<TIn>& S) {
    constexpr bool F32 = same_t<TIn, float>::v;
    int tid_o = threadIdx.x; asm volatile("" : "+v"(tid_o));
    const int tid = tid_o, wid = __builtin_amdgcn_readfirstlane(tid >> 6), lane = tid & 63, r32 = lane & 31, hi = lane >> 5;
    const int j_lo = swa_jlo(cur.P0, W);
    int j_hi = (cur.P0 + QB - 1) / KVBLK + 1; if (j_hi > skv / KVBLK) j_hi = skv / KVBLK;
    const int NT = j_hi - j_lo;
    const int kbn = swa_jlo(nxt.P0, W) * KVBLK;
    const int qlo = cur.P0 + wid * QBLK, qm = qlo + r32 - 4 * hi;
    char* V_lds = lds; char* K_lds = lds + 2 * SHM_V;
    float* ws = (float*)(lds + 2 * SHM_V + 2 * SHM_K) + wid * 64; float* li_l = ws, * al_l = ws + 32;
    float m_reg = -1e30f, l_reg = 0; f32x16 o[4] = {};
    const int sr = tid >> 4, sc = (tid & 15) * 8, vst0 = v_st(sr, sc), vst1 = v_st(32 + sr, sc), kws = KSWZ(sr, sc * 2);
    const int vb0 = (int)(uintptr_t)V_lds + v_rd_base(lane);
    const TIn* Kh = cur.K; const TIn* Vh = cur.V;
#define RESC(a) do { if (__any((a) < 1.f)) { if (hi == 0) al_l[r32] = (a); asm volatile("s_waitcnt lgkmcnt(0)" ::: "memory");              \
                     for (int d_ = 0; d_ < 4; ++d_) for (int r = 0; r < 16; ++r) o[d_][r] *= al_l[crow(r, hi)]; } } while (0)
#define KBASE(t) ((j_lo + (t)) * KVBLK)
#define ACT(t) (KBASE(t) <= qlo + QBLK - 1 && KBASE(t) + KVBLK - 1 >= qlo - W + 1)
#define MASKT(P0_, P1_, t) do { const int kb_ = KBASE(t); if ((!SK || ACT(t)) && (kb_ + KVBLK - 1 > qlo || kb_ <= qlo + QBLK - 1 - W)) mask_tile(P0_, P1_, qm - kb_, (unsigned)W); } while (0)
    constexpr int NQL = F32 ? 16 : 8;
    constexpr bool SK = WSKIP && !F32;
#define SEAM_K0() do { VMWN(NQL); if constexpr (F32) { SWRITE_KF(0); SBAR(); SLOAD_F((const float*)nxt.V, kbn); } else { SWRITE_HK(0); } SBAR(); } while (0)
    f32x16 pA0, pA1, pB0, pB1; float mnA, mnB, alA, alB; bf16x8 pa0, pa1, pa2, pa3;
    if constexpr (F32) { VMW(); SWRITE_VF(0); SBAR(); } else { SWRITE_HV(0); SBAR(); }
    if (NT > 1) { if constexpr (F32) SLOAD_F((const float*)Kh, KBASE(1)); else SLOAD_H(Kh, Vh, KBASE(1)); }
    SBAR(); qkt<0, SK>(pA0, pA1, K_lds, r32, hi, S.qr, ACT(0));
    if constexpr (F32) { if (NT > 1) { VMW(); SWRITE_KF(1); SBAR(); SLOAD_F((const float*)Vh, KBASE(1)); } }
    MASKT(pA0, pA1, 0); partialSM(pA0, pA1, m_reg, mnA, alA);
    if (NT > 1) { VMW(); if constexpr (F32) { SWRITE_VF(1); SBAR(); if (NT > 2) SLOAD_F((const float*)Kh, KBASE(2)); } else SWRITE_H(1); }
    __syncthreads();
#define HALF_STEP(PX0, PX1, mnX, alX, PY0, PY1, alY, t, KB, VB, SB) do {                                                      \
        SBAR(); qkt<KB, SK>(PX0, PX1, K_lds, r32, hi, S.qr, ACT(t));                                             \
        finishSM(PY0, PY1, alY, l_reg, pa0, pa1, pa2, pa3); SBAR();                                                           \
        if ((t) + 1 < NT) { if constexpr (F32) { VMW(); SWRITE_KF(SB); SBAR(); SLOAD_F((const float*)Vh, KBASE((t) + 1)); }  \
                            else { SLOAD_H(Kh, Vh, KBASE((t) + 1)); } SBAR(); }                                               \
        pv_tile<VB, SK>(o, vb0, pa0, pa1, pa2, pa3, ACT((t) - 1)); MASKT(PX0, PX1, (t)); partialSM(PX0, PX1, m_reg, mnX, alX);                                        \
        __syncthreads();                                                                                                      \
        if ((t) + 1 < NT) { VMW(); if constexpr (F32) { SWRITE_VF(SB); SBAR(); if ((t) + 2 < NT) SLOAD_F((const float*)Kh, KBASE((t) + 2)); } \
                            else { SWRITE_H(SB); } }                                                                          \
        RESC(alX); __syncthreads(); } while (0)
    for (int t = 1; t + 1 < NT; t += 2) {
        HALF_STEP(pB0, pB1, mnB, alB, pA0, pA1, alA, t, 1, 0, 0);
        HALF_STEP(pA0, pA1, mnA, alA, pB0, pB1, alB, t + 1, 0, 1, 1);
    }
    const bool even = (NT & 1) == 0;
    if (even) { SBAR(); qkt<1, SK>(pB0, pB1, K_lds, r32, hi, S.qr, ACT(NT - 1)); SBAR(); }
#define QROW(e) (nxt.Q + (size_t)(wid * QBLK + r32) * D + ((e) >> 1) * 16 + hi * 8 + ((e) & 1) * 4)
    if constexpr (F32) { SLOAD_F((const float*)nxt.K, kbn); SBAR();
#pragma unroll
        for (int e = 0; e < 8; ++e) S.tq[e] = *(const f32x4*)QROW(e); }
    else { SLOAD_H(nxt.K, nxt.V, kbn); SBAR();
#pragma unroll
        for (int d0 = 0; d0 < 8; ++d0) S.qr[d0] = load8<TIn>(nxt.Q + (size_t)(wid * QBLK + r32) * LDQ + d0 * 16 + hi * 8); }
    SBAR();
    finishSM(pA0, pA1, alA, l_reg, pa0, pa1, pa2, pa3); SBAR();
    if constexpr (F32) {
#pragma unroll
        for (int e = 8; e < 16; ++e) S.tq[e] = *(const f32x4*)QROW(e); SBAR(); }
#undef QROW
    pv_tile<0, SK>(o, vb0, pa0, pa1, pa2, pa3, ACT(even ? NT - 2 : NT - 1));
    if (even) { MASKT(pB0, pB1, NT - 1); partialSM(pB0, pB1, m_reg, mnB, alB); __syncthreads(); RESC(alB);
        finishSM(pB0, pB1, alB, l_reg, pa0, pa1, pa2, pa3); SBAR(); pv_tile<1, SK>(o, vb0, pa0, pa1, pa2, pa3, ACT(NT - 1)); }
    SBAR(); SEAM_K0();
    if (hi == 0) li_l[r32] = l_reg; asm volatile("s_waitcnt lgkmcnt(0)" ::: "memory");
    float rli[16];
#pragma unroll
    for (int r = 0; r < 16; ++r) rli[r] = __builtin_amdgcn_rcpf(li_l[crow(r, hi)]);
    TOut* Ow = cur.O + (size_t)(wid * QBLK) * LDO;
#pragma unroll
    for (int r = 0; r < 16; ++r) { const int orow = crow(r, hi);
#pragma unroll
        for (int d0 = 0; d0 < 4; ++d0) { const float v = o[d0][r] * rli[r];
            if constexpr (same_t<TOut, float>::v) { Ow[(size_t)orow * LDO + d0 * 32 + r32] = v; }
            else { const float vn = swz<1>(v);
                   if ((r32 & 1) == 0) *(unsigned*)(Ow + (size_t)orow * LDO + d0 * 32 + r32) = cvtpk(v, vn); } } }
    if constexpr (F32) {
#pragma unroll
        for (int d0 = 0; d0 < 8; ++d0) S.qr[d0] = pack8(S.tq[2 * d0], S.tq[2 * d0 + 1]); }
    __syncthreads();
#undef RESC
#undef KBASE
#undef ACT
#undef MASKT
#undef SEAM_K0
#undef HALF_STEP
}
#undef ROW
#undef VMW
#undef VMWN
#undef SLOAD_H
#undef SWRITE_HK
#undef SWRITE_HV
#undef SWRITE_H
#undef SLOAD_F
#undef SWRITE_KF
#undef SWRITE_VF

constexpr int P_QB = 128, SHM_VT = 2 * SHM_V;
constexpr int L_K = 0, L_V = 2 * SHM_K, L_P = L_V + 2 * SHM_VT, L_M = L_P + NW * 2048, L_WS = L_M + 2 * NW * 256, PAIR_LDS_BYTES = L_WS + NW * 256;
template <bool HAVE, bool PRE> __device__ __forceinline__ void pair_core(const bf16* Qp, const bf16* Kp, const bf16* V0p, const bf16* V1p, int P0, char* lds, f32x16 (&o)[4], bf16x8 (&sq)[8], bf16x8& sk0, bf16x8& sk1, const bf16* Qn, const bf16* Kn) {
    int tid_o = threadIdx.x; asm volatile("" : "+v"(tid_o));
    const int tid = tid_o, wid = __builtin_amdgcn_readfirstlane(tid >> 6), lane = tid & 63, r32 = lane & 31, hi = lane >> 5;
    const int wq = wid & 3, half = wid >> 2;
    const int NT = (P0 + P_QB) / KVBLK;
    const int qlo = P0 + wq * QBLK, qm = qlo + r32 - 4 * hi;
    char* K_lds = lds + L_K; char* V_lds = lds + L_V;
    float* ws = (float*)(lds + L_WS) + wid * 64; float* li_l = ws; float* al_l = ws + 32;
    float* Mmine = (float*)(lds + L_M) + wid * 64 + lane; const float* Mpart = (const float*)(lds + L_M) + (wid ^ 4) * 64 + lane;
    u32x4* Pmine = (u32x4*)(lds + L_P + wid * 2048) + lane; const u32x4* Ppart = (const u32x4*)(lds + L_P + (wid ^ 4) * 2048) + lane;
    const int sr = tid >> 4, sc = (tid & 15) * 8, vst0 = v_st(sr, sc), vst1 = v_st(32 + sr, sc), kws = KSWZ(sr, sc * 2);
    const int vb0 = (int)(uintptr_t)V_lds + half * SHM_V + v_rd_base(lane);
    const unsigned sof0 = (unsigned)(sr * D + sc) * 2u;
    bf16x8 qr[8];
    bf16x8 st_k0, st_k1, st_v00, st_v01, st_v10, st_v11;
    if constexpr (HAVE) { st_k0 = sk0; st_k1 = sk1; } else { st_k0 = *(const bf16x8*)((const char*)Kp + sof0); st_k1 = *(const bf16x8*)((const char*)Kp + 32 * D * 2 + sof0); }
#pragma unroll
    for (int d0 = 0; d0 < 8; ++d0) { if constexpr (HAVE) qr[d0] = sq[d0]; else qr[d0] = load8<bf16>(Qp + (size_t)(wq * QBLK + r32) * D + d0 * 16 + hi * 8); }
    const char* kb[4];
#pragma unroll
    for (int dd = 0; dd < 4; ++dd) kb[dd] = K_lds + half * (32 * 256) + KSWZ(r32, (dd * 16 + hi * 8) * 2);
    float m_reg = -1e30f, l_reg = 0.f;
#pragma unroll
    for (int d_ = 0; d_ < 4; ++d_) o[d_] = f32x16{};
#define PLOAD(k0) do { st_k0 = load8<bf16>(Kp + (size_t)((k0) + sr) * D + sc); st_k1 = load8<bf16>(Kp + (size_t)((k0) + 32 + sr) * D + sc);            \
                       st_v00 = load8<bf16>(V0p + (size_t)((k0) + sr) * D + sc); st_v01 = load8<bf16>(V0p + (size_t)((k0) + 32 + sr) * D + sc);        \
                       st_v10 = load8<bf16>(V1p + (size_t)((k0) + sr) * D + sc); st_v11 = load8<bf16>(V1p + (size_t)((k0) + 32 + sr) * D + sc); } while (0)
#define PWRITE(bf) do { *(bf16x8*)(K_lds + (bf) * SHM_K + kws) = st_k0; *(bf16x8*)(K_lds + (bf) * SHM_K + kws + 32 * 256) = st_k1;                       \
                        *(bf16x8*)(V_lds + (bf) * SHM_VT + vst0) = st_v00; *(bf16x8*)(V_lds + (bf) * SHM_VT + vst1) = st_v01;                             \
                        *(bf16x8*)(V_lds + (bf) * SHM_VT + SHM_V + vst0) = st_v10; *(bf16x8*)(V_lds + (bf) * SHM_VT + SHM_V + vst1) = st_v11; } while (0)
#define PTRRD(dst, base, off) asm volatile("ds_read_b64_tr_b16 %0, %1 offset:%2" : "=&v"(dst) : "v"(base), "i"(off) : "memory")
#define PPV_D0(d0) do { s16x4 l0, l1, l2, l3, h0, h1, h2, h3; constexpr int b_ = v_rd_off(d0, 0, 0);                                                        \
        PTRRD(l0, vbo, b_); PTRRD(h0, vbo, b_ + 2048); PTRRD(l1, vbo, b_ + 4096); PTRRD(h1, vbo, b_ + 6144); PTRRD(l2, vbp, b_); PTRRD(h2, vbp, b_ + 2048); PTRRD(l3, vbp, b_ + 4096); PTRRD(h3, vbp, b_ + 6144); \
        asm volatile("s_waitcnt lgkmcnt(0)" ::: "memory"); SBAR(); __builtin_amdgcn_s_setprio(1);                                                             \
        o[d0] = __builtin_amdgcn_mfma_f32_32x32x16_bf16(own0_, (bf16x8){l0[0], l0[1], l0[2], l0[3], h0[0], h0[1], h0[2], h0[3]}, o[d0], 0, 0, 0);             \
        o[d0] = __builtin_amdgcn_mfma_f32_32x32x16_bf16(own1_, (bf16x8){l1[0], l1[1], l1[2], l1[3], h1[0], h1[1], h1[2], h1[3]}, o[d0], 0, 0, 0);             \
        o[d0] = __builtin_amdgcn_mfma_f32_32x32x16_bf16(pt0, (bf16x8){l2[0], l2[1], l2[2], l2[3], h2[0], h2[1], h2[2], h2[3]}, o[d0], 0, 0, 0);               \
        o[d0] = __builtin_amdgcn_mfma_f32_32x32x16_bf16(pt1, (bf16x8){l3[0], l3[1], l3[2], l3[3], h3[0], h3[1], h3[2], h3[3]}, o[d0], 0, 0, 0); __builtin_amdgcn_s_setprio(0); } while (0)
#define PPV(vbuf, own0, own1) do { const u32x4 q0_ = Ppart[0], q1_ = Ppart[64]; const bf16x8 pt0 = __builtin_bit_cast(bf16x8, q0_), pt1 = __builtin_bit_cast(bf16x8, q1_), own0_ = own0, own1_ = own1;   \
        const int vbo = vb0 + (vbuf) * SHM_VT + half * 8192, vbp = vb0 + (vbuf) * SHM_VT + (half ^ 1) * 8192; PPV_D0(0); PPV_D0(1); PPV_D0(2); PPV_D0(3); } while (0)
    constexpr float C2 = 1.4426950408889634f * SCALE;
#define PBAR() asm volatile("s_waitcnt lgkmcnt(0)\n\ts_barrier" ::: "memory")
#define PLOADK(k0) do { const char* kt_ = (const char*)Kp + (size_t)(k0) * (D * 2); st_k0 = *(const bf16x8*)(kt_ + sof0); st_k1 = *(const bf16x8*)(kt_ + 32 * D * 2 + sof0); } while (0)
#define PLOADV(k0) do { const char* v0_ = (const char*)V0p + (size_t)(k0) * (D * 2); const char* v1_ = (const char*)V1p + (size_t)(k0) * (D * 2);                          \
                        st_v00 = *(const bf16x8*)(v0_ + sof0); st_v01 = *(const bf16x8*)(v0_ + 32 * D * 2 + sof0); st_v10 = *(const bf16x8*)(v1_ + sof0); st_v11 = *(const bf16x8*)(v1_ + 32 * D * 2 + sof0); } while (0)
#define PWRITEK(bf) do { *(bf16x8*)(K_lds + (bf) * SHM_K + kws) = st_k0; *(bf16x8*)(K_lds + (bf) * SHM_K + kws + 32 * 256) = st_k1; } while (0)
#define PWRITEV(bf) do { *(bf16x8*)(V_lds + (bf) * SHM_VT + vst0) = st_v00; *(bf16x8*)(V_lds + (bf) * SHM_VT + vst1) = st_v01;                            \
                         *(bf16x8*)(V_lds + (bf) * SHM_VT + SHM_V + vst0) = st_v10; *(bf16x8*)(V_lds + (bf) * SHM_VT + SHM_V + vst1) = st_v11; } while (0)
#define PQKT(P, bf) do { P = f32x16{}; bf16x8 kf_[8];                                                                                                     \
        _Pragma("unroll") for (int d0 = 0; d0 < 8; ++d0) kf_[d0] = *reinterpret_cast<const bf16x8*>(kb[d0 & 3] + (d0 >> 2) * 128 + (bf) * SHM_K);            \
        __builtin_amdgcn_s_setprio(1);                                                                                                                  \
        _Pragma("unroll") for (int d0 = 0; d0 < 8; ++d0) P = __builtin_amdgcn_mfma_f32_32x32x16_bf16(kf_[d0], qr[d0], P, 0, 0, 0);                          \
        __builtin_amdgcn_s_setprio(0); } while (0)
#define PMAX(P, t, LM) do { const int kb_ = (t) * KVBLK + half * 32;                                                                                      \
        if (kb_ + 31 > qlo) { const float NEG = -__builtin_inff(); const int dq = qm - kb_;                                                              \
            _Pragma("unroll") for (int r = 0; r < 16; ++r) { const int c = (r & 3) + 8 * (r >> 2); if (dq - c < 0) P[r] = NEG; } }                       \
        LM = fmaxf(fmaxf(P[0], P[1]), P[2]); _Pragma("unroll") for (int r = 3; r < 15; r += 2) LM = fmaxf(fmaxf(LM, P[r]), P[r + 1]); LM = fmaxf(LM, P[15]);                                                                       \
        { auto rr = __builtin_amdgcn_permlane32_swap(__float_as_uint(LM), __float_as_uint(LM), false, false); LM = fmaxf(__uint_as_float(rr[0]), __uint_as_float(rr[1])); } \
        Mmine[((t) & 1) * (NW * 64)] = LM; } while (0)
#define PPK4(P, B_, OUT) do { unsigned a0 = cvtpk(P[B_ + 0], P[B_ + 1]), a1 = cvtpk(P[B_ + 2], P[B_ + 3]), b0 = cvtpk(P[B_ + 4], P[B_ + 5]), b1 = cvtpk(P[B_ + 6], P[B_ + 7]);  \
        auto r0 = __builtin_amdgcn_permlane32_swap(a0, b0, false, false); auto r1 = __builtin_amdgcn_permlane32_swap(a1, b1, false, false);                  \
        u32x4 w = {r0[0], r1[0], r0[1], r1[1]}; OUT = *reinterpret_cast<bf16x8*>(&w); } while (0)
#define PSOFT(P, tt, LM, AL) do { const float pmax = fmaxf(LM, Mpart[((tt) & 1) * (NW * 64)]);                                                           \
        const bool defer = __all((pmax - m_reg) * SCALE <= THR); const float mn = defer ? m_reg : fmaxf(m_reg, pmax);                                    \
        AL = __builtin_amdgcn_exp2f((m_reg - mn) * C2); m_reg = mn; const float mnL = -mn * C2;                                                          \
        _Pragma("unroll") for (int r = 0; r < 16; ++r) P[r] = __builtin_amdgcn_exp2f(fmaf(P[r], C2, mnL));                                               \
        float ps = 0.f; _Pragma("unroll") for (int r = 0; r < 16; ++r) ps += P[r];                                                                        \
        { auto rr = __builtin_amdgcn_permlane32_swap(__float_as_uint(ps), __float_as_uint(ps), false, false); ps = __uint_as_float(rr[0]) + __uint_as_float(rr[1]); } \
        l_reg = l_reg * AL + ps; PPK4(P, 0, pa_o0); PPK4(P, 8, pa_o1);                                                                                    \
        Pmine[0] = __builtin_bit_cast(u32x4, pa_o0); Pmine[64] = __builtin_bit_cast(u32x4, pa_o1); } while (0)
#define PRESC(AL) do { if (__any((AL) < 1.f)) { if (hi == 0) al_l[r32] = (AL); asm volatile("s_waitcnt lgkmcnt(0)" ::: "memory");                       \
        _Pragma("unroll") for (int d_ = 0; d_ < 4; ++d_) _Pragma("unroll") for (int r = 0; r < 16; ++r) o[d_][r] *= al_l[crow(r, hi)]; } } while (0)
    bf16x8 pa_o0 = {}, pa_o1 = {};
    f32x16 p_old, p_new; float lm_old, lm_new, alpha;
    PWRITEK(0);
    PBAR();
    PLOADK(KVBLK); PLOADV(0);
    PQKT(p_old, 0); PMAX(p_old, 0, lm_old);
    PBAR();
    PWRITEK(1);
    PBAR();
#define PSTEP(PO, LMO, PN, LMN, t_, LAST) do { const int bf = (t_) & 1; const int tn = ((t_) + 1 < NT) ? (t_) + 1 : NT - 1;                                     \
        PWRITEV(bf ^ 1);                                                                                                                                     \
        if (!(LAST)) { PLOADK(tn * KVBLK); PLOADV((t_) * KVBLK); PQKT(PN, bf); }                                                                              \
        PSOFT(PO, (t_) - 1, LMO, alpha);                                                                                                                     \
        if (!(LAST)) { PMAX(PN, (t_), LMN); }                                                                                                                 \
        PRESC(alpha);                                                                                                                                        \
        PBAR();                                                                                                                                              \
        if (!(LAST)) { PWRITEK(bf ^ 1); }                                                                                                                     \
        PPV(bf ^ 1, pa_o0, pa_o1);                                                                                                                           \
        PBAR(); } while (0)
    for (int t = 1; t < NT; t += 2) { PSTEP(p_old, lm_old, p_new, lm_new, t, false); PSTEP(p_new, lm_new, p_old, lm_old, t + 1, (t + 1 == NT)); }
    if constexpr (PRE) {
#pragma unroll
        for (int d0 = 0; d0 < 8; ++d0) sq[d0] = load8<bf16>(Qn + (size_t)(wq * QBLK + r32) * D + d0 * 16 + hi * 8);
        sk0 = *(const bf16x8*)((const char*)Kn + sof0); sk1 = *(const bf16x8*)((const char*)Kn + 32 * D * 2 + sof0);
    }
    *Mmine = l_reg;
    PBAR();
    const float l_tot = l_reg + *Mpart;
    if (hi == 0) li_l[r32] = l_tot; asm volatile("s_waitcnt lgkmcnt(0)" ::: "memory");
    float rli[16];
#pragma unroll
    for (int r = 0; r < 16; ++r) rli[r] = __builtin_amdgcn_rcpf(li_l[crow(r, hi)]);
#pragma unroll
    for (int r = 0; r < 16; ++r)
#pragma unroll
        for (int d0 = 0; d0 < 4; ++d0) o[d0][r] *= rli[r];
    PBAR();
#undef PLOAD
#undef PWRITE
#undef PTRRD
#undef PPV_D0
#undef PPV
#undef PPK4
#undef PBAR
#undef PSTEP
#undef PLOADK
#undef PLOADV
#undef PWRITEK
#undef PWRITEV
#undef PQKT
#undef PMAX
#undef PSOFT
#undef PRESC
}

__device__ __forceinline__ void diff_block(const bf16* Qp, const bf16* Kp, const bf16* V0p, const bf16* V1p, int P0, char* lds, float lam, float oscale, const float* gain, unsigned short* mixrow0, int plane, u32x4* park) {
    f32x16 o[4];
    bf16x8 sq[8], sk0, sk1;
    pair_core<false, true>(Qp, Kp, V0p, V1p, P0, lds, o, sq, sk0, sk1, Qp + (size_t)plane, Kp + (size_t)plane);
    { int t2 = threadIdx.x; asm volatile("" : "+v"(t2)); u32x4* pk = park + (t2 >> 6) * 512 + (t2 & 63);
#pragma unroll
        for (int d0 = 0; d0 < 4; ++d0)
#pragma unroll
            for (int j4 = 0; j4 < 2; ++j4) { u32x4 w; w.x = cvtpk(o[d0][8 * j4], o[d0][8 * j4 + 1]); w.y = cvtpk(o[d0][8 * j4 + 2], o[d0][8 * j4 + 3]); w.z = cvtpk(o[d0][8 * j4 + 4], o[d0][8 * j4 + 5]); w.w = cvtpk(o[d0][8 * j4 + 6], o[d0][8 * j4 + 7]);
                pk[(d0 * 2 + j4) * 64] = w; } }
    pair_core<true, false>(Qp + (size_t)plane, Kp + (size_t)plane, V0p, V1p, P0, lds, o, sq, sk0, sk1, Qp, Kp);
    int tid_o = threadIdx.x; asm volatile("" : "+v"(tid_o));
    const int tid = tid_o, wid = __builtin_amdgcn_readfirstlane(tid >> 6), lane = tid & 63, r32 = lane & 31, hi = lane >> 5, wq = wid & 3, half = wid >> 2;
    unsigned op[4][8];
    { const u32x4* pk = park + wid * 512 + lane;
#pragma unroll
        for (int d0 = 0; d0 < 4; ++d0)
#pragma unroll
            for (int j4 = 0; j4 < 2; ++j4) { const u32x4 w = pk[(d0 * 2 + j4) * 64]; op[d0][4 * j4] = w.x; op[d0][4 * j4 + 1] = w.y; op[d0][4 * j4 + 2] = w.z; op[d0][4 * j4 + 3] = w.w; } }
    float q[16];
#pragma unroll
    for (int r = 0; r < 16; ++r) { q[r] = 0.f;
#pragma unroll
        for (int d0 = 0; d0 < 4; ++d0) { const unsigned w = op[d0][r >> 1]; const float a = (r & 1) ? __uint_as_float(w & 0xffff0000u) : __uint_as_float(w << 16);
            const float d = a - lam * o[d0][r]; o[d0][r] = d; q[r] += d * d; } }
#pragma unroll
    for (int r = 0; r < 16; ++r) { q[r] += swz<1>(q[r]); q[r] += swz<2>(q[r]); q[r] += swz<4>(q[r]); q[r] += swz<8>(q[r]); q[r] += swz<16>(q[r]); }
    float* X = (float*)(lds + L_M) + wid * 64; const float* Xp = (const float*)(lds + L_M) + (wid ^ 4) * 64;
    if (r32 == 0) {
#pragma unroll
        for (int r = 0; r < 16; ++r) X[crow(r, hi)] = q[r];
    }
    asm volatile("s_waitcnt lgkmcnt(0)\n\ts_barrier" ::: "memory");
    float g[4];
#pragma unroll
    for (int d0 = 0; d0 < 4; ++d0) g[d0] = gain[half * 128 + d0 * 32 + r32];
    unsigned short* orow = mixrow0 + (size_t)(wq * QBLK) * 2048 + half * 128;
#pragma unroll
    for (int r = 0; r < 16; ++r) { const int rw = crow(r, hi); const float ss = q[r] + Xp[rw]; const float rs = oscale / sqrtf(ss * (1.0f / 256.0f) + 1e-6f);
#pragma unroll
        for (int d0 = 0; d0 < 4; ++d0) { const float v = o[d0][r] * rs * g[d0];
            orow[(size_t)rw * 2048 + d0 * 32 + r32] = (unsigned short)cvtpk(v, v); } }
    asm volatile("s_waitcnt lgkmcnt(0)\n\ts_barrier" ::: "memory");
}
}
constexpr int BATCH = 8, SEQ = 4096, DM = 2048, DEPTH = 2, M = BATCH * SEQ;
constexpr int NZ = 5632, DFF = 5632;
constexpr float RMS_EPS = 1e-6f, LN_EPS = 1e-5f;
constexpr int NWAVES = 8;
#ifndef MK_PER_PHASE
#define MK_PER_PHASE 0
#endif
constexpr int LPH = 5;
constexpr int N_PHASES = 2 + LPH * DEPTH;
#ifndef REP_P0
#define REP_P0 1
#endif
#ifndef REP_GEMM
#define REP_GEMM 1
#endif
#ifndef REP_THIN
#define REP_THIN 1
#endif
#ifndef REP_MIX
#define REP_MIX 1
#endif
#ifndef REP_ATT
#define REP_ATT 1
#endif
constexpr size_t MiB = 1u << 20;
constexpr size_t WS_ROPE = 1 * MiB;
constexpr size_t WS_W = 17 * MiB, W_LAYER = 96 * MiB;
constexpr size_t WO_IN = 0, WO_OUT = 22 * MiB, WO_GU = 30 * MiB, WO_DOWN = 74 * MiB;
constexpr size_t WS_Z = 210 * MiB;
constexpr size_t WS_H = 562 * MiB;
constexpr size_t WS_MIX = 690 * MiB;
constexpr size_t WS_V = 818 * MiB;
constexpr size_t WS_O = 882 * MiB;
constexpr size_t WS_END = 1015 * MiB;
constexpr int LDS_BYTES = 136192;

#define LAS __attribute__((address_space(3)))
typedef unsigned short bf16;
typedef unsigned v4u __attribute__((ext_vector_type(4)));
typedef unsigned v2u __attribute__((ext_vector_type(2)));
typedef float f32x4 __attribute__((ext_vector_type(4)));
typedef short bf16x8 __attribute__((ext_vector_type(8)));
#define LDS_WAIT() asm volatile("s_waitcnt lgkmcnt(0)" ::: "memory")
__device__ __forceinline__ unsigned f2bf(float f) { unsigned u = __builtin_bit_cast(unsigned, f); return (u + 0x7fffu + ((u >> 16) & 1u)) >> 16; }
__device__ __forceinline__ unsigned pk2(float lo, float hi) { return f2bf(lo) | (f2bf(hi) << 16); }
__device__ __forceinline__ float bflo(unsigned w) { return __uint_as_float(w << 16); }
__device__ __forceinline__ float bfhi(unsigned w) { return __uint_as_float(w & 0xffff0000u); }
__device__ __forceinline__ void unpack8(const v4u w, float* f) { f[0] = bflo(w.x); f[1] = bfhi(w.x); f[2] = bflo(w.y); f[3] = bfhi(w.y); f[4] = bflo(w.z); f[5] = bfhi(w.z); f[6] = bflo(w.w); f[7] = bfhi(w.w); }
__device__ __forceinline__ v4u pack8f(const float* f) { v4u w; w.x = pk2(f[0], f[1]); w.y = pk2(f[2], f[3]); w.z = pk2(f[4], f[5]); w.w = pk2(f[6], f[7]); return w; }
__device__ __forceinline__ float wave_sum(float v) { v += swz<1>(v); v += swz<2>(v); v += swz<4>(v); v += swz<8>(v); v += swz<16>(v); return sum32(v); }
__device__ __forceinline__ float gelu_exact(float v) {
    const float av = fabsf(v), t = __builtin_amdgcn_rcpf(av * 0.2316418882f + 1.0f);
    float q = t * 0.5307027145f + (-0.7265760135f); q = q * t + 0.7107068705f; q = q * t + (-0.142248368f); q = q * t + 0.127414796f; q = q * t;
    const float e = __builtin_amdgcn_exp2f((v * v) * (-0.72134752044f));
    const float m = v * (q * e);
    return v < 0.f ? m : v - m;
}

__device__ __forceinline__ void transpose_item(const float* W, int K, int N, bf16* WT, int k0, int n0, int drow0, const float* gain, LAS float* scr, int lane) {
    float wv[32];
    const float* wp = W + (size_t)(k0 + (lane >> 5)) * N + n0 + (lane & 31);
#pragma unroll
    for (int i = 0; i < 32; ++i) wv[i] = wp[(size_t)(2 * i) * N];
    if (gain) {
#pragma unroll
        for (int i = 0; i < 32; ++i) wv[i] *= gain[k0 + 2 * i + (lane >> 5)];
    }
#pragma unroll
    for (int i = 0; i < 32; ++i) scr[(2 * i + (lane >> 5)) * 33 + (lane & 31)] = wv[i];
    LDS_WAIT(); asm volatile("" ::: "memory");
    const int c = lane & 7;
#pragma unroll
    for (int j = 0; j < 4; ++j) { const int n = (lane >> 3) + 8 * j; const LAS float* s = scr + (8 * c) * 33 + n;
        v4u o; o.x = pk2(s[0 * 33], s[1 * 33]); o.y = pk2(s[2 * 33], s[3 * 33]); o.z = pk2(s[4 * 33], s[5 * 33]); o.w = pk2(s[6 * 33], s[7 * 33]);
        *(v4u*)(WT + (size_t)(drow0 + n) * K + k0 + 8 * c) = o; }
    LDS_WAIT(); asm volatile("" ::: "memory");
}
__device__ __forceinline__ void x_row_to_bf16(const float* xrow, bf16* orow, float* ssq, int lane) {
    const f32x4* xr = (const f32x4*)xrow + lane; f32x4 v[8]; float s = 0.f;
#pragma unroll
    for (int j = 0; j < 8; ++j) { v[j] = xr[64 * j]; s += (v[j].x * v[j].x + v[j].y * v[j].y) + (v[j].z * v[j].z + v[j].w * v[j].w); }
    s = wave_sum(s);
#pragma unroll
    for (int j = 0; j < 8; ++j) { v2u w; w.x = pk2(v[j].x, v[j].y); w.y = pk2(v[j].z, v[j].w); ((v2u*)orow + lane)[64 * j] = w; }
    if (lane < 8) ssq[lane] = lane == 0 ? s : 0.f;
}
__device__ __forceinline__ void final_row(const bf16* xrow, float ssq, const float* g, float* orow, int lane) {
    const float rstd = 1.0f / sqrtf(ssq * (1.0f / DM) + RMS_EPS);
#pragma unroll
    for (int j = 0; j < 4; ++j) { const int c = 8 * lane + 512 * j; float x[8]; unpack8(*(const v4u*)(xrow + c), x);
        const f32x4 g0 = *(const f32x4*)(g + c), g1 = *(const f32x4*)(g + c + 4);
        *(f32x4*)(orow + c) = (f32x4){x[0] * rstd * g0[0], x[1] * rstd * g0[1], x[2] * rstd * g0[2], x[3] * rstd * g0[3]};
        *(f32x4*)(orow + c + 4) = (f32x4){x[4] * rstd * g1[0], x[5] * rstd * g1[1], x[6] * rstd * g1[2], x[7] * rstd * g1[3]}; }
}
typedef __attribute__((address_space(1))) unsigned gu32;
constexpr size_t WS_CTL = 0, CTL_ZERO_BYTES = 65536; constexpr int CW_BAR = 4096;
constexpr size_t WS_SSQ = 1010 * MiB;
constexpr int MISC_OFF = 131072, PSTAT_OFF = 131072 + 64;
#define XB_TMO      128
#define XB_XCNT(j)  (256  + 64 * (j))
#define XB_XSUB(j)  (1280 + 64 * (j))
#define XB_XGEN(j)  (2304 + 64 * (j))
#define XB_TOP      3328
#define XB_TOPGEN   3392
#define XCD_BAR_WORDS 3456
#define XB_SPIN_CAP (1u << 18)

__device__ __forceinline__ unsigned xb_ld(unsigned* p)              { return __hip_atomic_load(p, __ATOMIC_RELAXED, __HIP_MEMORY_SCOPE_AGENT); }
__device__ __forceinline__ unsigned xb_add(unsigned* p, unsigned v) { return __hip_atomic_fetch_add(p, v, __ATOMIC_RELAXED, __HIP_MEMORY_SCOPE_AGENT); }
__device__ __forceinline__ unsigned xb_xcc_id() { return (unsigned)__builtin_amdgcn_s_getreg((3 << 11) | 20) & 0xFu; }
#define XB_SPIN(cond, bar) do { unsigned _sp = 0; while (cond) { __builtin_amdgcn_s_sleep(1); \
    if ((++_sp & 255u) == 0u) { if (xb_ld(&(bar)[XB_TMO])) break; if (_sp > XB_SPIN_CAP) { atomicAdd(&(bar)[XB_TMO], 1u); break; } } } } while (0)

struct XcdBarrier {
    unsigned* bar; unsigned x;
    volatile LAS unsigned* st;
};

__device__ __forceinline__ XcdBarrier xcd_barrier_post(unsigned* bar, volatile LAS unsigned* st) {
    XcdBarrier b; b.bar = bar; b.x = xb_xcc_id(); b.st = st;
    if (threadIdx.x == 0) (void)xb_add(&bar[XB_XCNT(b.x)], 1u);
    return b;
}
__device__ __forceinline__ void xcd_barrier_complete(unsigned* bar, unsigned x, unsigned& nloc, unsigned& nx) {
    const unsigned G = gridDim.x * gridDim.y * gridDim.z;
    unsigned sum, cnt, mine, sp = 0u;
    for (;;) {
        sum = 0u; cnt = 0u; mine = 0u;
#pragma unroll
        for (unsigned j = 0; j < 16; ++j) { const unsigned c = xb_ld(&bar[XB_XCNT(j)]); sum += c; cnt += (c > 0u) ? 1u : 0u; mine = (j == x) ? c : mine; }
        if (sum == G) break;
        __builtin_amdgcn_s_sleep(1);
        if ((++sp & 255u) == 0u) { if (xb_ld(&bar[XB_TMO])) break; if (sp > XB_SPIN_CAP) { atomicAdd(&bar[XB_TMO], 1u); break; } }
    }
    nloc = mine > 0u ? mine : 1u; nx = cnt > 0u ? cnt : 1u;
}

__device__ __forceinline__ void xcd_barrier(const XcdBarrier& b) {
    asm volatile("s_waitcnt vmcnt(0)" ::: "memory");
    __syncthreads();
    if (threadIdx.x == 0) {
        unsigned* bar = b.bar;
        __builtin_amdgcn_s_waitcnt(0);
        unsigned nloc = b.st[0], nx = b.st[1];
        if (nloc == 0u) { xcd_barrier_complete(bar, b.x, nloc, nx); b.st[0] = nloc; b.st[1] = nx; }
        const unsigned old = xb_add(&bar[XB_XSUB(b.x)], 1u);
        const unsigned gen = old / nloc;
        if (old + 1u == (gen + 1u) * nloc) {
            __builtin_amdgcn_fence(__ATOMIC_RELEASE, "agent");
            asm volatile("s_waitcnt vmcnt(0)" ::: "memory");
            const unsigned og = xb_add(&bar[XB_TOP], 1u);
            const unsigned tg = og / nx;
            if (og + 1u == (tg + 1u) * nx) xb_add(&bar[XB_TOPGEN], 1u);
            else XB_SPIN(xb_ld(&bar[XB_TOPGEN]) == tg, bar);
            __builtin_amdgcn_fence(__ATOMIC_ACQUIRE, "agent");
            xb_add(&bar[XB_XGEN(b.x)], 1u);
            asm volatile("s_waitcnt vmcnt(0)" ::: "memory");
        } else {
            XB_SPIN(xb_ld(&bar[XB_XGEN(b.x)]) == gen, bar);
            __builtin_amdgcn_fence(__ATOMIC_ACQUIRE, "agent");
            asm volatile("s_waitcnt vmcnt(0)" ::: "memory");
        }
    }
    __syncthreads();
}
struct Args { const void* in[20]; float* out; unsigned char* ws; int ph_lo, ph_hi; };

__device__ __forceinline__ void gmlp_unit(int unit, const bf16* z, bf16* mix, const float* ln_g, const float* ln_b, const float* wsp, const float* bsp, const float* mixn,
                                          LAS unsigned char* lds, int tid, int lane, int wave) {
    const int g = unit & 3, n = (unit >> 2) & 31, b = unit >> 7;
    const size_t row0 = (size_t)b * SEQ + (size_t)n * 128;
    LAS unsigned short* vnT = (LAS unsigned short*)lds;
    {
        const int s = tid >> 2, cq = tid & 3;
        const bf16* src = z + (row0 + s) * NZ + 512 + g * 128 + cq * 32;
        float v[32]; float sum = 0.f;
#pragma unroll
        for (int i = 0; i < 4; ++i) { const v4u w = *(const v4u*)(src + i * 8); unpack8(w, v + i * 8); }
#pragma unroll
        for (int i = 0; i < 32; ++i) { v[i] = gelu_exact(v[i]); sum += v[i]; }
        sum += swz<1>(sum); sum += swz<2>(sum);
        const float mu = sum * (1.0f / 128.0f); float q = 0.f;
#pragma unroll
        for (int i = 0; i < 32; ++i) { v[i] -= mu; q += v[i] * v[i]; }
        q += swz<1>(q); q += swz<2>(q);
        const float rstd = 1.0f / sqrtf(q * (1.0f / 128.0f) + LN_EPS);
        const float* gp = ln_g + g * 128 + cq * 32; const float* bp = ln_b + g * 128 + cq * 32;
#pragma unroll
        for (int i = 0; i < 8; ++i) { const f32x4 gg = *(const f32x4*)(gp + 4 * i), bb = *(const f32x4*)(bp + 4 * i);
#pragma unroll
            for (int e = 0; e < 4; ++e) { const float vn = v[4 * i + e] * rstd * gg[e] + bb[e]; vnT[(cq * 32 + 4 * i + e) * 136 + s] = (unsigned short)f2bf(vn); } }
    }
    __syncthreads();
    {
        const int tcol = lane & 15, quad = lane >> 4, t = 16 * wave + tcol, nks = (wave >> 1) + 1;
        f32x4 acc[8];
#pragma unroll
        for (int ct = 0; ct < 8; ++ct) acc[ct] = (f32x4){0.f, 0.f, 0.f, 0.f};
        const float* wrow = wsp + ((size_t)g * 128 + t) * 128;
        for (int ks = 0; ks < nks; ++ks) {
            const int s0 = 32 * ks + 8 * quad;
            const f32x4 w0 = *(const f32x4*)(wrow + s0), w1 = *(const f32x4*)(wrow + s0 + 4);
            float wf[8] = {w0[0], w0[1], w0[2], w0[3], w1[0], w1[1], w1[2], w1[3]};
#pragma unroll
            for (int e = 0; e < 8; ++e) if (s0 + e > t) wf[e] = 0.f;
            const v4u bw = pack8f(wf); const bf16x8 bfrag = __builtin_bit_cast(bf16x8, bw);
#pragma unroll
            for (int ct = 0; ct < 8; ++ct) { const bf16x8 a = *(const LAS bf16x8*)(vnT + (16 * ct + tcol) * 136 + s0);
                acc[ct] = __builtin_amdgcn_mfma_f32_16x16x32_bf16(a, bfrag, acc[ct], 0, 0, 0); }
        }
        const float bst = bsp[g * 128 + t];
        const size_t m = row0 + t; const bf16* up = z + m * NZ + g * 128 + 4 * quad; float ss = 0.f;
#pragma unroll
        for (int ct = 0; ct < 8; ++ct) { const v2u uw = *(const v2u*)(up + 16 * ct);
            const float u0 = gelu_exact(bflo(uw.x)), u1 = gelu_exact(bfhi(uw.x)), u2 = gelu_exact(bflo(uw.y)), u3 = gelu_exact(bfhi(uw.y));
            acc[ct][0] = u0 * (acc[ct][0] + bst); acc[ct][1] = u1 * (acc[ct][1] + bst); acc[ct][2] = u2 * (acc[ct][2] + bst); acc[ct][3] = u3 * (acc[ct][3] + bst);
            ss += (acc[ct][0] * acc[ct][0] + acc[ct][1] * acc[ct][1]) + (acc[ct][2] * acc[ct][2] + acc[ct][3] * acc[ct][3]); }
        ss += swz<16>(ss); ss = sum32(ss);
        const float r = 1.0f / sqrtf(ss * (1.0f / 128.0f) + RMS_EPS);
        bf16* op = mix + m * DM + g * 128 + 4 * quad; const float* np = mixn + g * 128 + 4 * quad;
        f32x4 gnv[8];
#pragma unroll
        for (int ct = 0; ct < 8; ++ct) gnv[ct] = *(const f32x4*)(np + 16 * ct);
#pragma unroll
        for (int ct = 0; ct < 8; ++ct) { const f32x4 gn = gnv[ct]; v2u w;
            w.x = pk2(acc[ct][0] * r * gn[0], acc[ct][1] * r * gn[1]); w.y = pk2(acc[ct][2] * r * gn[2], acc[ct][3] * r * gn[3]); *(v2u*)(op + 16 * ct) = w; }
    }
    __syncthreads();
}

#define OPQ_V(x) asm volatile("" : "+v"(x))
__global__ void __launch_bounds__(NWAVES * 64, 2) hymba_fwd(Args args) {
    extern __shared__ __attribute__((aligned(16))) unsigned char lds[];
    {
        if (threadIdx.x < 32) ((LAS unsigned*)((LAS unsigned char*)lds + MISC_OFF))[threadIdx.x] = 0u;
        __syncthreads();
        (void)xcd_barrier_post((unsigned*)(args.ws + WS_CTL) + CW_BAR, (volatile LAS unsigned*)((LAS unsigned char*)lds + MISC_OFF));
    }
    if (args.ph_lo == 0) {
        const int p = 0;
        LAS unsigned char* ldsp = (LAS unsigned char*)lds;
        int tid = threadIdx.x; OPQ_V(tid);
        const int lane = tid & 63, wave = __builtin_amdgcn_readfirstlane(tid >> 6);
        int zs = 0; asm volatile("" : "+s"(zs));
        const int G = gridDim.x + zs, bx = blockIdx.x + zs, vcu = (G % 8 == 0) ? (bx % 8) * (G / 8) + bx / 8 : bx;
        const int gw = vcu * NWAVES + wave, NGW = G * NWAVES;
        unsigned char* ws = args.ws;
        float* xo = args.out;
        bf16* Z = (bf16*)(ws + WS_Z); bf16* Hb = (bf16*)(ws + WS_H); bf16* MIX = (bf16*)(ws + WS_MIX); bf16* VB = (bf16*)(ws + WS_V); bf16* OB = (bf16*)(ws + WS_O);
        float* ctab = (float*)(ws + WS_ROPE); float* stab = ctab + (size_t)M * 64;
        const bool fin = (p == N_PHASES - 1); const int l = fin ? 0 : (p - 1) / LPH, kk = (p - 1) % LPH, k = fin ? 7 : (p == 0) ? -1 : (kk == 0 ? 0 : kk == 1 ? 2 : kk + 2);
        float* ssq = (float*)(ws + WS_SSQ); bf16* QKb = (bf16*)args.out;
        unsigned char* wl = ws + WS_W + (size_t)l * W_LAYER;
        const float* mixn = (const float*)args.in[13] + (size_t)l * DM;
        {
            const float* x_in = (const float*)args.in[0]; const int* positions = (const int*)args.in[1];
            LAS float* scr = (LAS float*)(ldsp + wave * 16384);
            constexpr int I_IN = 32 * 176, I_OUT = 32 * 64, I_G = 32 * 176, I_DN = 88 * 64, I_LAYER = I_IN + I_OUT + 2 * I_G + I_DN;
            for (int it = gw; it < DEPTH * I_LAYER; it += NGW) {
                const int ll = it / I_LAYER; int r = it - ll * I_LAYER;
                unsigned char* wll = ws + WS_W + (size_t)ll * W_LAYER;
                if (r < I_IN) { const int kb = r / 176, nb = r % 176, n0 = 32 * nb, o = n0 & 255;
                    const int dr = (n0 >= 1024 && n0 < 3072) ? (n0 & ~255) + 128 * ((o >> 6) & 1) + 64 * (o >> 7) + (o & 63) : n0;
                    transpose_item((const float*)args.in[3] + (size_t)ll * DM * NZ, DM, NZ, (bf16*)(wll + WO_IN), 64 * kb, n0, dr, (const float*)args.in[2] + ll * DM, scr, lane); continue; } r -= I_IN;
                if (r < I_OUT) { const int kb = r / 64, nb = r % 64; transpose_item((const float*)args.in[14] + (size_t)ll * DM * DM, DM, DM, (bf16*)(wll + WO_OUT), 64 * kb, 32 * nb, 32 * nb, nullptr, scr, lane); continue; } r -= I_OUT;
                if (r < 2 * I_G) { const int up = r >= I_G; if (up) r -= I_G; const int kb = r / 176, nb = r % 176, n0 = 32 * nb;
                    transpose_item((const float*)args.in[up ? 17 : 16] + (size_t)ll * DM * DFF, DM, DFF, (bf16*)(wll + WO_GU), 64 * kb, n0, (n0 >> 7) * 256 + (n0 & 127) + (up ? 128 : 0), (const float*)args.in[15] + ll * DM, scr, lane); continue; } r -= 2 * I_G;
                { const int kb = r / 64, nb = r % 64; transpose_item((const float*)args.in[18] + (size_t)ll * DFF * DM, DFF, DM, (bf16*)(wll + WO_DOWN), 64 * kb, 32 * nb, 32 * nb, nullptr, scr, lane); }
            }
            for (int e = vcu * 512 + tid; e < M * 64; e += G * 512) { const int m = e >> 6, j = e & 63;
                const float inv_freq = 1.0f / powf(10000.0f, (float)(2 * j) * (1.0f / 128.0f)); const float ang = (float)positions[m] * inv_freq;
                float sn, cs; sincosf(ang, &sn, &cs); ctab[e] = cs; stab[e] = sn; }
            {
                f32x4 va[8], vb[8];
#define XLD(V, m_) do { const f32x4* xr_ = (const f32x4*)(x_in + (size_t)(m_) * DM) + lane; _Pragma("unroll") for (int j = 0; j < 8; ++j) V[j] = xr_[64 * j]; } while (0)
#define XST(V, m_) do { float s_ = 0.f; _Pragma("unroll") for (int j = 0; j < 8; ++j) s_ += (V[j].x * V[j].x + V[j].y * V[j].y) + (V[j].z * V[j].z + V[j].w * V[j].w); s_ = wave_sum(s_);            \
        v2u* o_ = (v2u*)(Hb + (size_t)(m_) * DM) + lane; _Pragma("unroll") for (int j = 0; j < 8; ++j) { v2u w_; w_.x = pk2(V[j].x, V[j].y); w_.y = pk2(V[j].z, V[j].w); o_[64 * j] = w_; }                 \
        float* q_ = (float*)(ws + WS_SSQ) + (size_t)(m_) * 8; if (lane < 8) q_[lane] = lane == 0 ? s_ : 0.f; } while (0)
                XLD(va, gw);
                for (int m = gw; m < M; m += 2 * NGW) {
                    XLD(vb, m + NGW); XST(va, m);
                    if (m + 2 * NGW < M) XLD(va, m + 2 * NGW);
                    XST(vb, m + NGW); }
#undef XLD
#undef XST
            }
        }
        if (1 < args.ph_hi) { XcdBarrier bar; bar.bar = (unsigned*)(args.ws + WS_CTL) + CW_BAR; bar.x = xb_xcc_id(); bar.st = (volatile LAS unsigned*)((LAS unsigned char*)lds + MISC_OFF); xcd_barrier(bar); }
        if (args.ph_hi < 0) cg::this_grid().sync();
    }
    for (int p = (args.ph_lo == 0 ? 1 : args.ph_lo); p < args.ph_hi; ++p) {
        LAS unsigned char* ldsp = (LAS unsigned char*)lds;
        int zs = 0; asm volatile("" : "+s"(zs));
        const int G = gridDim.x + zs, bx = blockIdx.x + zs, vcu = (G % 8 == 0) ? (bx % 8) * (G / 8) + bx / 8 : bx;
        const int NGW = G * NWAVES;
#define PHASE_IDS() int tid = threadIdx.x; OPQ_V(tid); const int lane = tid & 63, wave = __builtin_amdgcn_readfirstlane(tid >> 6); const int gw = vcu * NWAVES + wave; (void)gw; (void)lane
        unsigned char* ws = args.ws;
        float* xo = args.out;
        bf16* Z = (bf16*)(ws + WS_Z); bf16* Hb = (bf16*)(ws + WS_H); bf16* MIX = (bf16*)(ws + WS_MIX); bf16* VB = (bf16*)(ws + WS_V); bf16* OB = (bf16*)(ws + WS_O);
        float* ctab = (float*)(ws + WS_ROPE); float* stab = ctab + (size_t)M * 64;
        const bool fin = (p == N_PHASES - 1); const int l = fin ? 0 : (p - 1) / LPH, kk = (p - 1) % LPH, k = fin ? 7 : (p == 0) ? -1 : (kk == 0 ? 0 : kk == 1 ? 2 : kk + 2);
        float* ssq = (float*)(ws + WS_SSQ); bf16* QKb = (bf16*)args.out;
        unsigned char* wl = ws + WS_W + (size_t)l * W_LAYER;
        const float* mixn = (const float*)args.in[13] + (size_t)l * DM;
#ifdef ONLY_ATT
        if (k != 2) continue;
#endif
        if (k == 0) {
            pg8::Gemm g{Hb, (const bf16*)(wl + WO_IN), M, NZ, DM}; pg8::StaticOrder S; S.init(M, NZ, G, bx);
            const float* sqp = ssq + (size_t)(2 * l) * M * 8;
            int pmA, pmB; { pg8::Unit u0; S.next(0, u0); pmA = pmB = u0.pm; for (int i = 1; S.next(i, u0); ++i) if (u0.pm != pmA) { pmB = u0.pm; break; } }
            { int t = threadIdx.x; OPQ_V(t); ((LAS float*)(ldsp + PSTAT_OFF))[t] = pg8::row_rstd(sqp, (t < 256 ? pmA : pmB) * 256 + (t & 255)); }
            __syncthreads();
            const pg8::RsTab T{(const LAS float*)(ldsp + PSTAT_OFF), pmA, pmB, sqp};
            pg8::EpiIn E{Z, NZ, T, QKb, VB, ctab, stab};
            pg8::gemm_phase<pg8::EpiIn, pg8::StaticOrder, PG8_ALIGN, PG8_SP2>(ldsp, g, S, E);
        } else if (k == 2) {
            PHASE_IDS();
            {
                const float* cw = (const float*)args.in[12] + (size_t)l * 3 * 512 + lane * 8;
                float w0[8], w1[8], w2[8], gn[8];
#pragma unroll
                for (int h2 = 0; h2 < 2; ++h2) { const f32x4 a = *(const f32x4*)(cw + 4 * h2), b = *(const f32x4*)(cw + 512 + 4 * h2), c = *(const f32x4*)(cw + 1024 + 4 * h2), d = *(const f32x4*)(mixn + 1536 + lane * 8 + 4 * h2);
#pragma unroll
                    for (int e = 0; e < 4; ++e) { w0[4 * h2 + e] = a[e]; w1[4 * h2 + e] = b[e]; w2[4 * h2 + e] = c[e]; gn[4 * h2 + e] = d[e]; } }
                v4u ra[7], rb7[7];
#define CLD(R, m_) do { const int t_ = (m_) & (SEQ - 1); const bf16* zr_ = Z + (size_t)(m_) * NZ + lane * 8; const bf16* z1_ = zr_ - (t_ >= 1 ? NZ : 0); const bf16* z2_ = zr_ - (t_ >= 2 ? 2 * NZ : 0);   \
        R[0] = *(const v4u*)(zr_ + 4096); R[1] = *(const v4u*)(zr_ + 4608); R[2] = *(const v4u*)(zr_ + 5120); R[3] = *(const v4u*)(z1_ + 4608); R[4] = *(const v4u*)(z1_ + 5120);                          \
        R[5] = *(const v4u*)(z2_ + 4608); R[6] = *(const v4u*)(z2_ + 5120); } while (0)
#define CST(R, m_) do { const int t_ = (m_) & (SEQ - 1); const float f1 = t_ >= 1 ? 1.f : 0.f, f2 = t_ >= 2 ? 1.f : 0.f;         \
        float bg[8], y[8], cgv[8], hcv[8]; unpack8(R[0], bg); unpack8(R[1], cgv); unpack8(R[2], hcv);                                                                                                   \
        _Pragma("unroll") for (int e = 0; e < 8; ++e) y[e] = w2[e] * (cgv[e] * hcv[e]);                                                                                                                 \
        unpack8(R[3], cgv); unpack8(R[4], hcv); _Pragma("unroll") for (int e = 0; e < 8; ++e) y[e] += f1 * w1[e] * (cgv[e] * hcv[e]);                                                                    \
        unpack8(R[5], cgv); unpack8(R[6], hcv); _Pragma("unroll") for (int e = 0; e < 8; ++e) y[e] += f2 * w0[e] * (cgv[e] * hcv[e]);                                                                    \
        float ss = 0.f; _Pragma("unroll") for (int e = 0; e < 8; ++e) { y[e] *= bg[e]; ss += y[e] * y[e]; }                                                                                             \
        ss += swz<1>(ss); ss += swz<2>(ss); ss += swz<4>(ss); ss += swz<8>(ss);                                                                                                                         \
        const float r = 1.0f / sqrtf(ss * (1.0f / 128.0f) + RMS_EPS);                                                                                                                                   \
        _Pragma("unroll") for (int e = 0; e < 8; ++e) y[e] = y[e] * r * gn[e];                                                                                                                          \
        *(v4u*)(MIX + (size_t)(m_) * DM + 1536 + lane * 8) = pack8f(y); } while (0)
                CLD(ra, gw);
                for (int m = gw; m < M; m += 2 * NGW) {
                    CLD(rb7, m + NGW); CST(ra, m);
                    if (m + 2 * NGW < M) CLD(ra, m + 2 * NGW);
                    CST(rb7, m + NGW); }
#undef CLD
#undef CST
            }
            __syncthreads();
            for (int u = vcu; u < BATCH * 32 * 4; u += G)
                gmlp_unit(u, Z, MIX, (const float*)args.in[4] + l * 512, (const float*)args.in[5] + l * 512, (const float*)args.in[6] + (size_t)l * 4 * 128 * 128, (const float*)args.in[7] + l * 512, mixn, ldsp, tid, lane, wave);
            __syncthreads();
            {
                using ab = att::bf16;
                static_assert(att::PAIR_LDS_BYTES <= 131072, "attention LDS fits the phase region");
                const float lam_init = 0.8f - 0.6f * expf(-0.3f * (float)l);
                const float* lq1 = (const float*)args.in[8] + l * 128; const float* lk1 = (const float*)args.in[9] + l * 128;
                const float* lq2 = (const float*)args.in[10] + l * 128; const float* lk2 = (const float*)args.in[11] + l * 128;
                const float d1 = wave_sum(lq1[lane] * lk1[lane] + lq1[lane + 64] * lk1[lane + 64]), d2 = wave_sum(lq2[lane] * lk2[lane] + lq2[lane + 64] * lk2[lane + 64]);
                const float lam = expf(d1) - expf(d2) + lam_init;
                constexpr int TOTAL = BATCH * 4 * 16;
                for (int L = vcu; L < TOTAL; L += G) {
                    const int bh = L >> 4, xx = L & 15, b = bh >> 2, h = bh & 3;
                    const ab* Kp = (const ab*)QKb + ((size_t)b * 16 + 8 + h * 2) * SEQ * 128; const ab* V0p = (const ab*)VB + ((size_t)b * 8 + h * 2) * SEQ * 128;
                    for (int pass = 0; pass < 2; ++pass) { const int qb = pass ? 31 - xx : xx;
                        const ab* Qp = (const ab*)QKb + (((size_t)b * 16 + h * 2) * SEQ + (size_t)qb * 128) * 128;
                        att::diff_block(Qp, Kp, V0p, V0p + (size_t)SEQ * 128, qb * 128, (char*)lds, lam, 1.0f - lam_init, mixn + 512 + h * 256,
                                        MIX + ((size_t)b * SEQ + (size_t)qb * 128) * DM + 512 + h * 256, SEQ * 128, (att::u32x4*)OB + (size_t)vcu * 4096); }
                }
            }
        } else if (k == 4 || k == 6) {
            const bool dn = (k == 6);
            pg8::Gemm g{dn ? Z : MIX, (const bf16*)(wl + (dn ? WO_DOWN : WO_OUT)), M, DM, dn ? DFF : DM}; pg8::StaticOrder S; S.init(M, DM, G, bx);
            pg8::EpiRes E{Hb, DM, ssq + (size_t)(2 * l + (dn ? 2 : 1)) * M * 8, (LAS float*)(ldsp + PSTAT_OFF)};
            pg8::gemm_phase<pg8::EpiRes, pg8::StaticOrder, PG8_ALIGN, PG8_SP2>(ldsp, g, S, E);
        } else if (k == 5) {
            pg8::Gemm g{Hb, (const bf16*)(wl + WO_GU), M, 2 * DFF, DM}; pg8::StaticOrder S; S.init(M, 2 * DFF, G, bx);
            const float* sqp = ssq + (size_t)(2 * l + 1) * M * 8;
            int pmA, pmB; { pg8::Unit u0; S.next(0, u0); pmA = pmB = u0.pm; for (int i = 1; S.next(i, u0); ++i) if (u0.pm != pmA) { pmB = u0.pm; break; } }
            { int t = threadIdx.x; OPQ_V(t); ((LAS float*)(ldsp + PSTAT_OFF))[t] = pg8::row_rstd(sqp, (t < 256 ? pmA : pmB) * 256 + (t & 255)); }
            __syncthreads();
            const pg8::RsTab T{(const LAS float*)(ldsp + PSTAT_OFF), pmA, pmB, sqp};
            pg8::EpiSwiGLU E{Z, DFF, T};
            pg8::gemm_phase<pg8::EpiSwiGLU, pg8::StaticOrder, PG8_ALIGN, PG8_SP2>(ldsp, g, S, E);
        } else {
            PHASE_IDS();
            const float* gp = (const float*)args.in[19]; const float* sq = ssq + (size_t)(2 * DEPTH) * M * 8;
            v4u xa[4], xb4[4]; float sa, sb;
#define FLD(X, S_, m_) do { S_ = pg8::row_ssq(sq, (m_)); _Pragma("unroll") for (int j = 0; j < 4; ++j) X[j] = *(const v4u*)(Hb + (size_t)(m_) * DM + 8 * lane + 512 * j); } while (0)
#define FST(X, S_, m_) do { const float rstd = 1.0f / sqrtf(S_ * (1.0f / DM) + RMS_EPS); float* orow = xo + (size_t)(m_) * DM;                                                         \
        _Pragma("unroll") for (int j = 0; j < 4; ++j) { const int c = 8 * lane + 512 * j; float x[8]; unpack8(X[j], x);                                                                \
            *(f32x4*)(orow + c) = (f32x4){x[0] * rstd * gfin[j][0][0], x[1] * rstd * gfin[j][0][1], x[2] * rstd * gfin[j][0][2], x[3] * rstd * gfin[j][0][3]};                            \
            *(f32x4*)(orow + c + 4) = (f32x4){x[4] * rstd * gfin[j][1][0], x[5] * rstd * gfin[j][1][1], x[6] * rstd * gfin[j][1][2], x[7] * rstd * gfin[j][1][3]}; } } while (0)
            f32x4 gfin[4][2];
#pragma unroll
            for (int j = 0; j < 4; ++j) { gfin[j][0] = *(const f32x4*)(gp + 8 * lane + 512 * j); gfin[j][1] = *(const f32x4*)(gp + 8 * lane + 512 * j + 4); }
            FLD(xa, sa, gw);
            for (int m = gw; m < M; m += 2 * NGW) {
                FLD(xb4, sb, m + NGW); FST(xa, sa, m);
                if (m + 2 * NGW < M) FLD(xa, sa, m + 2 * NGW);
                FST(xb4, sb, m + NGW); }
#undef FLD
#undef FST
        }
        if (p + 1 < args.ph_hi) { XcdBarrier bar; bar.bar = (unsigned*)(args.ws + WS_CTL) + CW_BAR; bar.x = xb_xcc_id(); bar.st = (volatile LAS unsigned*)((LAS unsigned char*)lds + MISC_OFF); xcd_barrier(bar); }
    }
}

extern "C" void kernel_launch(void* const* d_in, const int* in_sizes, int n_in, void* d_out, int out_size, void* d_ws, size_t ws_size, hipStream_t stream) {
    static int grid = 0;
    if (grid == 0) {
        if (n_in != 20 || in_sizes[0] != M * DM || out_size != M * DM || ws_size < WS_END) { fprintf(stderr, "kernel_launch: shape/workspace mismatch (n_in %d, in0 %d, out %d, ws %zu)\n", n_in, n_in > 0 ? in_sizes[0] : -1, out_size, ws_size); grid = -1; return; }
        int dev = 0, cus = 0, per_cu = 0;
        if (hipGetDevice(&dev) != hipSuccess || hipDeviceGetAttribute(&cus, hipDeviceAttributeMultiprocessorCount, dev) != hipSuccess) { grid = -1; return; }
        if (hipFuncSetAttribute((const void*)hymba_fwd, hipFuncAttributeMaxDynamicSharedMemorySize, LDS_BYTES) != hipSuccess) { fprintf(stderr, "kernel_launch: hipFuncSetAttribute failed\n"); grid = -1; return; }
        if (hipOccupancyMaxActiveBlocksPerMultiprocessor(&per_cu, (const void*)hymba_fwd, NWAVES * 64, LDS_BYTES) != hipSuccess || per_cu < 1) { fprintf(stderr, "kernel_launch: occupancy query says %d\n", per_cu); per_cu = 1; }
        (void)hipGetLastError();
        grid = cus * 1;
        if (grid != 256) { fprintf(stderr, "kernel_launch: built for 256 CUs (the row-scale tables assume two row panels per workgroup), device has %d; nothing launched\n", cus); grid = -1; return; }
    }
    if (grid < 0) return;
    if (hipMemsetAsync((char*)d_ws + WS_CTL, 0, CTL_ZERO_BYTES, stream) != hipSuccess) { fprintf(stderr, "kernel_launch: memset of control words failed\n"); return; }
    Args a{};
    for (int i = 0; i < 20; ++i) a.in[i] = d_in[i];
    a.out = (float*)d_out; a.ws = (unsigned char*)d_ws;
#if MK_PER_PHASE
    for (int p = 0; p < N_PHASES; ++p) { a.ph_lo = p; a.ph_hi = p + 1;
        const int kk = (p - 1) % LPH, k = (p == 0 || p == N_PHASES - 1) ? -1 : (kk == 0 ? 0 : kk == 1 ? 2 : kk + 2);
        const int nrep = (p == 0) ? REP_P0 : (k == 0 || k == 5) ? REP_GEMM : (k == 2) ? REP_ATT : (k == 1) ? REP_MIX : (k == 3) ? REP_THIN : 1;
        for (int rep = 0; rep < nrep; ++rep) hipLaunchKernelGGL(hymba_fwd, dim3(grid), dim3(NWAVES * 64), LDS_BYTES, stream, a); }
#else
    a.ph_lo = 0; a.ph_hi = N_PHASES;
    void* kargs[] = {&a};
    hipError_t e = hipLaunchCooperativeKernel((const void*)hymba_fwd, dim3(grid), dim3(NWAVES * 64), kargs, LDS_BYTES, stream);
    if (e != hipSuccess) fprintf(stderr, "cooperative launch failed: %s (grid %d)\n", hipGetErrorString(e), grid);
#endif
}
```

```cpp
#include <hip/hip_runtime.h>
#include <hip/hip_cooperative_groups.h>
#include <hip/hip_bf16.h>
#include <cstdio>
#include <cstdint>
#include <cmath>
namespace cg = cooperative_groups;
template <int X> __device__ __forceinline__ float swz(float v) { return __int_as_float(__builtin_amdgcn_ds_swizzle(__float_as_int(v), 0x1f | (X << 10))); }
__device__ __forceinline__ float sum32(float v) { auto rr = __builtin_amdgcn_permlane32_swap(__float_as_uint(v), __float_as_uint(v), false, false); return __uint_as_float(rr[0]) + __uint_as_float(rr[1]); }
namespace pg8 {
#define PG8_LAS __attribute__((address_space(3)))
typedef unsigned short bf16_t;
typedef short bf16x8 __attribute__((ext_vector_type(8)));
typedef float f32x4 __attribute__((ext_vector_type(4)));
typedef unsigned u32x4 __attribute__((ext_vector_type(4)));
constexpr int BM = 256, BK = 64, HALF = 128, HTB = HALF * BK * 2  , STAGE_BYTES = 8 * HTB, NXCD = 8, WGM = 8;

__host__ __device__ __forceinline__ int lds_byte(int r, int c) { const int st = (r >> 4) * 2 + (c >> 5), rr = r & 15, cc = c & 31, ob = rr * 64 + cc * 2; return st * 1024 + (ob ^ (((ob >> 9) & 1) << 5)); }
__host__ __device__ __forceinline__ void stage_rc(int b, int& R, int& C) { const int st = b / 1024, sb = b % 1024, swz = sb ^ (((sb >> 9) & 1) << 5); R = (st >> 1) * 16 + swz / 64; C = (st & 1) * 32 + (swz % 64) / 2; }
__host__ __device__ __forceinline__ int perm32(int rho) { const int n = rho >> 4, i = rho & 15; return 8 * (i >> 2) + 4 * n + (i & 3); }

struct Unit { int pm, pn; };
struct Gemm { const bf16_t* A; const bf16_t* Bt; int M, N, K; };

struct StaticOrder {
    int nM, nN, nwg, G, c;
    __host__ __device__ void init(int M, int N, int G_, int c_) { nM = M / BM; nN = N / BM; nwg = nM * nN; G = G_; c = c_; }
    __host__ __device__ bool next(int i, Unit& u) const {
        const long L = (long)i * G + c; if (L >= nwg) return false;
        int wgid = (int)L; { const int q = nwg / NXCD, r = nwg % NXCD, xcd = wgid % NXCD, off = wgid / NXCD; wgid = (xcd < r ? xcd * (q + 1) : r * (q + 1) + (xcd - r) * q) + off; }
        const int nig = WGM * nN, gid = wgid / nig, fm = gid * WGM, gsz = (nM - fm) < WGM ? (nM - fm) : WGM;
        u.pm = fm + ((wgid % nig) % gsz); u.pn = (wgid % nig) / gsz; return true;
    }
    __device__ __forceinline__ void a_ready(const Unit&) const {}
    __device__ __forceinline__ void done(const Unit&) const {}
};

__device__ __forceinline__ unsigned cvt_pk_bf16(float lo, float hi) { unsigned r; asm volatile("v_cvt_pk_bf16_f32 %0, %1, %2" : "=v"(r) : "v"(lo), "v"(hi)); return r; }
typedef float f32x2 __attribute__((ext_vector_type(2)));
__device__ __forceinline__ float row_ssq(const float* ssqp, int row) { const f32x4 a = *(const f32x4*)(ssqp + (size_t)row * 8), b = *(const f32x4*)(ssqp + (size_t)row * 8 + 4); return ((a[0] + a[1]) + (a[2] + a[3])) + ((b[0] + b[1]) + (b[2] + b[3])); }
__device__ __forceinline__ float row_rstd(const float* ssqp, int row) { return 1.0f / sqrtf(row_ssq(ssqp, row) * (1.0f / 2048.0f) + 1e-6f); }
struct RsTab { const PG8_LAS float* rs; int pmA, pmB; const float* ssq;
    __device__ __forceinline__ float get(int pm, int r) const { return rs[(pm == pmA ? 0 : 256) + r]; } };
struct EpiZ {
    static constexpr bool PERM = true, AFTER_DRAIN = false, HAS_INIT = false;
    bf16_t* O; int ldc; const float* ssq;
    __device__ __forceinline__ void operator()(const f32x4 (&acc)[2][2][4][2], const Unit& u, int wr, int wc, int fr, int fq) const {
        const int row0 = u.pm * BM + wr * 64 + fr, col0 = u.pn * BM + wc * 32 + 8 * fq;
#pragma unroll
        for (int ai = 0; ai < 2; ++ai)
#pragma unroll
            for (int m = 0; m < 4; ++m) { const int row = row0 + ai * HALF + m * 16; const float rs = row_rstd(ssq, row); bf16_t* rowp = O + (size_t)row * ldc + col0;
#pragma unroll
                for (int bj = 0; bj < 2; ++bj) { const f32x4 v0 = acc[ai][bj][m][0] * rs, v1 = acc[ai][bj][m][1] * rs;
                    u32x4 w; w.x = cvt_pk_bf16(v0[0], v0[1]); w.y = cvt_pk_bf16(v0[2], v0[3]); w.z = cvt_pk_bf16(v1[0], v1[1]); w.w = cvt_pk_bf16(v1[2], v1[3]);
                    *(u32x4*)(rowp + bj * HALF) = w; } }
    }
};
struct EpiIn {
    static constexpr bool PERM = true, AFTER_DRAIN = false, HAS_INIT = false;
    bf16_t* Z; int ldc; RsTab T; bf16_t* QK; bf16_t* V; const float* ctab; const float* stab;
    __device__ __forceinline__ void operator()(const f32x4 (&acc)[2][2][4][2], const Unit& u, int wr, int wc, int fr, int fq) const {
        const int row0 = u.pm * BM + wr * 64 + fr, pn = u.pn;
        if (pn < 4 || pn >= 16) {
            const int col0 = pn * BM + wc * 32 + 8 * fq;
#pragma unroll
            for (int ai = 0; ai < 2; ++ai)
#pragma unroll
                for (int m = 0; m < 4; ++m) { const int row = row0 + ai * HALF + m * 16; const float rs = T.get(u.pm, wr * 64 + fr + ai * HALF + m * 16); bf16_t* rowp = Z + (size_t)row * ldc + col0;
#pragma unroll
                    for (int bj = 0; bj < 2; ++bj) { const f32x4 v0 = acc[ai][bj][m][0] * rs, v1 = acc[ai][bj][m][1] * rs;
                        u32x4 w; w.x = cvt_pk_bf16(v0[0], v0[1]); w.y = cvt_pk_bf16(v0[2], v0[3]); w.z = cvt_pk_bf16(v1[0], v1[1]); w.w = cvt_pk_bf16(v1[2], v1[3]);
                        *(u32x4*)(rowp + bj * HALF) = w; } }
        } else if (pn < 12) {
            const int hd = (pn - 4) * 2 + (wc >> 1), j0 = 32 * (wc & 1) + 8 * fq;
#pragma unroll
            for (int ai = 0; ai < 2; ++ai) {
                f32x4 tc[4][4];
#pragma unroll
                for (int m = 0; m < 4; ++m) { const size_t tb = (size_t)(row0 + ai * HALF + m * 16) * 64 + j0;
                    tc[m][0] = *(const f32x4*)(ctab + tb); tc[m][1] = *(const f32x4*)(ctab + tb + 4); tc[m][2] = *(const f32x4*)(stab + tb); tc[m][3] = *(const f32x4*)(stab + tb + 4); }
#pragma unroll
                for (int m = 0; m < 4; ++m) { const int row = row0 + ai * HALF + m * 16; const float rs = T.get(u.pm, wr * 64 + fr + ai * HALF + m * 16);
                    const f32x4 c0 = tc[m][0], c1 = tc[m][1], s0 = tc[m][2], s1 = tc[m][3];
                    const f32x4 a0 = acc[ai][0][m][0] * rs, a1 = acc[ai][0][m][1] * rs, b0 = acc[ai][1][m][0] * rs, b1 = acc[ai][1][m][1] * rs;
                    const f32x4 p0 = a0 * c0 - b0 * s0, p1 = a1 * c1 - b1 * s1, q0 = b0 * c0 + a0 * s0, q1 = b1 * c1 + a1 * s1;
                    bf16_t* dp = QK + (((size_t)(row >> 12) * 16 + hd) * 4096 + (row & 4095)) * 128 + j0;
                    u32x4 w; w.x = cvt_pk_bf16(p0[0], p0[1]); w.y = cvt_pk_bf16(p0[2], p0[3]); w.z = cvt_pk_bf16(p1[0], p1[1]); w.w = cvt_pk_bf16(p1[2], p1[3]); *(u32x4*)dp = w;
                    w.x = cvt_pk_bf16(q0[0], q0[1]); w.y = cvt_pk_bf16(q0[2], q0[3]); w.z = cvt_pk_bf16(q1[0], q1[1]); w.w = cvt_pk_bf16(q1[2], q1[3]); *(u32x4*)(dp + 64) = w; }
            }
        } else {
#pragma unroll
            for (int ai = 0; ai < 2; ++ai)
#pragma unroll
                for (int m = 0; m < 4; ++m) { const int row = row0 + ai * HALF + m * 16; const float rs = T.get(u.pm, wr * 64 + fr + ai * HALF + m * 16);
#pragma unroll
                    for (int bj = 0; bj < 2; ++bj) { const f32x4 v0 = acc[ai][bj][m][0] * rs, v1 = acc[ai][bj][m][1] * rs;
                        bf16_t* dp = V + (((size_t)(row >> 12) * 8 + (pn - 12) * 2 + bj) * 4096 + (row & 4095)) * 128 + wc * 32 + 8 * fq;
                        u32x4 w; w.x = cvt_pk_bf16(v0[0], v0[1]); w.y = cvt_pk_bf16(v0[2], v0[3]); w.z = cvt_pk_bf16(v1[0], v1[1]); w.w = cvt_pk_bf16(v1[2], v1[3]);
                        *(u32x4*)dp = w; } }
        }
    }
};
__device__ __forceinline__ float swiglu1(float g, float u) { return g * u * __builtin_amdgcn_rcpf(1.0f + __builtin_amdgcn_exp2f(-1.4426950408889634f * g)); }
struct EpiSwiGLU {
    static constexpr bool PERM = true, AFTER_DRAIN = false, HAS_INIT = false;
    bf16_t* O; int ldc; RsTab T;
    __device__ __forceinline__ void operator()(const f32x4 (&acc)[2][2][4][2], const Unit& u, int wr, int wc, int fr, int fq) const {
        const int row0 = u.pm * BM + wr * 64 + fr, col0 = u.pn * HALF + wc * 32 + 8 * fq;
#pragma unroll
        for (int ai = 0; ai < 2; ++ai)
#pragma unroll
            for (int m = 0; m < 4; ++m) { const int row = row0 + ai * HALF + m * 16; const float rs = T.get(u.pm, wr * 64 + fr + ai * HALF + m * 16); bf16_t* rowp = O + (size_t)row * ldc + col0;
                const f32x4 g0 = acc[ai][0][m][0] * rs, g1 = acc[ai][0][m][1] * rs, u0 = acc[ai][1][m][0] * rs, u1 = acc[ai][1][m][1] * rs;
                u32x4 w; w.x = cvt_pk_bf16(swiglu1(g0[0], u0[0]), swiglu1(g0[1], u0[1])); w.y = cvt_pk_bf16(swiglu1(g0[2], u0[2]), swiglu1(g0[3], u0[3]));
                w.z = cvt_pk_bf16(swiglu1(g1[0], u1[0]), swiglu1(g1[1], u1[1])); w.w = cvt_pk_bf16(swiglu1(g1[2], u1[2]), swiglu1(g1[3], u1[3]));
                *(u32x4*)rowp = w; }
    }
};
struct EpiRes {
    static constexpr bool PERM = true, AFTER_DRAIN = false, HAS_INIT = true;
    bf16_t* X; int ldc; float* ssqp; PG8_LAS float* P;
    __device__ __forceinline__ void init(f32x4 (&acc)[2][2][4][2], const Unit& u, int wr, int wc, int fr, int fq) const {
        const int row0 = u.pm * BM + wr * 64 + fr, col0 = u.pn * BM + wc * 32 + 8 * fq;
#pragma unroll
        for (int ai = 0; ai < 2; ++ai)
#pragma unroll
            for (int m = 0; m < 4; ++m) { const bf16_t* rp = X + (size_t)(row0 + ai * HALF + m * 16) * ldc + col0;
#pragma unroll
                for (int bj = 0; bj < 2; ++bj) { const u32x4 b = *(const u32x4*)(rp + bj * HALF);
                    acc[ai][bj][m][0] = (f32x4){__uint_as_float(b.x << 16), __uint_as_float(b.x & 0xffff0000u), __uint_as_float(b.y << 16), __uint_as_float(b.y & 0xffff0000u)};
                    acc[ai][bj][m][1] = (f32x4){__uint_as_float(b.z << 16), __uint_as_float(b.z & 0xffff0000u), __uint_as_float(b.w << 16), __uint_as_float(b.w & 0xffff0000u)}; } }
    }
    template <int AI0, int AI1> __device__ __forceinline__ void load_tile(u32x4 (&nx)[2][4][2], const Unit& u, int wr, int wc, int fr, int fq) const {
        const int row0 = u.pm * BM + wr * 64 + fr, col0 = u.pn * BM + wc * 32 + 8 * fq;
#pragma unroll
        for (int ai = AI0; ai < AI1; ++ai)
#pragma unroll
            for (int m = 0; m < 4; ++m) { const bf16_t* rp = X + (size_t)(row0 + ai * HALF + m * 16) * ldc + col0;
#pragma unroll
                for (int bj = 0; bj < 2; ++bj) nx[ai][m][bj] = *(const u32x4*)(rp + bj * HALF); }
    }
    __device__ __forceinline__ void unpack(f32x4 (&acc)[2][2][4][2], const u32x4 (&nx)[2][4][2]) const {
#pragma unroll
        for (int ai = 0; ai < 2; ++ai)
#pragma unroll
            for (int m = 0; m < 4; ++m)
#pragma unroll
                for (int bj = 0; bj < 2; ++bj) { const u32x4 b = nx[ai][m][bj];
                    acc[ai][bj][m][0] = (f32x4){__uint_as_float(b.x << 16), __uint_as_float(b.x & 0xffff0000u), __uint_as_float(b.y << 16), __uint_as_float(b.y & 0xffff0000u)};
                    acc[ai][bj][m][1] = (f32x4){__uint_as_float(b.z << 16), __uint_as_float(b.z & 0xffff0000u), __uint_as_float(b.w << 16), __uint_as_float(b.w & 0xffff0000u)}; }
    }
    __device__ __forceinline__ void fused(f32x4 (&acc)[2][2][4][2], const Unit& u, const Unit& un, bool has_next, int wr, int wc, int fr, int fq) const {
        const int row0 = u.pm * BM + wr * 64 + fr, col0 = u.pn * BM + wc * 32 + 8 * fq;
        u32x4 w[2][4][2];
#pragma unroll
        for (int ai = 0; ai < 2; ++ai)
#pragma unroll
            for (int m = 0; m < 4; ++m) { float part = 0.f;
#pragma unroll
                for (int bj = 0; bj < 2; ++bj) { const f32x4 a0 = acc[ai][bj][m][0], a1 = acc[ai][bj][m][1];
                    part += (a0[0] * a0[0] + a0[1] * a0[1]) + (a0[2] * a0[2] + a0[3] * a0[3]) + (a1[0] * a1[0] + a1[1] * a1[1]) + (a1[2] * a1[2] + a1[3] * a1[3]);
                    w[ai][m][bj].x = cvt_pk_bf16(a0[0], a0[1]); w[ai][m][bj].y = cvt_pk_bf16(a0[2], a0[3]); w[ai][m][bj].z = cvt_pk_bf16(a1[0], a1[1]); w[ai][m][bj].w = cvt_pk_bf16(a1[2], a1[3]); }
                part += swz<16>(part); part = sum32(part);
                if (fq == 0) P[(wr * 64 + ai * HALF + m * 16 + fr) * 4 + wc] = part; }
        asm volatile("" ::: "memory");
        u32x4 nx[2][4][2];
        if (has_next) load_tile<0, 2>(nx, un, wr, wc, fr, fq);
        asm volatile("" ::: "memory");
#pragma unroll
        for (int ai = 0; ai < 2; ++ai)
#pragma unroll
            for (int m = 0; m < 4; ++m) { bf16_t* rowp = X + (size_t)(row0 + ai * HALF + m * 16) * ldc + col0;
#pragma unroll
                for (int bj = 0; bj < 2; ++bj) *(u32x4*)(rowp + bj * HALF) = w[ai][m][bj]; }
        asm volatile("s_waitcnt lgkmcnt(0)" ::: "memory"); __builtin_amdgcn_s_barrier(); asm volatile("" ::: "memory");
        const int t = (wr * 4 + wc) * 64 + fq * 16 + fr;
        if (t < BM) { const f32x4 p = *(const PG8_LAS f32x4*)(P + t * 4); ssqp[((size_t)u.pm * BM + t) * 8 + u.pn] = (p[0] + p[1]) + (p[2] + p[3]); }
        if (has_next) unpack(acc, nx);
    }
    __device__ __forceinline__ void operator()(const f32x4 (&acc)[2][2][4][2], const Unit& u, int wr, int wc, int fr, int fq) const {
        const int row0 = u.pm * BM + wr * 64 + fr, col0 = u.pn * BM + wc * 32 + 8 * fq;
#pragma unroll
        for (int ai = 0; ai < 2; ++ai)
#pragma unroll
            for (int m = 0; m < 4; ++m) { const int row = row0 + ai * HALF + m * 16; bf16_t* rowp = X + (size_t)row * ldc + col0; float part = 0.f;
#pragma unroll
                for (int bj = 0; bj < 2; ++bj) { const f32x4 a0 = acc[ai][bj][m][0], a1 = acc[ai][bj][m][1];
                    part += (a0[0] * a0[0] + a0[1] * a0[1]) + (a0[2] * a0[2] + a0[3] * a0[3]) + (a1[0] * a1[0] + a1[1] * a1[1]) + (a1[2] * a1[2] + a1[3] * a1[3]);
                    u32x4 w; w.x = cvt_pk_bf16(a0[0], a0[1]); w.y = cvt_pk_bf16(a0[2], a0[3]); w.z = cvt_pk_bf16(a1[0], a1[1]); w.w = cvt_pk_bf16(a1[2], a1[3]);
                    *(u32x4*)(rowp + bj * HALF) = w; }
                part += swz<16>(part); part = sum32(part);
                if (fq == 0) P[(wr * 64 + ai * HALF + m * 16 + fr) * 4 + wc] = part; }
        asm volatile("s_waitcnt lgkmcnt(0)" ::: "memory"); __builtin_amdgcn_s_barrier(); asm volatile("" ::: "memory");
        const int t = (wr * 4 + wc) * 64 + fq * 16 + fr;
        if (t < BM) { const f32x4 p = *(const PG8_LAS f32x4*)(P + t * 4); ssqp[((size_t)u.pm * BM + t) * 8 + u.pn] = (p[0] + p[1]) + (p[2] + p[3]); }
    }
};
template <class Epi, class Sched, bool ALIGN_EPI = false, bool SP2 = false>
__device__ __forceinline__ void gemm_phase(PG8_LAS unsigned char* lds, const Gemm g, const Sched& S, const Epi& E) {
    int tid_o = threadIdx.x; asm volatile("" : "+v"(tid_o));
    const int tid = tid_o, wid = __builtin_amdgcn_readfirstlane(tid >> 6), lane = tid & 63, wr = wid >> 2, wc = wid & 3, fr = lane & 15, fq = lane >> 4;
    const int K = g.K, nt = K / BK;
    unsigned voffA[2], voffB[2];
#pragma unroll
    for (int i = 0; i < 2; ++i) { int R, C; stage_rc(tid * 16 + i * 8192, R, C); const int Rb = Epi::PERM ? ((R & ~31) + perm32(R & 31)) : R;
        voffA[i] = (unsigned)(R * K + C) * 2u; voffB[i] = (unsigned)(Rb * K + C) * 2u; }
    const size_t kstep = (size_t)(BK * 2);
    const size_t hstep = (size_t)HALF * K * 2;
    const size_t tstep = 2 * hstep;
    const unsigned ldsw = (unsigned)wid * 1024u;
    const int aoff = lds_byte(wr * 64 + fr, fq * 8), boff = lds_byte(wc * 32 + fr, fq * 8);
#define PG8_SA(b, h) (((b) * 2 + (h)) * HTB)
#define PG8_SB(b, h) ((4 + (b) * 2 + (h)) * HTB)
#define PG8_STAGE(bufoff, gbase, voff) do { _Pragma("unroll") for (int _i = 0; _i < 2; ++_i) \
        __builtin_amdgcn_global_load_lds((const unsigned*)((const char*)(gbase) + (voff)[_i]), (PG8_LAS unsigned*)(lds + (bufoff) + ldsw + _i * 8192), 16, 0, 0); } while (0)
#define PG8_LDA(dst, b, h) do { _Pragma("unroll") for (int m = 0; m < 4; ++m) _Pragma("unroll") for (int k = 0; k < 2; ++k) dst[m][k] = *(const PG8_LAS bf16x8*)(lds + PG8_SA(b, h) + aoff + m * 2048 + k * 1024); } while (0)
#define PG8_LDB(dst, b, h) do { _Pragma("unroll") for (int n = 0; n < 2; ++n) _Pragma("unroll") for (int k = 0; k < 2; ++k) dst[n][k] = *(const PG8_LAS bf16x8*)(lds + PG8_SB(b, h) + boff + n * 2048 + k * 1024); } while (0)
#define PG8_MMA(ai, bj, At, Bt) do { __builtin_amdgcn_s_setprio(1); _Pragma("unroll") for (int m = 0; m < 4; ++m) _Pragma("unroll") for (int n = 0; n < 2; ++n) _Pragma("unroll") for (int k = 0; k < 2; ++k) \
        acc[ai][bj][m][n] = __builtin_amdgcn_mfma_f32_16x16x32_bf16(Bt[n][k], At[m][k], acc[ai][bj][m][n], 0, 0, 0); __builtin_amdgcn_s_setprio(0); } while (0)
#define PG8_WAIT_V(n) asm volatile("s_waitcnt vmcnt(" #n ")" ::: "memory")
#define PG8_WAIT_L(n) asm volatile("s_waitcnt lgkmcnt(" #n ")" ::: "memory")
#define PG8_BAR __builtin_amdgcn_s_barrier()
#define PG8_SCHED __builtin_amdgcn_sched_barrier(0)
    Unit cur, nxt; int ui = 0;
    if (!S.next(0, cur)) return;
    f32x4 acc[2][2][4][2];
    if constexpr (Epi::HAS_INIT) E.init(acc, cur, wr, wc, fr, fq);
    else {
#pragma unroll
    for (int a = 0; a < 2; ++a)
#pragma unroll
        for (int b = 0; b < 2; ++b)
#pragma unroll
            for (int m = 0; m < 4; ++m)
#pragma unroll
                for (int n = 0; n < 2; ++n) acc[a][b][m][n] = (f32x4){0.f, 0.f, 0.f, 0.f};
    }
    bf16x8 At[4][2], B0[2][2], B1[2][2];
    const char* cA = (const char*)g.A + (size_t)cur.pm * tstep; const char* cB = (const char*)g.Bt + (size_t)cur.pn * tstep;
    S.a_ready(cur);
    if constexpr (SP2) {
        PG8_STAGE(PG8_SB(0, 0), cB, voffB); PG8_STAGE(PG8_SB(0, 1), cB + hstep, voffB); PG8_STAGE(PG8_SA(0, 0), cA, voffA); PG8_STAGE(PG8_SA(0, 1), cA + hstep, voffA);
        if (wr == 1) PG8_BAR;
        PG8_WAIT_V(2); PG8_BAR;
        PG8_STAGE(PG8_SB(1, 0), cB + kstep, voffB); PG8_STAGE(PG8_SA(1, 0), cA + kstep, voffA); PG8_STAGE(PG8_SB(1, 1), cB + hstep + kstep, voffB);
        PG8_WAIT_V(6); PG8_BAR;
    } else {
        PG8_STAGE(PG8_SB(0, 0), cB, voffB); PG8_STAGE(PG8_SA(0, 0), cA, voffA); PG8_STAGE(PG8_SB(0, 1), cB + hstep, voffB); PG8_STAGE(PG8_SA(0, 1), cA + hstep, voffA);
        if (wr == 1) PG8_BAR;
        PG8_WAIT_V(4); PG8_BAR;
        PG8_STAGE(PG8_SB(1, 0), cB + kstep, voffB); PG8_STAGE(PG8_SA(1, 0), cA + kstep, voffA); PG8_STAGE(PG8_SB(1, 1), cB + hstep + kstep, voffB);
        PG8_WAIT_V(6); PG8_BAR;
    }
    for (;;) {
        const bool has_next = S.next(ui + 1, nxt);
        const char* nA = has_next ? (const char*)g.A + (size_t)nxt.pm * tstep : cA; const char* nB = has_next ? (const char*)g.Bt + (size_t)nxt.pn * tstep : cB;
        for (int t = 0; t < nt; t += 2) {
            const bool last = (t == nt - 2);
            const char* a1 = cA + (size_t)(t + 1) * kstep;
            const char* a2 = last ? nA : cA + (size_t)(t + 2) * kstep; const char* b2 = last ? nB : cB + (size_t)(t + 2) * kstep;
            const char* a3 = a2 + kstep; const char* b3 = b2 + kstep;
            if (last && has_next) S.a_ready(nxt);
            if constexpr (SP2) {
            PG8_LDB(B0, 0, 0); PG8_LDB(B1, 0, 1); PG8_SCHED; PG8_LDA(At, 0, 0); PG8_STAGE(PG8_SA(1, 1), a1 + hstep, voffA);
            PG8_WAIT_V(8); PG8_WAIT_L(0); PG8_BAR; PG8_MMA(0, 0, At, B0); PG8_MMA(0, 1, At, B1); PG8_BAR; PG8_SCHED;
            PG8_LDA(At, 0, 1); PG8_STAGE(PG8_SB(0, 0), b2, voffB); PG8_STAGE(PG8_SB(0, 1), b2 + hstep, voffB); PG8_STAGE(PG8_SA(0, 0), a2, voffA);
            PG8_WAIT_V(8); PG8_WAIT_L(0); PG8_BAR; PG8_MMA(1, 0, At, B0); PG8_MMA(1, 1, At, B1); PG8_BAR; PG8_SCHED;
            PG8_LDB(B0, 1, 0); PG8_LDB(B1, 1, 1); PG8_SCHED; PG8_LDA(At, 1, 0); PG8_STAGE(PG8_SA(0, 1), a2 + hstep, voffA);
            PG8_WAIT_V(8); PG8_WAIT_L(0); PG8_BAR; PG8_MMA(0, 0, At, B0); PG8_MMA(0, 1, At, B1); PG8_BAR; PG8_SCHED;
            PG8_LDA(At, 1, 1); PG8_STAGE(PG8_SB(1, 0), b3, voffB); PG8_STAGE(PG8_SB(1, 1), b3 + hstep, voffB); PG8_STAGE(PG8_SA(1, 0), a3, voffA);
            PG8_WAIT_V(8); PG8_WAIT_L(0); PG8_BAR; PG8_MMA(1, 0, At, B0); PG8_MMA(1, 1, At, B1); PG8_BAR; PG8_SCHED;
            } else {
            PG8_LDB(B0, 0, 0); PG8_SCHED; PG8_LDA(At, 0, 0); PG8_STAGE(PG8_SA(1, 1), a1 + hstep, voffA);
            PG8_WAIT_L(8); PG8_BAR; PG8_WAIT_L(0); PG8_MMA(0, 0, At, B0); PG8_BAR; PG8_SCHED;
            PG8_LDB(B1, 0, 1); PG8_STAGE(PG8_SB(0, 0), b2, voffB);
            PG8_BAR; PG8_WAIT_L(0); PG8_MMA(0, 1, At, B1); PG8_BAR;
            PG8_LDA(At, 0, 1); PG8_STAGE(PG8_SA(0, 0), a2, voffA);
            PG8_BAR; PG8_WAIT_L(0); PG8_MMA(1, 0, At, B0); PG8_BAR; PG8_SCHED;
            PG8_STAGE(PG8_SB(0, 1), b2 + hstep, voffB);
            PG8_WAIT_V(6); PG8_BAR; PG8_MMA(1, 1, At, B1); PG8_BAR;
            PG8_LDB(B0, 1, 0); PG8_SCHED; PG8_LDA(At, 1, 0); PG8_STAGE(PG8_SA(0, 1), a2 + hstep, voffA);
            PG8_WAIT_L(8); PG8_BAR; PG8_WAIT_L(0); PG8_MMA(0, 0, At, B0); PG8_BAR; PG8_SCHED;
            PG8_LDB(B1, 1, 1); PG8_STAGE(PG8_SB(1, 0), b3, voffB);
            PG8_BAR; PG8_WAIT_L(0); PG8_MMA(0, 1, At, B1); PG8_BAR;
            PG8_LDA(At, 1, 1); PG8_STAGE(PG8_SA(1, 0), a3, voffA);
            PG8_BAR; PG8_WAIT_L(0); PG8_MMA(1, 0, At, B0); PG8_BAR; PG8_SCHED;
            PG8_STAGE(PG8_SB(1, 1), b3 + hstep, voffB);
            PG8_WAIT_V(6); PG8_BAR; PG8_MMA(1, 1, At, B1); PG8_BAR;
            }
        }
        if constexpr (ALIGN_EPI) { if (wr == 0) PG8_BAR; }
        int fr_e = fr, fq_e = fq; asm volatile("" : "+v"(fr_e), "+v"(fq_e));
        if constexpr (Epi::HAS_INIT) { E.fused(acc, cur, nxt, has_next, wr, wc, fr_e, fq_e); S.done(cur); }
        else if constexpr (!Epi::AFTER_DRAIN) { E(acc, cur, wr, wc, fr_e, fq_e); S.done(cur); }
        if (!has_next) break;
        if constexpr (Epi::HAS_INIT) { }
        else {
#pragma unroll
        for (int a = 0; a < 2; ++a)
#pragma unroll
            for (int b = 0; b < 2; ++b)
#pragma unroll
                for (int m = 0; m < 4; ++m)
#pragma unroll
                    for (int n = 0; n < 2; ++n) acc[a][b][m][n] = (f32x4){0.f, 0.f, 0.f, 0.f};
        }
        cur = nxt; cA = nA; cB = nB; ++ui;
        if constexpr (ALIGN_EPI) { if (wr == 1) PG8_BAR; }
    }
    PG8_WAIT_V(0);
    if constexpr (!ALIGN_EPI) { if (wr == 0) PG8_BAR; }
    PG8_BAR;
    if constexpr (Epi::AFTER_DRAIN) { E.fused(acc, cur, wr, wc, fr, fq, lds, wid, lane); S.done(cur); }
#undef PG8_SA
#undef PG8_SB
#undef PG8_STAGE
#undef PG8_LDA
#undef PG8_LDB
#undef PG8_MMA
#undef PG8_WAIT_V
#undef PG8_WAIT_L
#undef PG8_BAR
#undef PG8_SCHED
}
}
#ifndef PG8_SP2
#define PG8_SP2 true
#endif
#ifndef PG8_ALIGN
#define PG8_ALIGN true
#endif
namespace att {
constexpr int D = 128;
constexpr int LDQ = 128, LDKV = 128, LDO = 128;
constexpr float THR = 8.f;
constexpr bool WSKIP = false;
constexpr float SCALE = 0.08838834764831845f;
constexpr int NW = 8, QBLK = 32, KVBLK = 64, QB = NW * QBLK;
constexpr int SHM_V = KVBLK * D * 2, SHM_K = KVBLK * D * 2;
constexpr int LDS_BYTES = 2 * SHM_V + 2 * SHM_K + NW * 64 * 4;
using bf16 = __hip_bfloat16;
typedef short bf16x8 __attribute__((ext_vector_type(8)));
typedef short s16x4 __attribute__((ext_vector_type(4)));
typedef float f32x16 __attribute__((ext_vector_type(16)));
typedef float f32x4 __attribute__((ext_vector_type(4)));
typedef unsigned u32x4 __attribute__((ext_vector_type(4)));
template <class A, class Bt> struct same_t { static constexpr bool v = false; };
template <class A> struct same_t<A, A> { static constexpr bool v = true; };

#define KSWZ(row, colB) ((row) * 256 + ((colB) ^ (((row) & 7) << 4)))
#define SBAR() __builtin_amdgcn_sched_barrier(0)
__device__ __forceinline__ int v_st(int k, int c) { const int kk = (k & ~0xC) | ((k & 4) << 1) | ((k & 8) >> 1); return ((kk >> 3) * 4 + (c >> 5)) * 512 + ((kk & 7) * 32 + (c & 31)) * 2; }
__device__ __forceinline__ int v_rd_base(int lane) { return ((lane & 3) << 3) | (((lane >> 2) & 3) << 6) | (((lane >> 4) & 1) << 5) | (((lane >> 5) & 1) << 8); }
constexpr int v_rd_off(int d0, int ks, int half) { return d0 * 512 + ks * 4096 + half * 2048; }
__device__ __forceinline__ int crow(int r, int hi) { return (r & 3) + 8 * (r >> 2) + 4 * hi; }
__device__ __forceinline__ unsigned cvtpk(float lo, float hi) {
    unsigned r; asm volatile("v_cvt_pk_bf16_f32 %0, %1, %2" : "=v"(r) : "v"(lo), "v"(hi)); return r;
}
__device__ __forceinline__ bf16x8 pack8(f32x4 a, f32x4 b) {
    u32x4 w = {cvtpk(a[0], a[1]), cvtpk(a[2], a[3]), cvtpk(b[0], b[1]), cvtpk(b[2], b[3])};
    return *reinterpret_cast<bf16x8*>(&w);
}
template <class T> __device__ __forceinline__ bf16x8 load8(const T* p) {
    if constexpr (same_t<T, float>::v) { return pack8(*(const f32x4*)p, *(const f32x4*)(p + 4)); }
    else { return *reinterpret_cast<const bf16x8*>(p); }
}
__device__ __forceinline__ void mask_tile(f32x16& p0, f32x16& p1, int dq, unsigned W) {
    const float NEG = -__builtin_inff();
#pragma unroll
    for (int r = 0; r < 16; ++r) {
        const int c = (r & 3) + 8 * (r >> 2);
        if ((unsigned)(dq - c) >= W) p0[r] = NEG;
        if ((unsigned)(dq - c - 32) >= W) p1[r] = NEG;
    }
}
__device__ __forceinline__ void partialSM(f32x16& p0, f32x16& p1, float& m_reg, float& mn, float& alpha) {
    float pmax = p0[0]; for (int r = 1; r < 16; ++r) pmax = fmaxf(pmax, p0[r]); for (int r = 0; r < 16; ++r) pmax = fmaxf(pmax, p1[r]);
    { auto rr = __builtin_amdgcn_permlane32_swap(__float_as_uint(pmax), __float_as_uint(pmax), false, false);
      pmax = fmaxf(__uint_as_float(rr[0]), __uint_as_float(rr[1])); }
    constexpr float C2 = 1.4426950408889634f * SCALE;
    if (__builtin_expect(__all((pmax - m_reg) * SCALE <= THR), 1)) { mn = m_reg; alpha = 1.f; }
    else { mn = fmaxf(m_reg, pmax); alpha = __builtin_amdgcn_exp2f((m_reg - mn) * C2); m_reg = mn; }
    const float mnL = -mn * C2;
    for (int r = 0; r < 16; ++r) p0[r] = fmaf(p0[r], C2, mnL); for (int r = 0; r < 16; ++r) p1[r] = fmaf(p1[r], C2, mnL);
    for (int r = 0; r < 16; ++r) p0[r] = __builtin_amdgcn_exp2f(p0[r]);
}
__device__ __forceinline__ void finishSM(f32x16& p0, f32x16& p1, float alpha, float& l_reg, bf16x8& pa0, bf16x8& pa1, bf16x8& pa2, bf16x8& pa3) {
    for (int r = 0; r < 16; ++r) p1[r] = __builtin_amdgcn_exp2f(p1[r]);
    float ps = 0; for (int r = 0; r < 16; ++r) ps += p0[r]; for (int r = 0; r < 16; ++r) ps += p1[r];
    { auto rr = __builtin_amdgcn_permlane32_swap(__float_as_uint(ps), __float_as_uint(ps), false, false);
      ps = __uint_as_float(rr[0]) + __uint_as_float(rr[1]); }
    l_reg = l_reg * alpha + ps;
#define PK4(P, B_, OUT) do { unsigned a0 = cvtpk(P[B_+0], P[B_+1]), a1 = cvtpk(P[B_+2], P[B_+3]);                          \
        unsigned b0 = cvtpk(P[B_+4], P[B_+5]), b1 = cvtpk(P[B_+6], P[B_+7]);                                             \
        auto r0 = __builtin_amdgcn_permlane32_swap(a0, b0, false, false); auto r1 = __builtin_amdgcn_permlane32_swap(a1, b1, false, false); \
        u32x4 w = {r0[0], r1[0], r0[1], r1[1]}; OUT = *reinterpret_cast<bf16x8*>(&w); } while (0)
    PK4(p0, 0, pa0); PK4(p0, 8, pa1); PK4(p1, 0, pa2); PK4(p1, 8, pa3);
#undef PK4
}
template <int KB, bool SK>
__device__ __forceinline__ void qkt(f32x16& p0, f32x16& p1, const char* K_lds, int r32, int hi, const bf16x8* qr, bool act) {
    if (SK && !act) { const float NEG = -__builtin_inff();
#pragma unroll
        for (int r = 0; r < 16; ++r) { p0[r] = NEG; p1[r] = NEG; } return; }
    p0 = f32x16{}; p1 = f32x16{};
    const char* kb[4];
#pragma unroll
    for (int dd = 0; dd < 4; ++dd) kb[dd] = K_lds + KB * SHM_K + KSWZ(r32, (dd * 16 + hi * 8) * 2);
#pragma unroll
    for (int d0 = 0; d0 < 8; ++d0) { const char* a = kb[d0 & 3] + (d0 >> 2) * 128;
        bf16x8 b0 = *reinterpret_cast<const bf16x8*>(a);
        bf16x8 b1 = *reinterpret_cast<const bf16x8*>(a + 32 * 256);
        p0 = __builtin_amdgcn_mfma_f32_32x32x16_bf16(b0, qr[d0], p0, 0, 0, 0);
        p1 = __builtin_amdgcn_mfma_f32_32x32x16_bf16(b1, qr[d0], p1, 0, 0, 0); }
}
template <int VB, bool SK>
__device__ __forceinline__ void pv_tile(f32x16* o, int vb0, bf16x8 pa0, bf16x8 pa1, bf16x8 pa2, bf16x8 pa3, bool act) {
    if (SK && !act) return;
#define TRRD(dst, off) asm volatile("ds_read_b64_tr_b16 %0, %1 offset:%2" : "=&v"(dst) : "v"(vb0), "i"(off) : "memory")
#define PV_D0(d0) do { s16x4 l0, l1, l2, l3, h0, h1, h2, h3; constexpr int b_ = VB * SHM_V + v_rd_off(d0, 0, 0);     \
        TRRD(l0, b_); TRRD(h0, b_ + 2048); TRRD(l1, b_ + 4096); TRRD(h1, b_ + 6144); TRRD(l2, b_ + 8192); TRRD(h2, b_ + 10240); TRRD(l3, b_ + 12288); TRRD(h3, b_ + 14336); \
        asm volatile("s_waitcnt lgkmcnt(0)" ::: "memory"); SBAR();                 \
        o[d0] = __builtin_amdgcn_mfma_f32_32x32x16_bf16(pa0, (bf16x8){l0[0], l0[1], l0[2], l0[3], h0[0], h0[1], h0[2], h0[3]}, o[d0], 0, 0, 0);   \
        o[d0] = __builtin_amdgcn_mfma_f32_32x32x16_bf16(pa1, (bf16x8){l1[0], l1[1], l1[2], l1[3], h1[0], h1[1], h1[2], h1[3]}, o[d0], 0, 0, 0);   \
        o[d0] = __builtin_amdgcn_mfma_f32_32x32x16_bf16(pa2, (bf16x8){l2[0], l2[1], l2[2], l2[3], h2[0], h2[1], h2[2], h2[3]}, o[d0], 0, 0, 0);   \
        o[d0] = __builtin_amdgcn_mfma_f32_32x32x16_bf16(pa3, (bf16x8){l3[0], l3[1], l3[2], l3[3], h3[0], h3[1], h3[2], h3[3]}, o[d0], 0, 0, 0); } while (0)
    PV_D0(0); PV_D0(1); PV_D0(2); PV_D0(3);
#undef PV_D0
#undef TRRD
}

template <class TIn, class TOut> struct BlockRef { const TIn* Q; const TIn* K; const TIn* V; TOut* O; int P0; };
template <class TIn> struct Seam {
    bf16x8 qr[8];
    bf16x8 st_v0, st_v1, st_k0, st_k1; f32x4 sf0, sf1, sf2, sf3;
    f32x4 tq[16];
};
__device__ __forceinline__ int swa_jlo(int P0, int W) { const int lowk = P0 - W + 1; return lowk > 0 ? lowk / KVBLK : 0; }
#define ROW(p, k0, rr) ((p) + (size_t)((k0) + (rr)) * LDKV + sc)
#define VMW() asm volatile("s_waitcnt vmcnt(0)" ::: "memory")
#define VMWN(n) asm volatile("s_waitcnt vmcnt(%0)" :: "i"(n) : "memory")
#define SLOAD_H(Kp, Vp, k0) do { S.st_v0 = load8<TIn>(ROW(Vp, k0, sr)); S.st_v1 = load8<TIn>(ROW(Vp, k0, 32 + sr));              \
                         S.st_k0 = load8<TIn>(ROW(Kp, k0, sr)); S.st_k1 = load8<TIn>(ROW(Kp, k0, 32 + sr)); } while (0)
#define SWRITE_HK(bf) do { *(bf16x8*)(K_lds + (bf) * SHM_K + kws) = S.st_k0; *(bf16x8*)(K_lds + (bf) * SHM_K + kws + 32 * 256) = S.st_k1; } while (0)
#define SWRITE_HV(bf) do { *(bf16x8*)(V_lds + (bf) * SHM_V + vst0) = S.st_v0; *(bf16x8*)(V_lds + (bf) * SHM_V + vst1) = S.st_v1; } while (0)
#define SWRITE_H(bf) do { SWRITE_HV(bf); SWRITE_HK(bf); } while (0)
#define SLOAD_F(p, k0) do { S.sf0 = *(const f32x4*)ROW(p, k0, sr); S.sf1 = *(const f32x4*)(ROW(p, k0, sr) + 4);                \
                            S.sf2 = *(const f32x4*)ROW(p, k0, 32 + sr); S.sf3 = *(const f32x4*)(ROW(p, k0, 32 + sr) + 4); } while (0)
#define SWRITE_KF(bf) do { *(bf16x8*)(K_lds + (bf) * SHM_K + kws) = pack8(S.sf0, S.sf1); *(bf16x8*)(K_lds + (bf) * SHM_K + kws + 32 * 256) = pack8(S.sf2, S.sf3); } while (0)
#define SWRITE_VF(bf) do { *(bf16x8*)(V_lds + (bf) * SHM_V + vst0) = pack8(S.sf0, S.sf1); *(bf16x8*)(V_lds + (bf) * SHM_V + vst1) = pack8(S.sf2, S.sf3); } while (0)
template <class TIn, class TOut>
__device__ __forceinline__ void causal_swa_prime(const BlockRef<TIn, TOut>& cur, int W, char* lds, Seam<TIn>& S) {
    constexpr bool F32 = same_t<TIn, float>::v;
    int tid_o = threadIdx.x; asm volatile("" : "+v"(tid_o));
    const int tid = tid_o, wid = __builtin_amdgcn_readfirstlane(tid >> 6), lane = tid & 63, r32 = lane & 31, hi = lane >> 5;
    const int sr = tid >> 4, sc = (tid & 15) * 8, kws = KSWZ(sr, sc * 2); char* K_lds = lds + 2 * SHM_V;
    const int kb0 = swa_jlo(cur.P0, W) * KVBLK;
    for (int d0 = 0; d0 < 8; ++d0) S.qr[d0] = load8<TIn>(cur.Q + (size_t)(wid * QBLK + r32) * LDQ + d0 * 16 + hi * 8);
    if constexpr (F32) { SLOAD_F((const float*)cur.K, kb0); VMW(); SWRITE_KF(0); SBAR(); SLOAD_F((const float*)cur.V, kb0); }
    else { SLOAD_H(cur.K, cur.V, kb0); VMW(); SWRITE_HK(0); }
    __syncthreads();
}
template <class TIn, class TOut>
__device__ __forceinline__ void causal_swa_block(const BlockRef<TIn, TOut>& cur, const BlockRef<TIn, TOut>& nxt, int skv, int W, char* lds, Seam<TIn>& S) {
    constexpr bool F32 = same_t<TIn, float>::v;
    int tid_o = threadIdx.x; asm volatile("" : "+v"(tid_o));
    const int tid = tid_o, wid = __builtin_amdgcn_readfirstlane(tid >> 6), lane = tid & 63, r32 = lane & 31, hi = lane >> 5;
    const int j_lo = swa_jlo(cur.P0, W);
    int j_hi = (cur.P0 + QB - 1) / KVBLK + 1; if (j_hi > skv / KVBLK) j_hi = skv / KVBLK;
    const int NT = j_hi - j_lo;
    const int kbn = swa_jlo(nxt.P0, W) * KVBLK;
    const int qlo = cur.P0 + wid * QBLK, qm = qlo + r32 - 4 * hi;
    char* V_lds = lds; char* K_lds = lds + 2 * SHM_V;
    float* ws = (float*)(lds + 2 * SHM_V + 2 * SHM_K) + wid * 64; float* li_l = ws, * al_l = ws + 32;
    float m_reg = -1e30f, l_reg = 0; f32x16 o[4] = {};
    const int sr = tid >> 4, sc = (tid & 15) * 8, vst0 = v_st(sr, sc), vst1 = v_st(32 + sr, sc), kws = KSWZ(sr, sc * 2);
    const int vb0 = (int)(uintptr_t)V_lds + v_rd_base(lane);
    const TIn* Kh = cur.K; const TIn* Vh = cur.V;
#define RESC(a) do { if (__any((a) < 1.f)) { if (hi == 0) al_l[r32] = (a); asm volatile("s_waitcnt lgkmcnt(0)" ::: "memory");              \
                     for (int d_ = 0; d_ < 4; ++d_) for (int r = 0; r < 16; ++r) o[d_][r] *= al_l[crow(r, hi)]; } } while (0)
#define KBASE(t) ((j_lo + (t)) * KVBLK)
#define ACT(t) (KBASE(t) <= qlo + QBLK - 1 && KBASE(t) + KVBLK - 1 >= qlo - W + 1)
#define MASKT(P0_, P1_, t) do { const int kb_ = KBASE(t); if ((!SK || ACT(t)) && (kb_ + KVBLK - 1 > qlo || kb_ <= qlo + QBLK - 1 - W)) mask_tile(P0_, P1_, qm - kb_, (unsigned)W); } while (0)
    constexpr int NQL = F32 ? 16 : 8;
    constexpr bool SK = WSKIP && !F32;
#define SEAM_K0() do { VMWN(NQL); if constexpr (F32) { SWRITE_KF(0); SBAR(); SLOAD_F((const float*)nxt.V, kbn); } else { SWRITE_HK(0); } SBAR(); } while (0)
    f32x16 pA0, pA1, pB0, pB1; float mnA, mnB, alA, alB; bf16x8 pa0, pa1, pa2, pa3;
    if constexpr (F32) { VMW(); SWRITE_VF(0); SBAR(); } else { SWRITE_HV(0); SBAR(); }
    if (NT > 1) { if constexpr (F32) SLOAD_F((const float*)Kh, KBASE(1)); else SLOAD_H(Kh, Vh, KBASE(1)); }
    SBAR(); qkt<0, SK>(pA0, pA1, K_lds, r32, hi, S.qr, ACT(0));
    if constexpr (F32) { if (NT > 1) { VMW(); SWRITE_KF(1); SBAR(); SLOAD_F((const float*)Vh, KBASE(1)); } }
    MASKT(pA0, pA1, 0); partialSM(pA0, pA1, m_reg, mnA, alA);
    if (NT > 1) { VMW(); if constexpr (F32) { SWRITE_VF(1); SBAR(); if (NT > 2) SLOAD_F((const float*)Kh, KBASE(2)); } else SWRITE_H(1); }
    __syncthreads();
#define HALF_STEP(PX0, PX1, mnX, alX, PY0, PY1, alY, t, KB, VB, SB) do {                                                      \
        SBAR(); qkt<KB, SK>(PX0, PX1, K_lds, r32, hi, S.qr, ACT(t));                                             \
        finishSM(PY0, PY1, alY, l_reg, pa0, pa1, pa2, pa3); SBAR();                                                           \
        if ((t) + 1 < NT) { if constexpr (F32) { VMW(); SWRITE_KF(SB); SBAR(); SLOAD_F((const float*)Vh, KBASE((t) + 1)); }  \
                            else { SLOAD_H(Kh, Vh, KBASE((t) + 1)); } SBAR(); }                                               \
        pv_tile<VB, SK>(o, vb0, pa0, pa1, pa2, pa3, ACT((t) - 1)); MASKT(PX0, PX1, (t)); partialSM(PX0, PX1, m_reg, mnX, alX);                                        \
        __syncthreads();                                                                                                      \
        if ((t) + 1 < NT) { VMW(); if constexpr (F32) { SWRITE_VF(SB); SBAR(); if ((t) + 2 < NT) SLOAD_F((const float*)Kh, KBASE((t) + 2)); } \
                            else { SWRITE_H(SB); } }                                                                          \
        RESC(alX); __syncthreads(); } while (0)
    for (int t = 1; t + 1 < NT; t += 2) {
        HALF_STEP(pB0, pB1, mnB, alB, pA0, pA1, alA, t, 1, 0, 0);
        HALF_STEP(pA0, pA1, mnA, alA, pB0, pB1, alB, t + 1, 0, 1, 1);
    }
    const bool even = (NT & 1) == 0;
    if (even) { SBAR(); qkt<1, SK>(pB0, pB1, K_lds, r32, hi, S.qr, ACT(NT - 1)); SBAR(); }
#define QROW(e) (nxt.Q + (size_t)(wid * QBLK + r32) * D + ((e) >> 1) * 16 + hi * 8 + ((e) & 1) * 4)
    if constexpr (F32) { SLOAD_F((const float*)nxt.K, kbn); SBAR();
#pragma unroll
        for (int e = 0; e < 8; ++e) S.tq[e] = *(const f32x4*)QROW(e); }
    else { SLOAD_H(nxt.K, nxt.V, kbn); SBAR();
#pragma unroll
        for (int d0 = 0; d0 < 8; ++d0) S.qr[d0] = load8<TIn>(nxt.Q + (size_t)(wid * QBLK + r32) * LDQ + d0 * 16 + hi * 8); }
    SBAR();
    finishSM(pA0, pA1, alA, l_reg, pa0, pa1, pa2, pa3); SBAR();
    if constexpr (F32) {
#pragma unroll
        for (int e = 8; e < 16; ++e) S.tq[e] = *(const f32x4*)QROW(e); SBAR(); }
#undef QROW
    pv_tile<0, SK>(o, vb0, pa0, pa1, pa2, pa3, ACT(even ? NT - 2 : NT - 1));
    if (even) { MASKT(pB0, pB1, NT - 1); partialSM(pB0, pB1, m_reg, mnB, alB); __syncthreads(); RESC(alB);
        finishSM(pB0, pB1, alB, l_reg, pa0, pa1, pa2, pa3); SBAR(); pv_tile<1, SK>(o, vb0, pa0, pa1, pa2, pa3, ACT(NT - 1)); }
    SBAR(); SEAM_K0();
    if (hi == 0) li_l[r32] = l_reg; asm volatile("s_waitcnt lgkmcnt(0)" ::: "memory");
    float rli[16];
#pragma unroll
    for (int r = 0; r < 16; ++r) rli[r] = __builtin_amdgcn_rcpf(li_l[crow(r, hi)]);
    TOut* Ow = cur.O + (size_t)(wid * QBLK) * LDO;
#pragma unroll
    for (int r = 0; r < 16; ++r) { const int orow = crow(r, hi);
#pragma unroll
        for (int d0 = 0; d0 < 4; ++d0) { const float v = o[d0][r] * rli[r];
            if constexpr (same_t<TOut, float>::v) { Ow[(size_t)orow * LDO + d0 * 32 + r32] = v; }
            else { const float vn = swz<1>(v);
                   if ((r32 & 1) == 0) *(unsigned*)(Ow + (size_t)orow * LDO + d0 * 32 + r32) = cvtpk(v, vn); } } }
    if constexpr (F32) {
#pragma unroll
        for (int d0 = 0; d0 < 8; ++d0) S.qr[d0] = pack8(S.tq[2 * d0], S.tq[2 * d0 + 1]); }
    __syncthreads();
#undef RESC
#undef KBASE
#undef ACT
#undef MASKT
#undef SEAM_K0
#undef HALF_STEP
}
#undef ROW
#undef VMW
#undef VMWN
#undef SLOAD_H
#undef SWRITE_HK
#undef SWRITE_HV
#undef SWRITE_H
#undef SLOAD_F
#undef SWRITE_KF
#undef SWRITE_VF

constexpr int P_QB = 128, SHM_VT = 2 * SHM_V;
constexpr int L_K = 0, L_V = 2 * SHM_K, L_P = L_V + 2 * SHM_VT, L_M = L_P + NW * 2048, L_WS = L_M + 2 * NW * 256, PAIR_LDS_BYTES = L_WS + NW * 256;
template <bool HAVE, bool PRE> __device__ __forceinline__ void pair_core(const bf16* Qp, const bf16* Kp, const bf16* V0p, const bf16* V1p, int P0, char* lds, f32x16 (&o)[4], bf16x8 (&sq)[8], bf16x8& sk0, bf16x8& sk1, const bf16* Qn, const bf16* Kn) {
    int tid_o = threadIdx.x; asm volatile("" : "+v"(tid_o));
    const int tid = tid_o, wid = __builtin_amdgcn_readfirstlane(tid >> 6), lane = tid & 63, r32 = lane & 31, hi = lane >> 5;
    const int wq = wid & 3, half = wid >> 2;
    const int NT = (P0 + P_QB) / KVBLK;
    const int qlo = P0 + wq * QBLK, qm = qlo + r32 - 4 * hi;
    char* K_lds = lds + L_K; char* V_lds = lds + L_V;
    float* ws = (float*)(lds + L_WS) + wid * 64; float* li_l = ws; float* al_l = ws + 32;
    float* Mmine = (float*)(lds + L_M) + wid * 64 + lane; const float* Mpart = (const float*)(lds + L_M) + (wid ^ 4) * 64 + lane;
    u32x4* Pmine = (u32x4*)(lds + L_P + wid * 2048) + lane; const u32x4* Ppart = (const u32x4*)(lds + L_P + (wid ^ 4) * 2048) + lane;
    const int sr = tid >> 4, sc = (tid & 15) * 8, vst0 = v_st(sr, sc), vst1 = v_st(32 + sr, sc), kws = KSWZ(sr, sc * 2);
    const int vb0 = (int)(uintptr_t)V_lds + half * SHM_V + v_rd_base(lane);
    const unsigned sof0 = (unsigned)(sr * D + sc) * 2u;
    bf16x8 qr[8];
    bf16x8 st_k0, st_k1, st_v00, st_v01, st_v10, st_v11;
    if constexpr (HAVE) { st_k0 = sk0; st_k1 = sk1; } else { st_k0 = *(const bf16x8*)((const char*)Kp + sof0); st_k1 = *(const bf16x8*)((const char*)Kp + 32 * D * 2 + sof0); }
#pragma unroll
    for (int d0 = 0; d0 < 8; ++d0) { if constexpr (HAVE) qr[d0] = sq[d0]; else qr[d0] = load8<bf16>(Qp + (size_t)(wq * QBLK + r32) * D + d0 * 16 + hi * 8); }
    const char* kb[4];
#pragma unroll
    for (int dd = 0; dd < 4; ++dd) kb[dd] = K_lds + half * (32 * 256) + KSWZ(r32, (dd * 16 + hi * 8) * 2);
    float m_reg = -1e30f, l_reg = 0.f;
#pragma unroll
    for (int d_ = 0; d_ < 4; ++d_) o[d_] = f32x16{};
#define PLOAD(k0) do { st_k0 = load8<bf16>(Kp + (size_t)((k0) + sr) * D + sc); st_k1 = load8<bf16>(Kp + (size_t)((k0) + 32 + sr) * D + sc);            \
                       st_v00 = load8<bf16>(V0p + (size_t)((k0) + sr) * D + sc); st_v01 = load8<bf16>(V0p + (size_t)((k0) + 32 + sr) * D + sc);        \
                       st_v10 = load8<bf16>(V1p + (size_t)((k0) + sr) * D + sc); st_v11 = load8<bf16>(V1p + (size_t)((k0) + 32 + sr) * D + sc); } while (0)
#define PWRITE(bf) do { *(bf16x8*)(K_lds + (bf) * SHM_K + kws) = st_k0; *(bf16x8*)(K_lds + (bf) * SHM_K + kws + 32 * 256) = st_k1;                       \
                        *(bf16x8*)(V_lds + (bf) * SHM_VT + vst0) = st_v00; *(bf16x8*)(V_lds + (bf) * SHM_VT + vst1) = st_v01;                             \
                        *(bf16x8*)(V_lds + (bf) * SHM_VT + SHM_V + vst0) = st_v10; *(bf16x8*)(V_lds + (bf) * SHM_VT + SHM_V + vst1) = st_v11; } while (0)
#define PTRRD(dst, base, off) asm volatile("ds_read_b64_tr_b16 %0, %1 offset:%2" : "=&v"(dst) : "v"(base), "i"(off) : "memory")
#define PPV_D0(d0) do { s16x4 l0, l1, l2, l3, h0, h1, h2, h3; constexpr int b_ = v_rd_off(d0, 0, 0);                                                        \
        PTRRD(l0, vbo, b_); PTRRD(h0, vbo, b_ + 2048); PTRRD(l1, vbo, b_ + 4096); PTRRD(h1, vbo, b_ + 6144); PTRRD(l2, vbp, b_); PTRRD(h2, vbp, b_ + 2048); PTRRD(l3, vbp, b_ + 4096); PTRRD(h3, vbp, b_ + 6144); \
        asm volatile("s_waitcnt lgkmcnt(0)" ::: "memory"); SBAR(); __builtin_amdgcn_s_setprio(1);                                                             \
        o[d0] = __builtin_amdgcn_mfma_f32_32x32x16_bf16(own0_, (bf16x8){l0[0], l0[1], l0[2], l0[3], h0[0], h0[1], h0[2], h0[3]}, o[d0], 0, 0, 0);             \
        o[d0] = __builtin_amdgcn_mfma_f32_32x32x16_bf16(own1_, (bf16x8){l1[0], l1[1], l1[2], l1[3], h1[0], h1[1], h1[2], h1[3]}, o[d0], 0, 0, 0);             \
        o[d0] = __builtin_amdgcn_mfma_f32_32x32x16_bf16(pt0, (bf16x8){l2[0], l2[1], l2[2], l2[3], h2[0], h2[1], h2[2], h2[3]}, o[d0], 0, 0, 0);               \
        o[d0] = __builtin_amdgcn_mfma_f32_32x32x16_bf16(pt1, (bf16x8){l3[0], l3[1], l3[2], l3[3], h3[0], h3[1], h3[2], h3[3]}, o[d0], 0, 0, 0); __builtin_amdgcn_s_setprio(0); } while (0)
#define PPV(vbuf, own0, own1) do { const u32x4 q0_ = Ppart[0], q1_ = Ppart[64]; const bf16x8 pt0 = __builtin_bit_cast(bf16x8, q0_), pt1 = __builtin_bit_cast(bf16x8, q1_), own0_ = own0, own1_ = own1;   \
        const int vbo = vb0 + (vbuf) * SHM_VT + half * 8192, vbp = vb0 + (vbuf) * SHM_VT + (half ^ 1) * 8192; PPV_D0(0); PPV_D0(1); PPV_D0(2); PPV_D0(3); } while (0)
    constexpr float C2 = 1.4426950408889634f * SCALE;
#define PBAR() asm volatile("s_waitcnt lgkmcnt(0)\n\ts_barrier" ::: "memory")
#define PLOADK(k0) do { const char* kt_ = (const char*)Kp + (size_t)(k0) * (D * 2); st_k0 = *(const bf16x8*)(kt_ + sof0); st_k1 = *(const bf16x8*)(kt_ + 32 * D * 2 + sof0); } while (0)
#define PLOADV(k0) do { const char* v0_ = (const char*)V0p + (size_t)(k0) * (D * 2); const char* v1_ = (const char*)V1p + (size_t)(k0) * (D * 2);                          \
                        st_v00 = *(const bf16x8*)(v0_ + sof0); st_v01 = *(const bf16x8*)(v0_ + 32 * D * 2 + sof0); st_v10 = *(const bf16x8*)(v1_ + sof0); st_v11 = *(const bf16x8*)(v1_ + 32 * D * 2 + sof0); } while (0)
#define PWRITEK(bf) do { *(bf16x8*)(K_lds + (bf) * SHM_K + kws) = st_k0; *(bf16x8*)(K_lds + (bf) * SHM_K + kws + 32 * 256) = st_k1; } while (0)
#define PWRITEV(bf) do { *(bf16x8*)(V_lds + (bf) * SHM_VT + vst0) = st_v00; *(bf16x8*)(V_lds + (bf) * SHM_VT + vst1) = st_v01;                            \
                         *(bf16x8*)(V_lds + (bf) * SHM_VT + SHM_V + vst0) = st_v10; *(bf16x8*)(V_lds + (bf) * SHM_VT + SHM_V + vst1) = st_v11; } while (0)
#define PQKT(P, bf) do { P = f32x16{}; bf16x8 kf_[8];                                                                                                     \
        _Pragma("unroll") for (int d0 = 0; d0 < 8; ++d0) kf_[d0] = *reinterpret_cast<const bf16x8*>(kb[d0 & 3] + (d0 >> 2) * 128 + (bf) * SHM_K);            \
        __builtin_amdgcn_s_setprio(1);                                                                                                                  \
        _Pragma("unroll") for (int d0 = 0; d0 < 8; ++d0) P = __builtin_amdgcn_mfma_f32_32x32x16_bf16(kf_[d0], qr[d0], P, 0, 0, 0);                          \
        __builtin_amdgcn_s_setprio(0); } while (0)
#define PMAX(P, t, LM) do { const int kb_ = (t) * KVBLK + half * 32;                                                                                      \
        if (kb_ + 31 > qlo) { const float NEG = -__builtin_inff(); const int dq = qm - kb_;                                                              \
            _Pragma("unroll") for (int r = 0; r < 16; ++r) { const int c = (r & 3) + 8 * (r >> 2); if (dq - c < 0) P[r] = NEG; } }                       \
        LM = fmaxf(fmaxf(P[0], P[1]), P[2]); _Pragma("unroll") for (int r = 3; r < 15; r += 2) LM = fmaxf(fmaxf(LM, P[r]), P[r + 1]); LM = fmaxf(LM, P[15]);                                                                       \
        { auto rr = __builtin_amdgcn_permlane32_swap(__float_as_uint(LM), __float_as_uint(LM), false, false); LM = fmaxf(__uint_as_float(rr[0]), __uint_as_float(rr[1])); } \
        Mmine[((t) & 1) * (NW * 64)] = LM; } while (0)
#define PPK4(P, B_, OUT) do { unsigned a0 = cvtpk(P[B_ + 0], P[B_ + 1]), a1 = cvtpk(P[B_ + 2], P[B_ + 3]), b0 = cvtpk(P[B_ + 4], P[B_ + 5]), b1 = cvtpk(P[B_ + 6], P[B_ + 7]);  \
        auto r0 = __builtin_amdgcn_permlane32_swap(a0, b0, false, false); auto r1 = __builtin_amdgcn_permlane32_swap(a1, b1, false, false);                  \
        u32x4 w = {r0[0], r1[0], r0[1], r1[1]}; OUT = *reinterpret_cast<bf16x8*>(&w); } while (0)
#define PSOFT(P, tt, LM, AL) do { const float pmax = fmaxf(LM, Mpart[((tt) & 1) * (NW * 64)]);                                                           \
        const bool defer = __all((pmax - m_reg) * SCALE <= THR); const float mn = defer ? m_reg : fmaxf(m_reg, pmax);                                    \
        AL = __builtin_amdgcn_exp2f((m_reg - mn) * C2); m_reg = mn; const float mnL = -mn * C2;                                                          \
        _Pragma("unroll") for (int r = 0; r < 16; ++r) P[r] = __builtin_amdgcn_exp2f(fmaf(P[r], C2, mnL));                                               \
        float ps = 0.f; _Pragma("unroll") for (int r = 0; r < 16; ++r) ps += P[r];                                                                        \
        { auto rr = __builtin_amdgcn_permlane32_swap(__float_as_uint(ps), __float_as_uint(ps), false, false); ps = __uint_as_float(rr[0]) + __uint_as_float(rr[1]); } \
        l_reg = l_reg * AL + ps; PPK4(P, 0, pa_o0); PPK4(P, 8, pa_o1);                                                                                    \
        Pmine[0] = __builtin_bit_cast(u32x4, pa_o0); Pmine[64] = __builtin_bit_cast(u32x4, pa_o1); } while (0)
#define PRESC(AL) do { if (__any((AL) < 1.f)) { if (hi == 0) al_l[r32] = (AL); asm volatile("s_waitcnt lgkmcnt(0)" ::: "memory");                       \
        _Pragma("unroll") for (int d_ = 0; d_ < 4; ++d_) _Pragma("unroll") for (int r = 0; r < 16; ++r) o[d_][r] *= al_l[crow(r, hi)]; } } while (0)
    bf16x8 pa_o0 = {}, pa_o1 = {};
    f32x16 p_old, p_new; float lm_old, lm_new, alpha;
    PWRITEK(0);
    PBAR();
    PLOADK(KVBLK); PLOADV(0);
    PQKT(p_old, 0); PMAX(p_old, 0, lm_old);
    PBAR();
    PWRITEK(1);
    PBAR();
#define PSTEP(PO, LMO, PN, LMN, t_, LAST) do { const int bf = (t_) & 1; const int tn = ((t_) + 1 < NT) ? (t_) + 1 : NT - 1;                                     \
        PWRITEV(bf ^ 1);                                                                                                                                     \
        if (!(LAST)) { PLOADK(tn * KVBLK); PLOADV((t_) * KVBLK); PQKT(PN, bf); }                                                                              \
        PSOFT(PO, (t_) - 1, LMO, alpha);                                                                                                                     \
        if (!(LAST)) { PMAX(PN, (t_), LMN); }                                                                                                                 \
        PRESC(alpha);                                                                                                                                        \
        PBAR();                                                                                                                                              \
        if (!(LAST)) { PWRITEK(bf ^ 1); }                                                                                                                     \
        PPV(bf ^ 1, pa_o0, pa_o1);                                                                                                                           \
        PBAR(); } while (0)
    for (int t = 1; t < NT; t += 2) { PSTEP(p_old, lm_old, p_new, lm_new, t, false); PSTEP(p_new, lm_new, p_old, lm_old, t + 1, (t + 1 == NT)); }
    if constexpr (PRE) {
#pragma unroll
        for (int d0 = 0; d0 < 8; ++d0) sq[d0] = load8<bf16>(Qn + (size_t)(wq * QBLK + r32) * D + d0 * 16 + hi * 8);
        sk0 = *(const bf16x8*)((const char*)Kn + sof0); sk1 = *(const bf16x8*)((const char*)Kn + 32 * D * 2 + sof0);
    }
    *Mmine = l_reg;
    PBAR();
    const float l_tot = l_reg + *Mpart;
    if (hi == 0) li_l[r32] = l_tot; asm volatile("s_waitcnt lgkmcnt(0)" ::: "memory");
    float rli[16];
#pragma unroll
    for (int r = 0; r < 16; ++r) rli[r] = __builtin_amdgcn_rcpf(li_l[crow(r, hi)]);
#pragma unroll
    for (int r = 0; r < 16; ++r)
#pragma unroll
        for (int d0 = 0; d0 < 4; ++d0) o[d0][r] *= rli[r];
    PBAR();
#undef PLOAD
#undef PWRITE
#undef PTRRD
#undef PPV_D0
#undef PPV
#undef PPK4
#undef PBAR
#undef PSTEP
#undef PLOADK
#undef PLOADV
#undef PWRITEK
#undef PWRITEV
#undef PQKT
#undef PMAX
#undef PSOFT
#undef PRESC
}

__device__ __forceinline__ void diff_block(const bf16* Qp, const bf16* Kp, const bf16* V0p, const bf16* V1p, int P0, char* lds, float lam, float oscale, const float* gain, unsigned short* mixrow0, int plane, u32x4* park) {
    f32x16 o[4];
    bf16x8 sq[8], sk0, sk1;
    pair_core<false, true>(Qp, Kp, V0p, V1p, P0, lds, o, sq, sk0, sk1, Qp + (size_t)plane, Kp + (size_t)plane);
    { int t2 = threadIdx.x; asm volatile("" : "+v"(t2)); u32x4* pk = park + (t2 >> 6) * 512 + (t2 & 63);
#pragma unroll
        for (int d0 = 0; d0 < 4; ++d0)
#pragma unroll
            for (int j4 = 0; j4 < 2; ++j4) { u32x4 w; w.x = cvtpk(o[d0][8 * j4], o[d0][8 * j4 + 1]); w.y = cvtpk(o[d0][8 * j4 + 2], o[d0][8 * j4 + 3]); w.z = cvtpk(o[d0][8 * j4 + 4], o[d0][8 * j4 + 5]); w.w = cvtpk(o[d0][8 * j4 + 6], o[d0][8 * j4 + 7]);
                pk[(d0 * 2 + j4) * 64] = w; } }
    pair_core<true, false>(Qp + (size_t)plane, Kp + (size_t)plane, V0p, V1p, P0, lds, o, sq, sk0, sk1, Qp, Kp);
    int tid_o = threadIdx.x; asm volatile("" : "+v"(tid_o));
    const int tid = tid_o, wid = __builtin_amdgcn_readfirstlane(tid >> 6), lane = tid & 63, r32 = lane & 31, hi = lane >> 5, wq = wid & 3, half = wid >> 2;
    unsigned op[4][8];
    { const u32x4* pk = park + wid * 512 + lane;
#pragma unroll
        for (int d0 = 0; d0 < 4; ++d0)
#pragma unroll
            for (int j4 = 0; j4 < 2; ++j4) { const u32x4 w = pk[(d0 * 2 + j4) * 64]; op[d0][4 * j4] = w.x; op[d0][4 * j4 + 1] = w.y; op[d0][4 * j4 + 2] = w.z; op[d0][4 * j4 + 3] = w.w; } }
    float q[16];
#pragma unroll
    for (int r = 0; r < 16; ++r) { q[r] = 0.f;
#pragma unroll
        for (int d0 = 0; d0 < 4; ++d0) { const unsigned w = op[d0][r >> 1]; const float a = (r & 1) ? __uint_as_float(w & 0xffff0000u) : __uint_as_float(w << 16);
            const float d = a - lam * o[d0][r]; o[d0][r] = d; q[r] += d * d; } }
#pragma unroll
    for (int r = 0; r < 16; ++r) { q[r] += swz<1>(q[r]); q[r] += swz<2>(q[r]); q[r] += swz<4>(q[r]); q[r] += swz<8>(q[r]); q[r] += swz<16>(q[r]); }
    float* X = (float*)(lds + L_M) + wid * 64; const float* Xp = (const float*)(lds + L_M) + (wid ^ 4) * 64;
    if (r32 == 0) {
#pragma unroll
        for (int r = 0; r < 16; ++r) X[crow(r, hi)] = q[r];
    }
    asm volatile("s_waitcnt lgkmcnt(0)\n\ts_barrier" ::: "memory");
    float g[4];
#pragma unroll
    for (int d0 = 0; d0 < 4; ++d0) g[d0] = gain[half * 128 + d0 * 32 + r32];
    unsigned short* orow = mixrow0 + (size_t)(wq * QBLK) * 2048 + half * 128;
#pragma unroll
    for (int r = 0; r < 16; ++r) { const int rw = crow(r, hi); const float ss = q[r] + Xp[rw]; const float rs = oscale / sqrtf(ss * (1.0f / 256.0f) + 1e-6f);
#pragma unroll
        for (int d0 = 0; d0 < 4; ++d0) { const float v = o[d0][r] * rs * g[d0];
            orow[(size_t)rw * 2048 + d0 * 32 + r32] = (unsigned short)cvtpk(v, v); } }
    asm volatile("s_waitcnt lgkmcnt(0)\n\ts_barrier" ::: "memory");
}
}
constexpr int BATCH = 8, SEQ = 4096, DM = 2048, DEPTH = 2, M = BATCH * SEQ;
constexpr int NZ = 5632, DFF = 5632;
constexpr float RMS_EPS = 1e-6f, LN_EPS = 1e-5f;
constexpr int NWAVES = 8;
#ifndef MK_PER_PHASE
#define MK_PER_PHASE 0
#endif
constexpr int LPH = 5;
constexpr int N_PHASES = 2 + LPH * DEPTH;
#ifndef REP_P0
#define REP_P0 1
#endif
#ifndef REP_GEMM
#define REP_GEMM 1
#endif
#ifndef REP_THIN
#define REP_THIN 1
#endif
#ifndef REP_MIX
#define REP_MIX 1
#endif
#ifndef REP_ATT
#define REP_ATT 1
#endif
constexpr size_t MiB = 1u << 20;
constexpr size_t WS_ROPE = 1 * MiB;
constexpr size_t WS_W = 17 * MiB, W_LAYER = 96 * MiB;
constexpr size_t WO_IN = 0, WO_OUT = 22 * MiB, WO_GU = 30 * MiB, WO_DOWN = 74 * MiB;
constexpr size_t WS_Z = 210 * MiB;
constexpr size_t WS_H = 562 * MiB;
constexpr size_t WS_MIX = 690 * MiB;
constexpr size_t WS_V = 818 * MiB;
constexpr size_t WS_O = 882 * MiB;
constexpr size_t WS_END = 1015 * MiB;
constexpr int LDS_BYTES = 136192;

#define LAS __attribute__((address_space(3)))
typedef unsigned short bf16;
typedef unsigned v4u __attribute__((ext_vector_type(4)));
typedef unsigned v2u __attribute__((ext_vector_type(2)));
typedef float f32x4 __attribute__((ext_vector_type(4)));
typedef short bf16x8 __attribute__((ext_vector_type(8)));
#define LDS_WAIT() asm volatile("s_waitcnt lgkmcnt(0)" ::: "memory")
__device__ __forceinline__ unsigned f2bf(float f) { unsigned u = __builtin_bit_cast(unsigned, f); return (u + 0x7fffu + ((u >> 16) & 1u)) >> 16; }
__device__ __forceinline__ unsigned pk2(float lo, float hi) { return f2bf(lo) | (f2bf(hi) << 16); }
__device__ __forceinline__ float bflo(unsigned w) { return __uint_as_float(w << 16); }
__device__ __forceinline__ float bfhi(unsigned w) { return __uint_as_float(w & 0xffff0000u); }
__device__ __forceinline__ void unpack8(const v4u w, float* f) { f[0] = bflo(w.x); f[1] = bfhi(w.x); f[2] = bflo(w.y); f[3] = bfhi(w.y); f[4] = bflo(w.z); f[5] = bfhi(w.z); f[6] = bflo(w.w); f[7] = bfhi(w.w); }
__device__ __forceinline__ v4u pack8f(const float* f) { v4u w; w.x = pk2(f[0], f[1]); w.y = pk2(f[2], f[3]); w.z = pk2(f[4], f[5]); w.w = pk2(f[6], f[7]); return w; }
__device__ __forceinline__ float wave_sum(float v) { v += swz<1>(v); v += swz<2>(v); v += swz<4>(v); v += swz<8>(v); v += swz<16>(v); return sum32(v); }
__device__ __forceinline__ float gelu_exact(float v) {
    const float av = fabsf(v), t = __builtin_amdgcn_rcpf(av * 0.2316418882f + 1.0f);
    float q = t * 0.5307027145f + (-0.7265760135f); q = q * t + 0.7107068705f; q = q * t + (-0.142248368f); q = q * t + 0.127414796f; q = q * t;
    const float e = __builtin_amdgcn_exp2f((v * v) * (-0.72134752044f));
    const float m = v * (q * e);
    return v < 0.f ? m : v - m;
}

__device__ __forceinline__ void transpose_item(const float* W, int K, int N, bf16* WT, int k0, int n0, int drow0, const float* gain, LAS float* scr, int lane) {
    float wv[32];
    const float* wp = W + (size_t)(k0 + (lane >> 5)) * N + n0 + (lane & 31);
#pragma unroll
    for (int i = 0; i < 32; ++i) wv[i] = wp[(size_t)(2 * i) * N];
    if (gain) {
#pragma unroll
        for (int i = 0; i < 32; ++i) wv[i] *= gain[k0 + 2 * i + (lane >> 5)];
    }
#pragma unroll
    for (int i = 0; i < 32; ++i) scr[(2 * i + (lane >> 5)) * 33 + (lane & 31)] = wv[i];
    LDS_WAIT(); asm volatile("" ::: "memory");
    const int c = lane & 7;
#pragma unroll
    for (int j = 0; j < 4; ++j) { const int n = (lane >> 3) + 8 * j; const LAS float* s = scr + (8 * c) * 33 + n;
        v4u o; o.x = pk2(s[0 * 33], s[1 * 33]); o.y = pk2(s[2 * 33], s[3 * 33]); o.z = pk2(s[4 * 33], s[5 * 33]); o.w = pk2(s[6 * 33], s[7 * 33]);
        *(v4u*)(WT + (size_t)(drow0 + n) * K + k0 + 8 * c) = o; }
    LDS_WAIT(); asm volatile("" ::: "memory");
}
__device__ __forceinline__ void x_row_to_bf16(const float* xrow, bf16* orow, float* ssq, int lane) {
    const f32x4* xr = (const f32x4*)xrow + lane; f32x4 v[8]; float s = 0.f;
#pragma unroll
    for (int j = 0; j < 8; ++j) { v[j] = xr[64 * j]; s += (v[j].x * v[j].x + v[j].y * v[j].y) + (v[j].z * v[j].z + v[j].w * v[j].w); }
    s = wave_sum(s);
#pragma unroll
    for (int j = 0; j < 8; ++j) { v2u w; w.x = pk2(v[j].x, v[j].y); w.y = pk2(v[j].z, v[j].w); ((v2u*)orow + lane)[64 * j] = w; }
    if (lane < 8) ssq[lane] = lane == 0 ? s : 0.f;
}
__device__ __forceinline__ void final_row(const bf16* xrow, float ssq, const float* g, float* orow, int lane) {
    const float rstd = 1.0f / sqrtf(ssq * (1.0f / DM) + RMS_EPS);
#pragma unroll
    for (int j = 0; j < 4; ++j) { const int c = 8 * lane + 512 * j; float x[8]; unpack8(*(const v4u*)(xrow + c), x);
        const f32x4 g0 = *(const f32x4*)(g + c), g1 = *(const f32x4*)(g + c + 4);
        *(f32x4*)(orow + c) = (f32x4){x[0] * rstd * g0[0], x[1] * rstd * g0[1], x[2] * rstd * g0[2], x[3] * rstd * g0[3]};
        *(f32x4*)(orow + c + 4) = (f32x4){x[4] * rstd * g1[0], x[5] * rstd * g1[1], x[6] * rstd * g1[2], x[7] * rstd * g1[3]}; }
}
typedef __attribute__((address_space(1))) unsigned gu32;
constexpr size_t WS_CTL = 0, CTL_ZERO_BYTES = 65536; constexpr int CW_BAR = 4096;
constexpr size_t WS_SSQ = 1010 * MiB;
constexpr int MISC_OFF = 131072, PSTAT_OFF = 131072 + 64;
#define XB_TMO      128
#define XB_XCNT(j)  (256  + 64 * (j))
#define XB_XSUB(j)  (1280 + 64 * (j))
#define XB_XGEN(j)  (2304 + 64 * (j))
#define XB_TOP      3328
#define XB_TOPGEN   3392
#define XCD_BAR_WORDS 3456
#define XB_SPIN_CAP (1u << 18)

__device__ __forceinline__ unsigned xb_ld(unsigned* p)              { return __hip_atomic_load(p, __ATOMIC_RELAXED, __HIP_MEMORY_SCOPE_AGENT); }
__device__ __forceinline__ unsigned xb_add(unsigned* p, unsigned v) { return __hip_atomic_fetch_add(p, v, __ATOMIC_RELAXED, __HIP_MEMORY_SCOPE_AGENT); }
__device__ __forceinline__ unsigned xb_xcc_id() { return (unsigned)__builtin_amdgcn_s_getreg((3 << 11) | 20) & 0xFu; }
#define XB_SPIN(cond, bar) do { unsigned _sp = 0; while (cond) { __builtin_amdgcn_s_sleep(1); \
    if ((++_sp & 255u) == 0u) { if (xb_ld(&(bar)[XB_TMO])) break; if (_sp > XB_SPIN_CAP) { atomicAdd(&(bar)[XB_TMO], 1u); break; } } } } while (0)

struct XcdBarrier {
    unsigned* bar; unsigned x;
    volatile LAS unsigned* st;
};

__device__ __forceinline__ XcdBarrier xcd_barrier_post(unsigned* bar, volatile LAS unsigned* st) {
    XcdBarrier b; b.bar = bar; b.x = xb_xcc_id(); b.st = st;
    if (threadIdx.x == 0) (void)xb_add(&bar[XB_XCNT(b.x)], 1u);
    return b;
}
__device__ __forceinline__ void xcd_barrier_complete(unsigned* bar, unsigned x, unsigned& nloc, unsigned& nx) {
    const unsigned G = gridDim.x * gridDim.y * gridDim.z;
    unsigned sum, cnt, mine, sp = 0u;
    for (;;) {
        sum = 0u; cnt = 0u; mine = 0u;
#pragma unroll
        for (unsigned j = 0; j < 16; ++j) { const unsigned c = xb_ld(&bar[XB_XCNT(j)]); sum += c; cnt += (c > 0u) ? 1u : 0u; mine = (j == x) ? c : mine; }
        if (sum == G) break;
        __builtin_amdgcn_s_sleep(1);
        if ((++sp & 255u) == 0u) { if (xb_ld(&bar[XB_TMO])) break; if (sp > XB_SPIN_CAP) { atomicAdd(&bar[XB_TMO], 1u); break; } }
    }
    nloc = mine > 0u ? mine : 1u; nx = cnt > 0u ? cnt : 1u;
}

__device__ __forceinline__ void xcd_barrier(const XcdBarrier& b) {
    asm volatile("s_waitcnt vmcnt(0)" ::: "memory");
    __syncthreads();
    if (threadIdx.x == 0) {
        unsigned* bar = b.bar;
        __builtin_amdgcn_s_waitcnt(0);
        unsigned nloc = b.st[0], nx = b.st[1];
        if (nloc == 0u) { xcd_barrier_complete(bar, b.x, nloc, nx); b.st[0] = nloc; b.st[1] = nx; }
        const unsigned old = xb_add(&bar[XB_XSUB(b.x)], 1u);
        const unsigned gen = old / nloc;
        if (old + 1u == (gen + 1u) * nloc) {
            __builtin_amdgcn_fence(__ATOMIC_RELEASE, "agent");
            asm volatile("s_waitcnt vmcnt(0)" ::: "memory");
            const unsigned og = xb_add(&bar[XB_TOP], 1u);
            const unsigned tg = og / nx;
            if (og + 1u == (tg + 1u) * nx) xb_add(&bar[XB_TOPGEN], 1u);
            else XB_SPIN(xb_ld(&bar[XB_TOPGEN]) == tg, bar);
            __builtin_amdgcn_fence(__ATOMIC_ACQUIRE, "agent");
            xb_add(&bar[XB_XGEN(b.x)], 1u);
            asm volatile("s_waitcnt vmcnt(0)" ::: "memory");
        } else {
            XB_SPIN(xb_ld(&bar[XB_XGEN(b.x)]) == gen, bar);
            __builtin_amdgcn_fence(__ATOMIC_ACQUIRE, "agent");
            asm volatile("s_waitcnt vmcnt(0)" ::: "memory");
        }
    }
    __syncthreads();
}
struct Args { const void* in[20]; float* out; unsigned char* ws; int ph_lo, ph_hi; };

__device__ __forceinline__ void gmlp_unit(int unit, const bf16* z, bf16* mix, const float* ln_g, const float* ln_b, const float* wsp, const float* bsp, const float* mixn,
                                          LAS unsigned char* lds, int tid, int lane, int wave) {
    const int g = unit & 3, n = (unit >> 2) & 31, b = unit >> 7;
    const size_t row0 = (size_t)b * SEQ + (size_t)n * 128;
    LAS unsigned short* vnT = (LAS unsigned short*)lds;
    {
        const int s = tid >> 2, cq = tid & 3;
        const bf16* src = z + (row0 + s) * NZ + 512 + g * 128 + cq * 32;
        float v[32]; float sum = 0.f;
#pragma unroll
        for (int i = 0; i < 4; ++i) { const v4u w = *(const v4u*)(src + i * 8); unpack8(w, v + i * 8); }
#pragma unroll
        for (int i = 0; i < 32; ++i) { v[i] = gelu_exact(v[i]); sum += v[i]; }
        sum += swz<1>(sum); sum += swz<2>(sum);
        const float mu = sum * (1.0f / 128.0f); float q = 0.f;
#pragma unroll
        for (int i = 0; i < 32; ++i) { v[i] -= mu; q += v[i] * v[i]; }
        q += swz<1>(q); q += swz<2>(q);
        const float rstd = 1.0f / sqrtf(q * (1.0f / 128.0f) + LN_EPS);
        const float* gp = ln_g + g * 128 + cq * 32; const float* bp = ln_b + g * 128 + cq * 32;
#pragma unroll
        for (int i = 0; i < 8; ++i) { const f32x4 gg = *(const f32x4*)(gp + 4 * i), bb = *(const f32x4*)(bp + 4 * i);
#pragma unroll
            for (int e = 0; e < 4; ++e) { const float vn = v[4 * i + e] * rstd * gg[e] + bb[e]; vnT[(cq * 32 + 4 * i + e) * 136 + s] = (unsigned short)f2bf(vn); } }
    }
    __syncthreads();
    {
        const int tcol = lane & 15, quad = lane >> 4, t = 16 * wave + tcol, nks = (wave >> 1) + 1;
        f32x4 acc[8];
#pragma unroll
        for (int ct = 0; ct < 8; ++ct) acc[ct] = (f32x4){0.f, 0.f, 0.f, 0.f};
        const float* wrow = wsp + ((size_t)g * 128 + t) * 128;
        for (int ks = 0; ks < nks; ++ks) {
            const int s0 = 32 * ks + 8 * quad;
            const f32x4 w0 = *(const f32x4*)(wrow + s0), w1 = *(const f32x4*)(wrow + s0 + 4);
            float wf[8] = {w0[0], w0[1], w0[2], w0[3], w1[0], w1[1], w1[2], w1[3]};
#pragma unroll
            for (int e = 0; e < 8; ++e) if (s0 + e > t) wf[e] = 0.f;
            const v4u bw = pack8f(wf); const bf16x8 bfrag = __builtin_bit_cast(bf16x8, bw);
#pragma unroll
            for (int ct = 0; ct < 8; ++ct) { const bf16x8 a = *(const LAS bf16x8*)(vnT + (16 * ct + tcol) * 136 + s0);
                acc[ct] = __builtin_amdgcn_mfma_f32_16x16x32_bf16(a, bfrag, acc[ct], 0, 0, 0); }
        }
        const float bst = bsp[g * 128 + t];
        const size_t m = row0 + t; const bf16* up = z + m * NZ + g * 128 + 4 * quad; float ss = 0.f;
#pragma unroll
        for (int ct = 0; ct < 8; ++ct) { const v2u uw = *(const v2u*)(up + 16 * ct);
            const float u0 = gelu_exact(bflo(uw.x)), u1 = gelu_exact(bfhi(uw.x)), u2 = gelu_exact(bflo(uw.y)), u3 = gelu_exact(bfhi(uw.y));
            acc[ct][0] = u0 * (acc[ct][0] + bst); acc[ct][1] = u1 * (acc[ct][1] + bst); acc[ct][2] = u2 * (acc[ct][2] + bst); acc[ct][3] = u3 * (acc[ct][3] + bst);
            ss += (acc[ct][0] * acc[ct][0] + acc[ct][1] * acc[ct][1]) + (acc[ct][2] * acc[ct][2] + acc[ct][3] * acc[ct][3]); }
        ss += swz<16>(ss); ss = sum32(ss);
        const float r = 1.0f / sqrtf(ss * (1.0f / 128.0f) + RMS_EPS);
        bf16* op = mix + m * DM + g * 128 + 4 * quad; const float* np = mixn + g * 128 + 4 * quad;
        f32x4 gnv[8];
#pragma unroll
        for (int ct = 0; ct < 8; ++ct) gnv[ct] = *(const f32x4*)(np + 16 * ct);
#pragma unroll
        for (int ct = 0; ct < 8; ++ct) { const f32x4 gn = gnv[ct]; v2u w;
            w.x = pk2(acc[ct][0] * r * gn[0], acc[ct][1] * r * gn[1]); w.y = pk2(acc[ct][2] * r * gn[2], acc[ct][3] * r * gn[3]); *(v2u*)(op + 16 * ct) = w; }
    }
    __syncthreads();
}

#define OPQ_V(x) asm volatile("" : "+v"(x))
__global__ void __launch_bounds__(NWAVES * 64, 2) hymba_fwd(Args args) {
    extern __shared__ __attribute__((aligned(16))) unsigned char lds[];
    {
        if (threadIdx.x < 32) ((LAS unsigned*)((LAS unsigned char*)lds + MISC_OFF))[threadIdx.x] = 0u;
        __syncthreads();
        (void)xcd_barrier_post((unsigned*)(args.ws + WS_CTL) + CW_BAR, (volatile LAS unsigned*)((LAS unsigned char*)lds + MISC_OFF));
    }
    if (args.ph_lo == 0) {
        const int p = 0;
        LAS unsigned char* ldsp = (LAS unsigned char*)lds;
        int tid = threadIdx.x; OPQ_V(tid);
        const int lane = tid & 63, wave = __builtin_amdgcn_readfirstlane(tid >> 6);
        int zs = 0; asm volatile("" : "+s"(zs));
        const int G = gridDim.x + zs, bx = blockIdx.x + zs, vcu = (G % 8 == 0) ? (bx % 8) * (G / 8) + bx / 8 : bx;
        const int gw = vcu * NWAVES + wave, NGW = G * NWAVES;
        unsigned char* ws = args.ws;
        float* xo = args.out;
        bf16* Z = (bf16*)(ws + WS_Z); bf16* Hb = (bf16*)(ws + WS_H); bf16* MIX = (bf16*)(ws + WS_MIX); bf16* VB = (bf16*)(ws + WS_V); bf16* OB = (bf16*)(ws + WS_O);
        float* ctab = (float*)(ws + WS_ROPE); float* stab = ctab + (size_t)M * 64;
        const bool fin = (p == N_PHASES - 1); const int l = fin ? 0 : (p - 1) / LPH, kk = (p - 1) % LPH, k = fin ? 7 : (p == 0) ? -1 : (kk == 0 ? 0 : kk == 1 ? 2 : kk + 2);
        float* ssq = (float*)(ws + WS_SSQ); bf16* QKb = (bf16*)args.out;
        unsigned char* wl = ws + WS_W + (size_t)l * W_LAYER;
        const float* mixn = (const float*)args.in[13] + (size_t)l * DM;
        {
            const float* x_in = (const float*)args.in[0]; const int* positions = (const int*)args.in[1];
            LAS float* scr = (LAS float*)(ldsp + wave * 16384);
            constexpr int I_IN = 32 * 176, I_OUT = 32 * 64, I_G = 32 * 176, I_DN = 88 * 64, I_LAYER = I_IN + I_OUT + 2 * I_G + I_DN;
            for (int it = gw; it < DEPTH * I_LAYER; it += NGW) {
                const int ll = it / I_LAYER; int r = it - ll * I_LAYER;
                unsigned char* wll = ws + WS_W + (size_t)ll * W_LAYER;
                if (r < I_IN) { const int kb = r / 176, nb = r % 176, n0 = 32 * nb, o = n0 & 255;
                    const int dr = (n0 >= 1024 && n0 < 3072) ? (n0 & ~255) + 128 * ((o >> 6) & 1) + 64 * (o >> 7) + (o & 63) : n0;
                    transpose_item((const float*)args.in[3] + (size_t)ll * DM * NZ, DM, NZ, (bf16*)(wll + WO_IN), 64 * kb, n0, dr, (const float*)args.in[2] + ll * DM, scr, lane); continue; } r -= I_IN;
                if (r < I_OUT) { const int kb = r / 64, nb = r % 64; transpose_item((const float*)args.in[14] + (size_t)ll * DM * DM, DM, DM, (bf16*)(wll + WO_OUT), 64 * kb, 32 * nb, 32 * nb, nullptr, scr, lane); continue; } r -= I_OUT;
                if (r < 2 * I_G) { const int up = r >= I_G; if (up) r -= I_G; const int kb = r / 176, nb = r % 176, n0 = 32 * nb;
                    transpose_item((const float*)args.in[up ? 17 : 16] + (size_t)ll * DM * DFF, DM, DFF, (bf16*)(wll + WO_GU), 64 * kb, n0, (n0 >> 7) * 256 + (n0 & 127) + (up ? 128 : 0), (const float*)args.in[15] + ll * DM, scr, lane); continue; } r -= 2 * I_G;
                { const int kb = r / 64, nb = r % 64; transpose_item((const float*)args.in[18] + (size_t)ll * DFF * DM, DFF, DM, (bf16*)(wll + WO_DOWN), 64 * kb, 32 * nb, 32 * nb, nullptr, scr, lane); }
            }
            for (int e = vcu * 512 + tid; e < M * 64; e += G * 512) { const int m = e >> 6, j = e & 63;
                const float inv_freq = 1.0f / powf(10000.0f, (float)(2 * j) * (1.0f / 128.0f)); const float ang = (float)positions[m] * inv_freq;
                float sn, cs; sincosf(ang, &sn, &cs); ctab[e] = cs; stab[e] = sn; }
            {
                f32x4 va[8], vb[8];
#define XLD(V, m_) do { const f32x4* xr_ = (const f32x4*)(x_in + (size_t)(m_) * DM) + lane; _Pragma("unroll") for (int j = 0; j < 8; ++j) V[j] = xr_[64 * j]; } while (0)
#define XST(V, m_) do { float s_ = 0.f; _Pragma("unroll") for (int j = 0; j < 8; ++j) s_ += (V[j].x * V[j].x + V[j].y * V[j].y) + (V[j].z * V[j].z + V[j].w * V[j].w); s_ = wave_sum(s_);            \
        v2u* o_ = (v2u*)(Hb + (size_t)(m_) * DM) + lane; _Pragma("unroll") for (int j = 0; j < 8; ++j) { v2u w_; w_.x = pk2(V[j].x, V[j].y); w_.y = pk2(V[j].z, V[j].w); o_[64 * j] = w_; }                 \
        float* q_ = (float*)(ws + WS_SSQ) + (size_t)(m_) * 8; if (lane < 8) q_[lane] = lane == 0 ? s_ : 0.f; } while (0)
                XLD(va, gw);
                for (int m = gw; m < M; m += 2 * NGW) {
                    XLD(vb, m + NGW); XST(va, m);
                    if (m + 2 * NGW < M) XLD(va, m + 2 * NGW);
                    XST(vb, m + NGW); }
#undef XLD
#undef XST
            }
        }
        if (1 < args.ph_hi) { XcdBarrier bar; bar.bar = (unsigned*)(args.ws + WS_CTL) + CW_BAR; bar.x = xb_xcc_id(); bar.st = (volatile LAS unsigned*)((LAS unsigned char*)lds + MISC_OFF); xcd_barrier(bar); }
        if (args.ph_hi < 0) cg::this_grid().sync();
    }
    for (int p = (args.ph_lo == 0 ? 1 : args.ph_lo); p < args.ph_hi; ++p) {
        LAS unsigned char* ldsp = (LAS unsigned char*)lds;
        int zs = 0; asm volatile("" : "+s"(zs));
        const int G = gridDim.x + zs, bx = blockIdx.x + zs, vcu = (G % 8 == 0) ? (bx % 8) * (G / 8) + bx / 8 : bx;
        const int NGW = G * NWAVES;
#define PHASE_IDS() int tid = threadIdx.x; OPQ_V(tid); const int lane = tid & 63, wave = __builtin_amdgcn_readfirstlane(tid >> 6); const int gw = vcu * NWAVES + wave; (void)gw; (void)lane
        unsigned char* ws = args.ws;
        float* xo = args.out;
        bf16* Z = (bf16*)(ws + WS_Z); bf16* Hb = (bf16*)(ws + WS_H); bf16* MIX = (bf16*)(ws + WS_MIX); bf16* VB = (bf16*)(ws + WS_V); bf16* OB = (bf16*)(ws + WS_O);
        float* ctab = (float*)(ws + WS_ROPE); float* stab = ctab + (size_t)M * 64;
        const bool fin = (p == N_PHASES - 1); const int l = fin ? 0 : (p - 1) / LPH, kk = (p - 1) % LPH, k = fin ? 7 : (p == 0) ? -1 : (kk == 0 ? 0 : kk == 1 ? 2 : kk + 2);
        float* ssq = (float*)(ws + WS_SSQ); bf16* QKb = (bf16*)args.out;
        unsigned char* wl = ws + WS_W + (size_t)l * W_LAYER;
        const float* mixn = (const float*)args.in[13] + (size_t)l * DM;
#ifdef ONLY_ATT
        if (k != 2) continue;
#endif
        if (k == 0) {
            pg8::Gemm g{Hb, (const bf16*)(wl + WO_IN), M, NZ, DM}; pg8::StaticOrder S; S.init(M, NZ, G, bx);
            const float* sqp = ssq + (size_t)(2 * l) * M * 8;
            int pmA, pmB; { pg8::Unit u0; S.next(0, u0); pmA = pmB = u0.pm; for (int i = 1; S.next(i, u0); ++i) if (u0.pm != pmA) { pmB = u0.pm; break; } }
            { int t = threadIdx.x; OPQ_V(t); ((LAS float*)(ldsp + PSTAT_OFF))[t] = pg8::row_rstd(sqp, (t < 256 ? pmA : pmB) * 256 + (t & 255)); }
            __syncthreads();
            const pg8::RsTab T{(const LAS float*)(ldsp + PSTAT_OFF), pmA, pmB, sqp};
            pg8::EpiIn E{Z, NZ, T, QKb, VB, ctab, stab};
            pg8::gemm_phase<pg8::EpiIn, pg8::StaticOrder, PG8_ALIGN, PG8_SP2>(ldsp, g, S, E);
        } else if (k == 2) {
            PHASE_IDS();
            {
                const float* cw = (const float*)args.in[12] + (size_t)l * 3 * 512 + lane * 8;
                float w0[8], w1[8], w2[8], gn[8];
#pragma unroll
                for (int h2 = 0; h2 < 2; ++h2) { const f32x4 a = *(const f32x4*)(cw + 4 * h2), b = *(const f32x4*)(cw + 512 + 4 * h2), c = *(const f32x4*)(cw + 1024 + 4 * h2), d = *(const f32x4*)(mixn + 1536 + lane * 8 + 4 * h2);
#pragma unroll
                    for (int e = 0; e < 4; ++e) { w0[4 * h2 + e] = a[e]; w1[4 * h2 + e] = b[e]; w2[4 * h2 + e] = c[e]; gn[4 * h2 + e] = d[e]; } }
                v4u ra[7], rb7[7];
#define CLD(R, m_) do { const int t_ = (m_) & (SEQ - 1); const bf16* zr_ = Z + (size_t)(m_) * NZ + lane * 8; const bf16* z1_ = zr_ - (t_ >= 1 ? NZ : 0); const bf16* z2_ = zr_ - (t_ >= 2 ? 2 * NZ : 0);   \
        R[0] = *(const v4u*)(zr_ + 4096); R[1] = *(const v4u*)(zr_ + 4608); R[2] = *(const v4u*)(zr_ + 5120); R[3] = *(const v4u*)(z1_ + 4608); R[4] = *(const v4u*)(z1_ + 5120);                          \
        R[5] = *(const v4u*)(z2_ + 4608); R[6] = *(const v4u*)(z2_ + 5120); } while (0)
#define CST(R, m_) do { const int t_ = (m_) & (SEQ - 1); const float f1 = t_ >= 1 ? 1.f : 0.f, f2 = t_ >= 2 ? 1.f : 0.f;         \
        float bg[8], y[8], cgv[8], hcv[8]; unpack8(R[0], bg); unpack8(R[1], cgv); unpack8(R[2], hcv);                                                                                                   \
        _Pragma("unroll") for (int e = 0; e < 8; ++e) y[e] = w2[e] * (cgv[e] * hcv[e]);                                                                                                                 \
        unpack8(R[3], cgv); unpack8(R[4], hcv); _Pragma("unroll") for (int e = 0; e < 8; ++e) y[e] += f1 * w1[e] * (cgv[e] * hcv[e]);                                                                    \
        unpack8(R[5], cgv); unpack8(R[6], hcv); _Pragma("unroll") for (int e = 0; e < 8; ++e) y[e] += f2 * w0[e] * (cgv[e] * hcv[e]);                                                                    \
        float ss = 0.f; _Pragma("unroll") for (int e = 0; e < 8; ++e) { y[e] *= bg[e]; ss += y[e] * y[e]; }                                                                                             \
        ss += swz<1>(ss); ss += swz<2>(ss); ss += swz<4>(ss); ss += swz<8>(ss);                                                                                                                         \
        const float r = 1.0f / sqrtf(ss * (1.0f / 128.0f) + RMS_EPS);                                                                                                                                   \
        _Pragma("unroll") for (int e = 0; e < 8; ++e) y[e] = y[e] * r * gn[e];                                                                                                                          \
        *(v4u*)(MIX + (size_t)(m_) * DM + 1536 + lane * 8) = pack8f(y); } while (0)
                CLD(ra, gw);
                for (int m = gw; m < M; m += 2 * NGW) {
                    CLD(rb7, m + NGW); CST(ra, m);
                    if (m + 2 * NGW < M) CLD(ra, m + 2 * NGW);
                    CST(rb7, m + NGW); }
#undef CLD
#undef CST
            }
            __syncthreads();
            for (int u = vcu; u < BATCH * 32 * 4; u += G)
                gmlp_unit(u, Z, MIX, (const float*)args.in[4] + l * 512, (const float*)args.in[5] + l * 512, (const float*)args.in[6] + (size_t)l * 4 * 128 * 128, (const float*)args.in[7] + l * 512, mixn, ldsp, tid, lane, wave);
            __syncthreads();
            {
                using ab = att::bf16;
                static_assert(att::PAIR_LDS_BYTES <= 131072, "attention LDS fits the phase region");
                const float lam_init = 0.8f - 0.6f * expf(-0.3f * (float)l);
                const float* lq1 = (const float*)args.in[8] + l * 128; const float* lk1 = (const float*)args.in[9] + l * 128;
                const float* lq2 = (const float*)args.in[10] + l * 128; const float* lk2 = (const float*)args.in[11] + l * 128;
                const float d1 = wave_sum(lq1[lane] * lk1[lane] + lq1[lane + 64] * lk1[lane + 64]), d2 = wave_sum(lq2[lane] * lk2[lane] + lq2[lane + 64] * lk2[lane + 64]);
                const float lam = expf(d1) - expf(d2) + lam_init;
                const int X = vcu >> 5, j = vcu & 31;
                for (int q = 0; q < 4; ++q) {
                    const int bh = 4 * X + q, b = bh >> 2, h = bh & 3, qb = (q & 1) ? 31 - j : j;
                    const ab* Kp = (const ab*)QKb + ((size_t)b * 16 + 8 + h * 2) * SEQ * 128; const ab* V0p = (const ab*)VB + ((size_t)b * 8 + h * 2) * SEQ * 128;
                    const ab* Qp = (const ab*)QKb + (((size_t)b * 16 + h * 2) * SEQ + (size_t)qb * 128) * 128;
                    att::diff_block(Qp, Kp, V0p, V0p + (size_t)SEQ * 128, qb * 128, (char*)lds, lam, 1.0f - lam_init, mixn + 512 + h * 256,
                                    MIX + ((size_t)b * SEQ + (size_t)qb * 128) * DM + 512 + h * 256, SEQ * 128, (att::u32x4*)OB + (size_t)vcu * 4096);
                }
            }
        } else if (k == 4 || k == 6) {
            const bool dn = (k == 6);
            pg8::Gemm g{dn ? Z : MIX, (const bf16*)(wl + (dn ? WO_DOWN : WO_OUT)), M, DM, dn ? DFF : DM}; pg8::StaticOrder S; S.init(M, DM, G, bx);
            pg8::EpiRes E{Hb, DM, ssq + (size_t)(2 * l + (dn ? 2 : 1)) * M * 8, (LAS float*)(ldsp + PSTAT_OFF)};
            pg8::gemm_phase<pg8::EpiRes, pg8::StaticOrder, PG8_ALIGN, PG8_SP2>(ldsp, g, S, E);
        } else if (k == 5) {
            pg8::Gemm g{Hb, (const bf16*)(wl + WO_GU), M, 2 * DFF, DM}; pg8::StaticOrder S; S.init(M, 2 * DFF, G, bx);
            const float* sqp = ssq + (size_t)(2 * l + 1) * M * 8;
            int pmA, pmB; { pg8::Unit u0; S.next(0, u0); pmA = pmB = u0.pm; for (int i = 1; S.next(i, u0); ++i) if (u0.pm != pmA) { pmB = u0.pm; break; } }
            { int t = threadIdx.x; OPQ_V(t); ((LAS float*)(ldsp + PSTAT_OFF))[t] = pg8::row_rstd(sqp, (t < 256 ? pmA : pmB) * 256 + (t & 255)); }
            __syncthreads();
            const pg8::RsTab T{(const LAS float*)(ldsp + PSTAT_OFF), pmA, pmB, sqp};
            pg8::EpiSwiGLU E{Z, DFF, T};
            pg8::gemm_phase<pg8::EpiSwiGLU, pg8::StaticOrder, PG8_ALIGN, PG8_SP2>(ldsp, g, S, E);
        } else {
            PHASE_IDS();
            const float* gp = (const float*)args.in[19]; const float* sq = ssq + (size_t)(2 * DEPTH) * M * 8;
            v4u xa[4], xb4[4]; float sa, sb;
#define FLD(X, S_, m_) do { S_ = pg8::row_ssq(sq, (m_)); _Pragma("unroll") for (int j = 0; j < 4; ++j) X[j] = *(const v4u*)(Hb + (size_t)(m_) * DM + 8 * lane + 512 * j); } while (0)
#define FST(X, S_, m_) do { const float rstd = 1.0f / sqrtf(S_ * (1.0f / DM) + RMS_EPS); float* orow = xo + (size_t)(m_) * DM;                                                         \
        _Pragma("unroll") for (int j = 0; j < 4; ++j) { const int c = 8 * lane + 512 * j; float x[8]; unpack8(X[j], x);                                                                \
            *(f32x4*)(orow + c) = (f32x4){x[0] * rstd * gfin[j][0][0], x[1] * rstd * gfin[j][0][1], x[2] * rstd * gfin[j][0][2], x[3] * rstd * gfin[j][0][3]};                            \
            *(f32x4*)(orow + c + 4) = (f32x4){x[4] * rstd * gfin[j][1][0], x[5] * rstd * gfin[j][1][1], x[6] * rstd * gfin[j][1][2], x[7] * rstd * gfin[j][1][3]}; } } while (0)
            f32x4 gfin[4][2];
#pragma unroll
            for (int j = 0; j < 4; ++j) { gfin[j][0] = *(const f32x4*)(gp + 8 * lane + 512 * j); gfin[j][1] = *(const f32x4*)(gp + 8 * lane + 512 * j + 4); }
            FLD(xa, sa, gw);
            for (int m = gw; m < M; m += 2 * NGW) {
                FLD(xb4, sb, m + NGW); FST(xa, sa, m);
                if (m + 2 * NGW < M) FLD(xa, sa, m + 2 * NGW);
                FST(xb4, sb, m + NGW); }
#undef FLD
#undef FST
        }
        if (p + 1 < args.ph_hi) { XcdBarrier bar; bar.bar = (unsigned*)(args.ws + WS_CTL) + CW_BAR; bar.x = xb_xcc_id(); bar.st = (volatile LAS unsigned*)((LAS unsigned char*)lds + MISC_OFF); xcd_barrier(bar); }
    }
}

extern "C" void kernel_launch(void* const* d_in, const int* in_sizes, int n_in, void* d_out, int out_size, void* d_ws, size_t ws_size, hipStream_t stream) {
    static int grid = 0;
    if (grid == 0) {
        if (n_in != 20 || in_sizes[0] != M * DM || out_size != M * DM || ws_size < WS_END) { fprintf(stderr, "kernel_launch: shape/workspace mismatch (n_in %d, in0 %d, out %d, ws %zu)\n", n_in, n_in > 0 ? in_sizes[0] : -1, out_size, ws_size); grid = -1; return; }
        int dev = 0, cus = 0, per_cu = 0;
        if (hipGetDevice(&dev) != hipSuccess || hipDeviceGetAttribute(&cus, hipDeviceAttributeMultiprocessorCount, dev) != hipSuccess) { grid = -1; return; }
        if (hipFuncSetAttribute((const void*)hymba_fwd, hipFuncAttributeMaxDynamicSharedMemorySize, LDS_BYTES) != hipSuccess) { fprintf(stderr, "kernel_launch: hipFuncSetAttribute failed\n"); grid = -1; return; }
        if (hipOccupancyMaxActiveBlocksPerMultiprocessor(&per_cu, (const void*)hymba_fwd, NWAVES * 64, LDS_BYTES) != hipSuccess || per_cu < 1) { fprintf(stderr, "kernel_launch: occupancy query says %d\n", per_cu); per_cu = 1; }
        (void)hipGetLastError();
        grid = cus * 1;
        if (grid != 256) { fprintf(stderr, "kernel_launch: built for 256 CUs (the row-scale tables assume two row panels per workgroup), device has %d; nothing launched\n", cus); grid = -1; return; }
    }
    if (grid < 0) return;
    if (hipMemsetAsync((char*)d_ws + WS_CTL, 0, CTL_ZERO_BYTES, stream) != hipSuccess) { fprintf(stderr, "kernel_launch: memset of control words failed\n"); return; }
    Args a{};
    for (int i = 0; i < 20; ++i) a.in[i] = d_in[i];
    a.out = (float*)d_out; a.ws = (unsigned char*)d_ws;
#if MK_PER_PHASE
    for (int p = 0; p < N_PHASES; ++p) { a.ph_lo = p; a.ph_hi = p + 1;
        const int kk = (p - 1) % LPH, k = (p == 0 || p == N_PHASES - 1) ? -1 : (kk == 0 ? 0 : kk == 1 ? 2 : kk + 2);
        const int nrep = (p == 0) ? REP_P0 : (k == 0 || k == 5) ? REP_GEMM : (k == 2) ? REP_ATT : (k == 1) ? REP_MIX : (k == 3) ? REP_THIN : 1;
        for (int rep = 0; rep < nrep; ++rep) hipLaunchKernelGGL(hymba_fwd, dim3(grid), dim3(NWAVES * 64), LDS_BYTES, stream, a); }
#else
    a.ph_lo = 0; a.ph_hi = N_PHASES;
    void* kargs[] = {&a};
    hipError_t e = hipLaunchCooperativeKernel((const void*)hymba_fwd, dim3(grid), dim3(NWAVES * 64), kargs, LDS_BYTES, stream);
    if (e != hipSuccess) fprintf(stderr, "cooperative launch failed: %s (grid %d)\n", hipGetErrorString(e), grid);
#endif
}
```
